# Optimizing an MI355X kernel written in HIP

```python
import math
import jax, jax.numpy as jnp
from jax import lax
import numpy as np

D_MODEL = 1024
BATCH = 4
SEQ = 4096
DEPTH = 2
DEC_BATCH = 32
DEC_SEQ = 8
PAST_LEN = 8192
PAGE_SIZE = 128

N_EVEN = (DEPTH + 1) // 2
N_ODD = DEPTH // 2
A_WIDTH = D_MODEL // 2
CHUNK = 128
A_GROUPS = 4
A_GROUP_DIM = A_WIDTH // A_GROUPS
B_HEADS = 4
B_QK_DIM = 64
B_V_DIM = 2 * B_QK_DIM
B_WIDTH = B_HEADS * B_V_DIM
IN_EVEN_WIDTH = 2 * A_WIDTH + 2 * B_HEADS * 2 * B_QK_DIM + B_WIDTH
Q_BLOCK = 128
SCALE = B_QK_DIM ** -0.5
SSM_GROUP = 16
SSM_GROUPS = D_MODEL // SSM_GROUP
SSM_STATE = 64
D_FF = ((8 * D_MODEL // 3 + 255) // 256) * 256
EPS = 1e-6

kernel_name = 'hybrid_sgu_diffattn_s5_step'


def rmsnorm(x, g):
    xf = x.astype(jnp.float32)
    y = xf * lax.rsqrt(jnp.mean(xf * xf, axis=-1, keepdims=True) + EPS)
    return (y * g.astype(jnp.float32)).astype(x.dtype)


def swiglu(h, w_in, w_out):
    gate, up = jnp.split(h @ w_in, 2, axis=-1)
    return (jax.nn.silu(gate) * up) @ w_out


def even_project(h, w_in, sgu_norm):
    b, t, _ = h.shape
    p = h @ w_in
    uv = jax.nn.gelu(p[..., :2 * A_WIDTH])
    u = uv[..., :A_WIDTH]
    v = rmsnorm(uv[..., A_WIDTH:], sgu_norm)
    o = 2 * A_WIDTH
    qk = B_HEADS * 2 * B_QK_DIM
    q = p[..., o:o + qk].reshape(b, t, B_HEADS, 2 * B_QK_DIM)
    k = p[..., o + qk:o + 2 * qk].reshape(b, t, B_HEADS, 2 * B_QK_DIM)
    vb = p[..., o + 2 * qk:].reshape(b, t, B_HEADS, B_V_DIM)
    return u, v, q, k, vb


def spatial_gate(v, sgu_w, sgu_b):
    t = v.shape[2]
    w = jnp.where(jnp.tril(jnp.ones((t, t), dtype=bool)), sgu_w[:, :t, :t], 0)
    vg = v.reshape(v.shape[:3] + (A_GROUPS, A_GROUP_DIM))
    out = jnp.einsum('gts,bnsgd->bntgd', w, vg) + sgu_b[:, :t].T[:, :, None]
    return out.reshape(v.shape)


def diff_lambda(lq1, lk1, lq2, lk2, lam_init):
    f32 = jnp.float32
    e1 = jnp.exp(jnp.sum(lq1.astype(f32) * lk1.astype(f32)))
    e2 = jnp.exp(jnp.sum(lq2.astype(f32) * lk2.astype(f32)))
    return e1 - e2 + lam_init


def diff_scores(q, k):
    s1 = jnp.einsum('bqhd,bkhd->bhqk', q[..., :B_QK_DIM], k[..., :B_QK_DIM])
    s2 = jnp.einsum('bqhd,bkhd->bhqk', q[..., B_QK_DIM:], k[..., B_QK_DIM:])
    return s1.astype(jnp.float32), s2.astype(jnp.float32)


def diff_attn_prompt(q, k, v, lam):
    b, s = q.shape[:2]
    q = q * SCALE
    k_pos = jnp.arange(s)

    def block(i):
        start = i * Q_BLOCK
        qb = lax.dynamic_slice_in_dim(q, start, Q_BLOCK, axis=1)
        s1, s2 = diff_scores(qb, k)
        mask = (start + jnp.arange(Q_BLOCK))[:, None] >= k_pos[None, :]
        p1 = jax.nn.softmax(jnp.where(mask, s1, -jnp.inf), axis=-1)
        p2 = jax.nn.softmax(jnp.where(mask, s2, -jnp.inf), axis=-1)
        return jnp.einsum('bhqk,bkhd->bqhd', (p1 - lam * p2).astype(v.dtype), v)

    o = lax.map(block, jnp.arange(s // Q_BLOCK))
    return o.transpose(1, 0, 2, 3, 4).reshape(b, s, B_HEADS, B_V_DIM)


def diff_attn_sample(q, k_new, v_new, k_past, v_past, lam):
    t = q.shape[1]
    n_past = k_past.shape[1]
    q = q * SCALE
    p1s, p2s = diff_scores(q, k_past)
    n1, n2 = diff_scores(q, k_new)
    mask = jnp.tril(jnp.ones((t, t), dtype=bool))
    p1 = jax.nn.softmax(jnp.concatenate([p1s, jnp.where(mask, n1, -jnp.inf)], axis=-1), axis=-1)
    p2 = jax.nn.softmax(jnp.concatenate([p2s, jnp.where(mask, n2, -jnp.inf)], axis=-1), axis=-1)
    a = (p1 - lam * p2).astype(v_new.dtype)
    return (jnp.einsum('bhqk,bkhd->bqhd', a[..., :n_past], v_past)
            + jnp.einsum('bhqk,bkhd->bqhd', a[..., n_past:], v_new))


def diff_head_out(o, subln, lam_init):
    b, t = o.shape[:2]
    return (rmsnorm(o, subln) * (1.0 - lam_init)).reshape(b, t, B_WIDTH)


def s5_scan(u, s0_re, s0_im, a_re, a_im, log_dt, b_re, b_im, c_re, c_im, d_skip):
    bsz, t, _ = u.shape
    f32 = jnp.float32
    a = lax.complex(a_re.astype(f32), a_im.astype(f32))
    dt = jnp.exp(log_dt.astype(f32))[:, None]
    a_bar = jnp.exp(a * dt)
    b_bar = ((a_bar - 1.0) / a)[:, :, None] * lax.complex(b_re.astype(f32), b_im.astype(f32))
    c = lax.complex(c_re.astype(f32), c_im.astype(f32))
    uc = u.astype(f32).reshape(bsz, t, SSM_GROUPS, SSM_GROUP)
    bu = jnp.einsum('gpc,btgc->btgp', b_bar, uc.astype(jnp.complex64))
    a_seq = jnp.broadcast_to(a_bar, bu.shape)

    def combine(left, right):
        a_l, b_l = left
        a_r, b_r = right
        return a_r * a_l, a_r * b_l + b_r

    a_cum, s = lax.associative_scan(combine, (a_seq, bu), axis=1)
    s = s + a_cum * lax.complex(s0_re.astype(f32), s0_im.astype(f32))[:, None]
    y = jnp.real(jnp.einsum('gcp,btgp->btgc', c, s)) + d_skip.astype(f32).reshape(SSM_GROUPS, SSM_GROUP) * uc
    s_last = s[:, -1]
    return y.reshape(bsz, t, D_MODEL).astype(u.dtype), jnp.real(s_last), jnp.imag(s_last)


def s5_glu(y, w_glu, b_glu):
    g = jax.nn.gelu(y)
    z = g @ w_glu + b_glu
    return z[..., :D_MODEL] * jax.nn.sigmoid(z[..., D_MODEL:])


def setup_inputs(seed: int = 0) -> dict:
    key = jax.random.key(seed)
    keys = jax.random.split(key, 48)

    def nrm(i, shape, scale=1.0):
        return jax.random.normal(keys[i], shape, jnp.float32) * scale

    n_pages = PAST_LEN // PAGE_SIZE
    n_used = DEC_BATCH * n_pages
    n_phys = n_used + max(1, n_used // 4)
    page_table = jax.random.permutation(keys[0], n_phys)[:n_used].reshape(DEC_BATCH, n_pages).astype(jnp.int32)
    a_im_init = math.pi * jnp.arange(SSM_STATE, dtype=jnp.float32)
    return {
        'x_prompt': nrm(1, (BATCH, SEQ, D_MODEL)),
        'x_sample': nrm(2, (DEC_BATCH, DEC_SEQ, D_MODEL)),
        'cache_k': nrm(3, (N_EVEN, n_phys, PAGE_SIZE, B_HEADS, 2 * B_QK_DIM)),
        'cache_v': nrm(4, (N_EVEN, n_phys, PAGE_SIZE, B_HEADS, B_V_DIM)),
        'page_table': page_table,
        'state_ssm_re': nrm(5, (N_ODD, DEC_BATCH, SSM_GROUPS, SSM_STATE), 0.1),
        'state_ssm_im': nrm(6, (N_ODD, DEC_BATCH, SSM_GROUPS, SSM_STATE), 0.1),
        'norm_mix': 1.0 + nrm(7, (DEPTH, D_MODEL), 0.02),
        'norm_ffn': 1.0 + nrm(8, (DEPTH, D_MODEL), 0.02),
        'norm_final': 1.0 + nrm(9, (D_MODEL,), 0.02),
        'w_in_even': nrm(10, (N_EVEN, D_MODEL, IN_EVEN_WIDTH), D_MODEL ** -0.5),
        'w_out_even': nrm(11, (N_EVEN, A_WIDTH + B_WIDTH, D_MODEL), (A_WIDTH + B_WIDTH) ** -0.5),
        'sgu_norm': 1.0 + nrm(12, (N_EVEN, A_WIDTH), 0.02),
        'sgu_w': nrm(13, (N_EVEN, A_GROUPS, CHUNK, CHUNK), CHUNK ** -0.5),
        'sgu_b': 1.0 + nrm(14, (N_EVEN, A_GROUPS, CHUNK), 0.02),
        'lambda_q1': nrm(15, (N_EVEN, B_QK_DIM), 0.1),
        'lambda_k1': nrm(16, (N_EVEN, B_QK_DIM), 0.1),
        'lambda_q2': nrm(17, (N_EVEN, B_QK_DIM), 0.1),
        'lambda_k2': nrm(18, (N_EVEN, B_QK_DIM), 0.1),
        'attn_subln': 1.0 + nrm(19, (N_EVEN, B_V_DIM), 0.02),
        'ssm_a_re': -0.5 + nrm(20, (N_ODD, SSM_GROUPS, SSM_STATE), 0.01),
        'ssm_a_im': a_im_init + nrm(21, (N_ODD, SSM_GROUPS, SSM_STATE), 0.01),
        'ssm_log_dt': jax.random.uniform(keys[22], (N_ODD, SSM_GROUPS), jnp.float32, math.log(1e-3), math.log(1e-1)),
        'ssm_b_re': nrm(23, (N_ODD, SSM_GROUPS, SSM_STATE, SSM_GROUP), (2 * SSM_GROUP) ** -0.5),
        'ssm_b_im': nrm(24, (N_ODD, SSM_GROUPS, SSM_STATE, SSM_GROUP), (2 * SSM_GROUP) ** -0.5),
        'ssm_c_re': nrm(25, (N_ODD, SSM_GROUPS, SSM_GROUP, SSM_STATE), SSM_STATE ** -0.5),
        'ssm_c_im': nrm(26, (N_ODD, SSM_GROUPS, SSM_GROUP, SSM_STATE), SSM_STATE ** -0.5),
        'ssm_d': nrm(27, (N_ODD, D_MODEL)),
        'w_glu': nrm(28, (N_ODD, D_MODEL, 2 * D_MODEL), D_MODEL ** -0.5),
        'b_glu': nrm(29, (N_ODD, 2 * D_MODEL), 0.02),
        'w_ffn_in': nrm(30, (DEPTH, D_MODEL, 2 * D_FF), D_MODEL ** -0.5),
        'w_ffn_out': nrm(31, (DEPTH, D_FF, D_MODEL), D_FF ** -0.5),
    }


def reference(x_prompt, x_sample, cache_k, cache_v, page_table, state_ssm_re, state_ssm_im,
              norm_mix, norm_ffn, norm_final, w_in_even, w_out_even, sgu_norm, sgu_w, sgu_b,
              lambda_q1, lambda_k1, lambda_q2, lambda_k2, attn_subln,
              ssm_a_re, ssm_a_im, ssm_log_dt, ssm_b_re, ssm_b_im, ssm_c_re, ssm_c_im, ssm_d,
              w_glu, b_glu, w_ffn_in, w_ffn_out):
    xp, xs = x_prompt, x_sample
    kp_rows, vp_rows, ks_rows, vs_rows, chunk_rows = [], [], [], [], []
    sp_re, sp_im, ss_re, ss_im = [], [], [], []
    for l in range(DEPTH):
        hp = rmsnorm(xp, norm_mix[l])
        hs = rmsnorm(xs, norm_mix[l])
        if l % 2 == 0:
            i = l // 2
            lam_init = 0.8 - 0.6 * math.exp(-0.3 * l)
            lam = diff_lambda(lambda_q1[i], lambda_k1[i], lambda_q2[i], lambda_k2[i], lam_init)
            up, vp, qp, kp, vbp = even_project(hp, w_in_even[i], sgu_norm[i])
            us, vs, qs, k_s, vbs = even_project(hs, w_in_even[i], sgu_norm[i])
            b, s = xp.shape[:2]
            a_p = up * spatial_gate(vp.reshape(b, s // CHUNK, CHUNK, A_WIDTH), sgu_w[i], sgu_b[i]).reshape(b, s, A_WIDTH)
            a_s = us * spatial_gate(vs[:, None], sgu_w[i], sgu_b[i])[:, 0]
            b_p = diff_head_out(diff_attn_prompt(qp, kp, vbp, lam), attn_subln[i], lam_init)
            db = xs.shape[0]
            k_past = cache_k[i][page_table].reshape(db, -1, B_HEADS, 2 * B_QK_DIM)
            v_past = cache_v[i][page_table].reshape(db, -1, B_HEADS, B_V_DIM)
            b_s = diff_head_out(diff_attn_sample(qs, k_s, vbs, k_past, v_past, lam), attn_subln[i], lam_init)
            mp = jnp.concatenate([a_p, b_p], axis=-1) @ w_out_even[i]
            ms = jnp.concatenate([a_s, b_s], axis=-1) @ w_out_even[i]
            kp_rows.append(kp)
            vp_rows.append(vbp)
            ks_rows.append(k_s)
            vs_rows.append(vbs)
            chunk_rows.append(vs)
        else:
            j = l // 2
            zeros = jnp.zeros((xp.shape[0], SSM_GROUPS, SSM_STATE), jnp.float32)
            ssm_params = (ssm_a_re[j], ssm_a_im[j], ssm_log_dt[j], ssm_b_re[j], ssm_b_im[j],
                          ssm_c_re[j], ssm_c_im[j], ssm_d[j])
            y_p, p_re, p_im = s5_scan(hp, zeros, zeros, *ssm_params)
            y_s, s_re, s_im = s5_scan(hs, state_ssm_re[j], state_ssm_im[j], *ssm_params)
            mp = s5_glu(y_p, w_glu[j], b_glu[j])
            ms = s5_glu(y_s, w_glu[j], b_glu[j])
            sp_re.append(p_re)
            sp_im.append(p_im)
            ss_re.append(s_re)
            ss_im.append(s_im)
        xp = xp + mp
        xs = xs + ms
        xp = xp + swiglu(rmsnorm(xp, norm_ffn[l]), w_ffn_in[l], w_ffn_out[l])
        xs = xs + swiglu(rmsnorm(xs, norm_ffn[l]), w_ffn_in[l], w_ffn_out[l])
    y_prompt = rmsnorm(xp, norm_final)
    y_sample = rmsnorm(xs, norm_final)
    return (y_prompt, y_sample, jnp.stack(kp_rows), jnp.stack(vp_rows), jnp.stack(ks_rows),
            jnp.stack(vs_rows), jnp.stack(chunk_rows), jnp.stack(sp_re), jnp.stack(sp_im),
            jnp.stack(ss_re), jnp.stack(ss_im))
```

```cpp
#include <hip/hip_runtime.h>
#include <cstdio>
#include <cstdint>
namespace pg8 {
#define PG8_LAS __attribute__((address_space(3)))
typedef unsigned short bf16_t;
typedef short bf16x8 __attribute__((ext_vector_type(8)));
typedef float f32x4 __attribute__((ext_vector_type(4)));
typedef unsigned u32x4 __attribute__((ext_vector_type(4)));
constexpr int BM = 256, BK = 64, HALF = 128, HTB = HALF * BK * 2  , STAGE_BYTES = 8 * HTB, NXCD = 8, WGM = 8;

__host__ __device__ __forceinline__ int lds_byte(int r, int c) { const int st = (r >> 4) * 2 + (c >> 5), rr = r & 15, cc = c & 31, ob = rr * 64 + cc * 2; return st * 1024 + (ob ^ (((ob >> 9) & 1) << 5)); }
__host__ __device__ __forceinline__ void stage_rc(int b, int& R, int& C) { const int st = b / 1024, sb = b % 1024, swz = sb ^ (((sb >> 9) & 1) << 5); R = (st >> 1) * 16 + swz / 64; C = (st & 1) * 32 + (swz % 64) / 2; }
__host__ __device__ __forceinline__ int perm32(int rho) { const int n = rho >> 4, i = rho & 15; return 8 * (i >> 2) + 4 * n + (i & 3); }

struct Unit { int pm, pn; };
struct Gemm { const bf16_t* A; const bf16_t* Bt; int M, N, K; };

struct StaticOrder {
    int nM, nN, nwg, G, c;
    __host__ __device__ void init(int M, int N, int G_, int c_) { nM = M / BM; nN = N / BM; nwg = nM * nN; G = G_; c = c_; }
    __host__ __device__ bool next(int i, Unit& u) const {
        const long L = (long)i * G + c; if (L >= nwg) return false;
        int wgid = (int)L; { const int q = nwg / NXCD, r = nwg % NXCD, xcd = wgid % NXCD, off = wgid / NXCD; wgid = (xcd < r ? xcd * (q + 1) : r * (q + 1) + (xcd - r) * q) + off; }
        const int nig = WGM * nN, gid = wgid / nig, fm = gid * WGM, gsz = (nM - fm) < WGM ? (nM - fm) : WGM;
        u.pm = fm + ((wgid % nig) % gsz); u.pn = (wgid % nig) / gsz; return true;
    }
    __device__ __forceinline__ void a_ready(const Unit&) const {}
    __device__ __forceinline__ void done(const Unit&) const {}
};

__device__ __forceinline__ unsigned cvt_pk_bf16(float lo, float hi) { unsigned r; asm volatile("v_cvt_pk_bf16_f32 %0, %1, %2" : "=v"(r) : "v"(lo), "v"(hi)); return r; }
typedef float f32x2 __attribute__((ext_vector_type(2)));
constexpr int NP_ = 16384, NS_ = 256;
constexpr size_t OFF_YP = 0, OFF_YS = OFF_YP + (size_t)NP_ * 1024, OFF_KP = OFF_YS + (size_t)NS_ * 1024, OFF_VP = OFF_KP + (size_t)NP_ * 512, OFF_KS = OFF_VP + (size_t)NP_ * 512,
                 OFF_VS = OFF_KS + (size_t)NS_ * 512, OFF_CV = OFF_VS + (size_t)NS_ * 512, OFF_SRP = OFF_CV + (size_t)NS_ * 512, OFF_SIP = OFF_SRP + 4 * 64 * 64, OFF_SRS = OFF_SIP + 4 * 64 * 64,
                 OFF_SIS = OFF_SRS + 32 * 64 * 64, OUT_TOTAL = OFF_SIS + 32 * 64 * 64;
constexpr float QSCALE = 0.125f * 1.4426950408889634f;
#define PG8_RLXA __ATOMIC_RELAXED, __HIP_MEMORY_SCOPE_AGENT
__device__ __forceinline__ void ss_add(unsigned long long* p, float v) { __hip_atomic_fetch_add(p, (unsigned long long)(v * 1048576.0f + 0.5f), PG8_RLXA); }
__device__ __forceinline__ float ss_rinv(const unsigned long long* p, float inv_n) { const unsigned long long w = __hip_atomic_load(p, PG8_RLXA); return __builtin_amdgcn_rsqf((float)w * (inv_n * (1.0f / 1048576.0f)) + 1e-6f); }
__device__ __forceinline__ float gelu_t(float x) { const float t = x * (1.0f + 0.044715f * x * x); return x * __builtin_amdgcn_rcpf(1.0f + __builtin_amdgcn_exp2f(-2.302208198f * t)); }
__device__ __forceinline__ float sigm(float x) { return __builtin_amdgcn_rcpf(1.0f + __builtin_amdgcn_exp2f(-1.4426950409f * x)); }
__device__ __forceinline__ float quad_sum(float s) { s += __shfl_xor(s, 16); s += __shfl_xor(s, 32); return s; }
__device__ __forceinline__ u32x4 pack8(const f32x4 a, const f32x4 b) { u32x4 w; w.x = cvt_pk_bf16(a[0], a[1]); w.y = cvt_pk_bf16(a[2], a[3]); w.z = cvt_pk_bf16(b[0], b[1]); w.w = cvt_pk_bf16(b[2], b[3]); return w; }

struct EpiInProj {
    static constexpr bool PERM = true, AFTER_DRAIN = false;
    const float* r0; bf16_t* U; bf16_t* VR; bf16_t* QB; bf16_t* KB; bf16_t* VB; unsigned long long* vss; float* out;
    __device__ __forceinline__ void operator()(const f32x4 (&acc)[2][2][4][2], const Unit& u, int wr, int wc, int fr, int fq) const {
        const int row0 = u.pm * BM + wr * 64 + fr, seg = u.pn >> 1, col0 = (u.pn & 1) * 256 + wc * 32 + 8 * fq;
        bf16_t* dstb = seg == 0 ? U : seg == 1 ? VR : seg == 2 ? QB : seg == 3 ? KB : VB;
        const bool prompt = u.pm < NP_ / BM;
        float* dstf = out + (prompt ? (seg == 3 ? OFF_KP : OFF_VP) : (seg == 3 ? OFF_KS : OFF_VS));
#pragma unroll
        for (int ai = 0; ai < 2; ++ai)
#pragma unroll
            for (int m = 0; m < 4; ++m) {
                const int row = row0 + ai * HALF + m * 16; const float r = r0[row]; float ssq = 0.f;
                const int orow = prompt ? row : row - NP_;
#pragma unroll
                for (int bj = 0; bj < 2; ++bj) {
                    f32x4 v0 = acc[ai][bj][m][0] * r, v1 = acc[ai][bj][m][1] * r; const int col = col0 + bj * HALF;
                    if (seg <= 1) {
#pragma unroll
                        for (int i = 0; i < 4; ++i) { v0[i] = gelu_t(v0[i]); v1[i] = gelu_t(v1[i]); }
                        if (seg == 1) ssq += (v0[0] * v0[0] + v0[1] * v0[1]) + (v0[2] * v0[2] + v0[3] * v0[3]) + (v1[0] * v1[0] + v1[1] * v1[1]) + (v1[2] * v1[2] + v1[3] * v1[3]);
                    } else if (seg == 2) { v0 = v0 * QSCALE; v1 = v1 * QSCALE; }
                    else { float* o = dstf + (size_t)orow * 512 + col; *(f32x4*)o = v0; *(f32x4*)(o + 4) = v1; }
                    *(u32x4*)(dstb + (size_t)row * 512 + col) = pack8(v0, v1);
                }
                if (seg == 1) { ssq = quad_sum(ssq); if (fq == 0) ss_add(vss + row, ssq); }
            }
    }
};
struct EpiResid {
    static constexpr bool PERM = true, AFTER_DRAIN = false;
    const float* resP; const float* resS; float* X; bf16_t* XB; unsigned long long* ss;
    __device__ __forceinline__ void operator()(const f32x4 (&acc)[2][2][4][2], const Unit& u, int wr, int wc, int fr, int fq) const {
        const int row0 = u.pm * BM + wr * 64 + fr, col0 = u.pn * BM + wc * 32 + 8 * fq; const bool prompt = u.pm < NP_ / BM;
#pragma unroll
        for (int ai = 0; ai < 2; ++ai)
#pragma unroll
            for (int m = 0; m < 4; ++m) {
                const int row = row0 + ai * HALF + m * 16; float ssq = 0.f;
                const float* rp = (prompt ? resP + (size_t)row * 1024 : resS + (size_t)(row - NP_) * 1024) + col0;
#pragma unroll
                for (int bj = 0; bj < 2; ++bj) {
                    const f32x4 o0 = acc[ai][bj][m][0] + *(const f32x4*)(rp + bj * HALF), o1 = acc[ai][bj][m][1] + *(const f32x4*)(rp + bj * HALF + 4);
                    float* xo = X + (size_t)row * 1024 + col0 + bj * HALF; *(f32x4*)xo = o0; *(f32x4*)(xo + 4) = o1;
                    if (XB) *(u32x4*)(XB + (size_t)row * 1024 + col0 + bj * HALF) = pack8(o0, o1);
                    ssq += (o0[0] * o0[0] + o0[1] * o0[1]) + (o0[2] * o0[2] + o0[3] * o0[3]) + (o1[0] * o1[0] + o1[1] * o1[1]) + (o1[2] * o1[2] + o1[3] * o1[3]);
                }
                ssq = quad_sum(ssq); if (fq == 0) ss_add(ss + row, ssq);
            }
    }
};
struct EpiSwiGLU {
    static constexpr bool PERM = true, AFTER_DRAIN = false;
    const unsigned long long* ss; bf16_t* ACT;
    __device__ __forceinline__ void operator()(const f32x4 (&acc)[2][2][4][2], const Unit& u, int wr, int wc, int fr, int fq) const {
        const int row0 = u.pm * BM + wr * 64 + fr, col0 = u.pn * HALF + wc * 32 + 8 * fq;
#pragma unroll
        for (int ai = 0; ai < 2; ++ai)
#pragma unroll
            for (int m = 0; m < 4; ++m) {
                const int row = row0 + ai * HALF + m * 16; const float r = ss_rinv(ss + row, 1.0f / 1024.0f);
                f32x4 a[2];
#pragma unroll
                for (int n = 0; n < 2; ++n) { const f32x4 g = acc[ai][0][m][n] * r, up = acc[ai][1][m][n] * r;
#pragma unroll
                    for (int i = 0; i < 4; ++i) a[n][i] = g[i] * sigm(g[i]) * up[i]; }
                *(u32x4*)(ACT + (size_t)row * 2816 + col0) = pack8(a[0], a[1]);
            }
    }
};
struct EpiGLU {
    static constexpr bool PERM = true, AFTER_DRAIN = false;
    const float* bglu; float* X; bf16_t* XB; unsigned long long* ss;
    __device__ __forceinline__ void operator()(const f32x4 (&acc)[2][2][4][2], const Unit& u, int wr, int wc, int fr, int fq) const {
        const int row0 = u.pm * BM + wr * 64 + fr, col0 = u.pn * HALF + wc * 32 + 8 * fq;
        f32x4 bv[2], bg[2];
#pragma unroll
        for (int n = 0; n < 2; ++n) { bv[n] = *(const f32x4*)(bglu + col0 + 4 * n); bg[n] = *(const f32x4*)(bglu + 1024 + col0 + 4 * n); }
#pragma unroll
        for (int ai = 0; ai < 2; ++ai)
#pragma unroll
            for (int m = 0; m < 4; ++m) {
                const int row = row0 + ai * HALF + m * 16; float* xp = X + (size_t)row * 1024 + col0; f32x4 o[2]; float ssq = 0.f;
#pragma unroll
                for (int n = 0; n < 2; ++n) { const f32x4 zv = acc[ai][0][m][n] + bv[n], zg = acc[ai][1][m][n] + bg[n], x = *(const f32x4*)(xp + 4 * n);
#pragma unroll
                    for (int i = 0; i < 4; ++i) { o[n][i] = x[i] + zv[i] * sigm(zg[i]); ssq += o[n][i] * o[n][i]; } }
                *(f32x4*)xp = o[0]; *(f32x4*)(xp + 4) = o[1];
                *(u32x4*)(XB + (size_t)row * 1024 + col0) = pack8(o[0], o[1]);
                ssq = quad_sum(ssq); if (fq == 0) ss_add(ss + row, ssq);
            }
    }
};
template <class Epi, class Sched, bool ALIGN_EPI = false, bool SP2 = false>
__device__ __forceinline__ void gemm_phase(PG8_LAS unsigned char* lds, const Gemm g, const Sched& S, const Epi& E) {
    int tid_ = threadIdx.x; asm volatile("" : "+v"(tid_));
    const int tid = tid_, wid = __builtin_amdgcn_readfirstlane(tid >> 6), lane = tid & 63, wr = wid >> 2, wc = wid & 3, fr = lane & 15, fq = lane >> 4;
    const int K = g.K, nt = K / BK;
    unsigned voffA[2], voffB[2];
#pragma unroll
    for (int i = 0; i < 2; ++i) { int R, C; stage_rc(tid * 16 + i * 8192, R, C); const int Rb = Epi::PERM ? ((R & ~31) + perm32(R & 31)) : R;
        voffA[i] = (unsigned)(R * K + C) * 2u; voffB[i] = (unsigned)(Rb * K + C) * 2u; }
    const size_t kstep = (size_t)(BK * 2);
    const size_t hstep = (size_t)HALF * K * 2;
    const size_t tstep = 2 * hstep;
    const unsigned ldsw = (unsigned)wid * 1024u;
    const int aoff = lds_byte(wr * 64 + fr, fq * 8), boff = lds_byte(wc * 32 + fr, fq * 8);
#define PG8_SA(b, h) (((b) * 2 + (h)) * HTB)
#define PG8_SB(b, h) ((4 + (b) * 2 + (h)) * HTB)
#define PG8_STAGE(bufoff, gbase, voff) do { _Pragma("unroll") for (int _i = 0; _i < 2; ++_i) \
        __builtin_amdgcn_global_load_lds((const unsigned*)((const char*)(gbase) + (voff)[_i]), (PG8_LAS unsigned*)(lds + (bufoff) + ldsw + _i * 8192), 16, 0, 0); } while (0)
#define PG8_LDA(dst, b, h) do { _Pragma("unroll") for (int m = 0; m < 4; ++m) _Pragma("unroll") for (int k = 0; k < 2; ++k) dst[m][k] = *(const PG8_LAS bf16x8*)(lds + PG8_SA(b, h) + aoff + m * 2048 + k * 1024); } while (0)
#define PG8_LDB(dst, b, h) do { _Pragma("unroll") for (int n = 0; n < 2; ++n) _Pragma("unroll") for (int k = 0; k < 2; ++k) dst[n][k] = *(const PG8_LAS bf16x8*)(lds + PG8_SB(b, h) + boff + n * 2048 + k * 1024); } while (0)
#define PG8_MMA(ai, bj, At, Bt) do { __builtin_amdgcn_s_setprio(1); _Pragma("unroll") for (int m = 0; m < 4; ++m) _Pragma("unroll") for (int n = 0; n < 2; ++n) _Pragma("unroll") for (int k = 0; k < 2; ++k) \
        acc[ai][bj][m][n] = __builtin_amdgcn_mfma_f32_16x16x32_bf16(Bt[n][k], At[m][k], acc[ai][bj][m][n], 0, 0, 0); __builtin_amdgcn_s_setprio(0); } while (0)
#define PG8_WAIT_V(n) asm volatile("s_waitcnt vmcnt(" #n ")" ::: "memory")
#define PG8_WAIT_L(n) asm volatile("s_waitcnt lgkmcnt(" #n ")" ::: "memory")
#define PG8_BAR __builtin_amdgcn_s_barrier()
#define PG8_SCHED __builtin_amdgcn_sched_barrier(0)
    Unit cur, nxt; int ui = 0;
    if (!S.next(0, cur)) return;
    f32x4 acc[2][2][4][2];
#pragma unroll
    for (int a = 0; a < 2; ++a)
#pragma unroll
        for (int b = 0; b < 2; ++b)
#pragma unroll
            for (int m = 0; m < 4; ++m)
#pragma unroll
                for (int n = 0; n < 2; ++n) acc[a][b][m][n] = (f32x4){0.f, 0.f, 0.f, 0.f};
    bf16x8 At[4][2], B0[2][2], B1[2][2];
    const char* cA = (const char*)g.A + (size_t)cur.pm * tstep; const char* cB = (const char*)g.Bt + (size_t)cur.pn * tstep;
    S.a_ready(cur);
    if constexpr (SP2) {
        PG8_STAGE(PG8_SB(0, 0), cB, voffB); PG8_STAGE(PG8_SB(0, 1), cB + hstep, voffB); PG8_STAGE(PG8_SA(0, 0), cA, voffA); PG8_STAGE(PG8_SA(0, 1), cA + hstep, voffA);
        if (wr == 1) PG8_BAR;
        PG8_WAIT_V(2); PG8_BAR;
        PG8_STAGE(PG8_SB(1, 0), cB + kstep, voffB); PG8_STAGE(PG8_SA(1, 0), cA + kstep, voffA); PG8_STAGE(PG8_SB(1, 1), cB + hstep + kstep, voffB);
        PG8_WAIT_V(6); PG8_BAR;
    } else {
        PG8_STAGE(PG8_SB(0, 0), cB, voffB); PG8_STAGE(PG8_SA(0, 0), cA, voffA); PG8_STAGE(PG8_SB(0, 1), cB + hstep, voffB); PG8_STAGE(PG8_SA(0, 1), cA + hstep, voffA);
        if (wr == 1) PG8_BAR;
        PG8_WAIT_V(4); PG8_BAR;
        PG8_STAGE(PG8_SB(1, 0), cB + kstep, voffB); PG8_STAGE(PG8_SA(1, 0), cA + kstep, voffA); PG8_STAGE(PG8_SB(1, 1), cB + hstep + kstep, voffB);
        PG8_WAIT_V(6); PG8_BAR;
    }
    for (;;) {
        const bool has_next = S.next(ui + 1, nxt);
        const char* nA = has_next ? (const char*)g.A + (size_t)nxt.pm * tstep : cA; const char* nB = has_next ? (const char*)g.Bt + (size_t)nxt.pn * tstep : cB;
        for (int t = 0; t < nt; t += 2) {
            const bool last = (t == nt - 2);
            const char* a1 = cA + (size_t)(t + 1) * kstep;
            const char* a2 = last ? nA : cA + (size_t)(t + 2) * kstep; const char* b2 = last ? nB : cB + (size_t)(t + 2) * kstep;
            const char* a3 = a2 + kstep; const char* b3 = b2 + kstep;
            if (last && has_next) S.a_ready(nxt);
            if constexpr (SP2) {
            PG8_LDB(B0, 0, 0); PG8_LDB(B1, 0, 1); PG8_SCHED; PG8_LDA(At, 0, 0); PG8_STAGE(PG8_SA(1, 1), a1 + hstep, voffA);
            PG8_WAIT_V(8); PG8_WAIT_L(0); PG8_BAR; PG8_MMA(0, 0, At, B0); PG8_MMA(0, 1, At, B1); PG8_BAR; PG8_SCHED;
            PG8_LDA(At, 0, 1); PG8_STAGE(PG8_SB(0, 0), b2, voffB); PG8_STAGE(PG8_SB(0, 1), b2 + hstep, voffB); PG8_STAGE(PG8_SA(0, 0), a2, voffA);
            PG8_WAIT_V(8); PG8_WAIT_L(0); PG8_BAR; PG8_MMA(1, 0, At, B0); PG8_MMA(1, 1, At, B1); PG8_BAR; PG8_SCHED;
            PG8_LDB(B0, 1, 0); PG8_LDB(B1, 1, 1); PG8_SCHED; PG8_LDA(At, 1, 0); PG8_STAGE(PG8_SA(0, 1), a2 + hstep, voffA);
            PG8_WAIT_V(8); PG8_WAIT_L(0); PG8_BAR; PG8_MMA(0, 0, At, B0); PG8_MMA(0, 1, At, B1); PG8_BAR; PG8_SCHED;
            PG8_LDA(At, 1, 1); PG8_STAGE(PG8_SB(1, 0), b3, voffB); PG8_STAGE(PG8_SB(1, 1), b3 + hstep, voffB); PG8_STAGE(PG8_SA(1, 0), a3, voffA);
            PG8_WAIT_V(8); PG8_WAIT_L(0); PG8_BAR; PG8_MMA(1, 0, At, B0); PG8_MMA(1, 1, At, B1); PG8_BAR; PG8_SCHED;
            } else {
            PG8_LDB(B0, 0, 0); PG8_SCHED; PG8_LDA(At, 0, 0); PG8_STAGE(PG8_SA(1, 1), a1 + hstep, voffA);
            PG8_WAIT_L(8); PG8_BAR; PG8_WAIT_L(0); PG8_MMA(0, 0, At, B0); PG8_BAR; PG8_SCHED;
            PG8_LDB(B1, 0, 1); PG8_STAGE(PG8_SB(0, 0), b2, voffB);
            PG8_BAR; PG8_WAIT_L(0); PG8_MMA(0, 1, At, B1); PG8_BAR;
            PG8_LDA(At, 0, 1); PG8_STAGE(PG8_SA(0, 0), a2, voffA);
            PG8_BAR; PG8_WAIT_L(0); PG8_MMA(1, 0, At, B0); PG8_BAR; PG8_SCHED;
            PG8_STAGE(PG8_SB(0, 1), b2 + hstep, voffB);
            PG8_WAIT_V(6); PG8_BAR; PG8_MMA(1, 1, At, B1); PG8_BAR;
            PG8_LDB(B0, 1, 0); PG8_SCHED; PG8_LDA(At, 1, 0); PG8_STAGE(PG8_SA(0, 1), a2 + hstep, voffA);
            PG8_WAIT_L(8); PG8_BAR; PG8_WAIT_L(0); PG8_MMA(0, 0, At, B0); PG8_BAR; PG8_SCHED;
            PG8_LDB(B1, 1, 1); PG8_STAGE(PG8_SB(1, 0), b3, voffB);
            PG8_BAR; PG8_WAIT_L(0); PG8_MMA(0, 1, At, B1); PG8_BAR;
            PG8_LDA(At, 1, 1); PG8_STAGE(PG8_SA(1, 0), a3, voffA);
            PG8_BAR; PG8_WAIT_L(0); PG8_MMA(1, 0, At, B0); PG8_BAR; PG8_SCHED;
            PG8_STAGE(PG8_SB(1, 1), b3 + hstep, voffB);
            PG8_WAIT_V(6); PG8_BAR; PG8_MMA(1, 1, At, B1); PG8_BAR;
            }
        }
        if constexpr (ALIGN_EPI) { if (wr == 0) PG8_BAR; }
        if constexpr (!Epi::AFTER_DRAIN) { E(acc, cur, wr, wc, fr, fq); S.done(cur); }
        if (!has_next) break;
#pragma unroll
        for (int a = 0; a < 2; ++a)
#pragma unroll
            for (int b = 0; b < 2; ++b)
#pragma unroll
                for (int m = 0; m < 4; ++m)
#pragma unroll
                    for (int n = 0; n < 2; ++n) acc[a][b][m][n] = (f32x4){0.f, 0.f, 0.f, 0.f};
        cur = nxt; cA = nA; cB = nB; ++ui;
        if constexpr (ALIGN_EPI) { if (wr == 1) PG8_BAR; }
    }
    PG8_WAIT_V(0);
    if constexpr (!ALIGN_EPI) { if (wr == 0) PG8_BAR; }
    PG8_BAR;
    if constexpr (Epi::AFTER_DRAIN) { E.fused(acc, cur, wr, wc, fr, fq, lds, wid, lane); S.done(cur); }
#undef PG8_SA
#undef PG8_SB
#undef PG8_STAGE
#undef PG8_LDA
#undef PG8_LDB
#undef PG8_MMA
#undef PG8_WAIT_V
#undef PG8_WAIT_L
#undef PG8_BAR
#undef PG8_SCHED
}
}
#define GAS __attribute__((address_space(1)))
#define LAS __attribute__((address_space(3)))
typedef unsigned short bf16;
typedef unsigned v4u __attribute__((ext_vector_type(4)));
typedef float f32x4 __attribute__((ext_vector_type(4)));
typedef short bf16x8 __attribute__((ext_vector_type(8)));
typedef GAS unsigned gu32;
typedef GAS unsigned long long gu64;
#define RLX_AGENT __ATOMIC_RELAXED, __HIP_MEMORY_SCOPE_AGENT
#define LDS_WAIT() asm volatile("s_waitcnt lgkmcnt(0)" ::: "memory")
#define VM_WAIT() asm volatile("s_waitcnt vmcnt(0)" ::: "memory")
__device__ __forceinline__ unsigned long long rt() { return __builtin_amdgcn_s_memrealtime(); }
__device__ __forceinline__ unsigned f2bf(float f) { unsigned u = __builtin_bit_cast(unsigned, f); return (u + 0x7fffu + ((u >> 16) & 1u)) >> 16; }
__device__ __forceinline__ unsigned pk2(float lo, float hi) { return f2bf(lo) | (f2bf(hi) << 16); }

#define XB_TMO      128
#define XB_XCNT(j)  (256  + 64 * (j))
#define XB_XSUB(j)  (1280 + 64 * (j))
#define XB_XGEN(j)  (2304 + 64 * (j))
#define XB_TOP      3328
#define XB_TOPGEN   3392
#define XCD_BAR_WORDS 3456
#define XB_SPIN_CAP (1u << 18)

__device__ __forceinline__ unsigned xb_ld(unsigned* p)              { return __hip_atomic_load(p, __ATOMIC_RELAXED, __HIP_MEMORY_SCOPE_AGENT); }
__device__ __forceinline__ unsigned xb_add(unsigned* p, unsigned v) { return __hip_atomic_fetch_add(p, v, __ATOMIC_RELAXED, __HIP_MEMORY_SCOPE_AGENT); }
__device__ __forceinline__ unsigned xb_xcc_id() { return (unsigned)__builtin_amdgcn_s_getreg((3 << 11) | 20) & 0xFu; }
#define XB_SPIN(cond, bar) do { unsigned _sp = 0; while (cond) { __builtin_amdgcn_s_sleep(1); \
    if ((++_sp & 255u) == 0u) { if (xb_ld(&(bar)[XB_TMO])) break; if (_sp > XB_SPIN_CAP) { atomicAdd(&(bar)[XB_TMO], 1u); break; } } } } while (0)

struct XcdBarrier {
    unsigned* bar; unsigned x;
    volatile LAS unsigned* st;
};

__device__ __forceinline__ XcdBarrier xcd_barrier_post(unsigned* bar, volatile LAS unsigned* st) {
    XcdBarrier b; b.bar = bar; b.x = xb_xcc_id(); b.st = st;
    if (threadIdx.x == 0) (void)xb_add(&bar[XB_XCNT(b.x)], 1u);
    return b;
}
__device__ __forceinline__ void xcd_barrier_complete(unsigned* bar, unsigned x, unsigned& nloc, unsigned& nx) {
    const unsigned G = gridDim.x * gridDim.y * gridDim.z;
    unsigned sum, cnt, mine, sp = 0u;
    for (;;) {
        sum = 0u; cnt = 0u; mine = 0u;
#pragma unroll
        for (unsigned j = 0; j < 16; ++j) { const unsigned c = xb_ld(&bar[XB_XCNT(j)]); sum += c; cnt += (c > 0u) ? 1u : 0u; mine = (j == x) ? c : mine; }
        if (sum == G) break;
        __builtin_amdgcn_s_sleep(1);
        if ((++sp & 255u) == 0u) { if (xb_ld(&bar[XB_TMO])) break; if (sp > XB_SPIN_CAP) { atomicAdd(&bar[XB_TMO], 1u); break; } }
    }
    nloc = mine > 0u ? mine : 1u; nx = cnt > 0u ? cnt : 1u;
}

__device__ __forceinline__ void xcd_barrier(const XcdBarrier& b) {
    asm volatile("s_waitcnt vmcnt(0)" ::: "memory");
    __syncthreads();
    if (threadIdx.x == 0) {
        unsigned* bar = b.bar;
        __builtin_amdgcn_s_waitcnt(0);
        unsigned nloc = b.st[0], nx = b.st[1];
        if (nloc == 0u) { xcd_barrier_complete(bar, b.x, nloc, nx); b.st[0] = nloc; b.st[1] = nx; }
        const unsigned old = xb_add(&bar[XB_XSUB(b.x)], 1u);
        const unsigned gen = old / nloc;
        if (old + 1u == (gen + 1u) * nloc) {
            __builtin_amdgcn_fence(__ATOMIC_RELEASE, "agent");
            asm volatile("s_waitcnt vmcnt(0)" ::: "memory");
            const unsigned og = xb_add(&bar[XB_TOP], 1u);
            const unsigned tg = og / nx;
            if (og + 1u == (tg + 1u) * nx) xb_add(&bar[XB_TOPGEN], 1u);
            else XB_SPIN(xb_ld(&bar[XB_TOPGEN]) == tg, bar);
            __builtin_amdgcn_fence(__ATOMIC_ACQUIRE, "agent");
            xb_add(&bar[XB_XGEN(b.x)], 1u);
            asm volatile("s_waitcnt vmcnt(0)" ::: "memory");
        } else {
            XB_SPIN(xb_ld(&bar[XB_XGEN(b.x)]) == gen, bar);
            __builtin_amdgcn_fence(__ATOMIC_ACQUIRE, "agent");
            asm volatile("s_waitcnt vmcnt(0)" ::: "memory");
        }
    }
    __syncthreads();
}
constexpr int NWAVES = 8;
constexpr int NP = 16384, NS = 256, NTOK = NP + NS, DM = 1024, DFF = 2816, SEQ = 4096;
constexpr float EPS = 1e-6f, LAM_INIT = 0.2f;
using pg8::OFF_YP; using pg8::OFF_CV; using pg8::OFF_SRP; using pg8::OFF_SIP; using pg8::OFF_SRS; using pg8::OFF_SIS; using pg8::OUT_TOTAL;
constexpr size_t MiB = 1u << 20;
constexpr size_t WS_CTL = 0, CTL_ZERO_BYTES = 2 * MiB;
constexpr int CW_BAR = 4096;
constexpr size_t WS_SS = 64 * 1024;
constexpr size_t WS_R0 = 2 * MiB;
constexpr size_t WS_PW1 = 2 * MiB + 128 * 1024, WS_PW16 = WS_PW1 + 32 * 1024;
constexpr size_t WS_BBAR = 2 * MiB + 256 * 1024;
constexpr size_t WS_WTRIL = 3 * MiB;
constexpr size_t WS_T = 4 * MiB, WS_E = 12 * MiB, WS_F = 16 * MiB;
constexpr size_t WS_W1 = 24 * MiB, WS_W2 = 29 * MiB, WS_W3 = 31 * MiB, WS_W4 = 42 * MiB, WS_W5 = 48 * MiB, WS_W6 = 52 * MiB, WS_W7 = 63 * MiB;
constexpr size_t WS_XB = 70 * MiB, WS_X = 104 * MiB, WS_U = 170 * MiB, WS_VR = 187 * MiB, WS_QB = 204 * MiB, WS_KB = 221 * MiB, WS_VB = 238 * MiB;
constexpr size_t WS_CB = 256 * MiB, WS_ACT = 290 * MiB, WS_PART = 380 * MiB, WS_END = 400 * MiB;
constexpr int PART_STRIDE = 32 + 16 * 128;
static_assert(WS_W7 + (size_t)1024 * 2816 * 2 <= WS_XB && WS_XB + (size_t)NTOK * 1024 * 2 <= WS_X && WS_X + (size_t)NTOK * 1024 * 4 <= WS_U && WS_VB + (size_t)NTOK * 512 * 2 <= WS_CB &&
              WS_CB + (size_t)NTOK * 1024 * 2 <= WS_ACT && WS_ACT + (size_t)NTOK * 2816 * 2 <= WS_PART && WS_PART + (size_t)32 * 4 * 16 * PART_STRIDE * 4 <= WS_END && WS_SS + 5 * (size_t)NTOK * 8 <= CTL_ZERO_BYTES, "d_ws map");
constexpr int RING_OFF = 0, SCRATCH_BYTES = 147456;
constexpr int LDSCTL_OFF = SCRATCH_BYTES, MISC_OFF = LDSCTL_OFF + 320;
constexpr int LDS_BYTES = SCRATCH_BYTES + 1024;

typedef short s16x4 __attribute__((ext_vector_type(4)));
typedef float f32x16 __attribute__((ext_vector_type(16)));
typedef float f32x2_t __attribute__((ext_vector_type(2))); typedef __bf16 bf16x2_t __attribute__((ext_vector_type(2)));
__device__ __forceinline__ unsigned cvtpk(float lo, float hi) { f32x2_t v = {lo, hi}; bf16x2_t b = __builtin_convertvector(v, bf16x2_t); return __builtin_bit_cast(unsigned, b); }
__device__ __forceinline__ float bf2f(unsigned short h) { return __uint_as_float((unsigned)h << 16); }
__device__ __forceinline__ float bflo(unsigned w) { return __uint_as_float(w << 16); }
__device__ __forceinline__ float bfhi(unsigned w) { return __uint_as_float(w & 0xffff0000u); }
__device__ __forceinline__ float ex2(float x) { return __builtin_amdgcn_exp2f(x); }
__device__ __forceinline__ float wave_sum(float v) {
#pragma unroll
    for (int o = 1; o < 64; o <<= 1) v += __shfl_xor(v, o);
    return v;
}
__device__ __forceinline__ f32x4 mfma16(bf16x8 a, bf16x8 b, f32x4 c) { return __builtin_amdgcn_mfma_f32_16x16x32_bf16(a, b, c, 0, 0, 0); }
__device__ __forceinline__ f32x16 mfma32(bf16x8 a, bf16x8 b, f32x16 c) { return __builtin_amdgcn_mfma_f32_32x32x16_bf16(a, b, c, 0, 0, 0); }
typedef short v4i16_t __attribute__((ext_vector_type(4)));
__device__ __forceinline__ bf16x8 tr_pair(const LAS unsigned char* p0, const LAS unsigned char* p1) {
    const s16x4 lo = __builtin_bit_cast(s16x4, __builtin_amdgcn_ds_read_tr16_b64_v4i16((LAS v4i16_t*)p0));
    const s16x4 hi = __builtin_bit_cast(s16x4, __builtin_amdgcn_ds_read_tr16_b64_v4i16((LAS v4i16_t*)p1));
    return (bf16x8){lo[0], lo[1], lo[2], lo[3], hi[0], hi[1], hi[2], hi[3]};
}
__device__ __forceinline__ bf16x8 pack_bf8(const f32x4 a, const f32x4 b) { v4u w; w.x = cvtpk(a[0], a[1]); w.y = cvtpk(a[2], a[3]); w.z = cvtpk(b[0], b[1]); w.w = cvtpk(b[2], b[3]); return __builtin_bit_cast(bf16x8, w); }
using pg8::ss_rinv; using pg8::gelu_t;

struct Frame {
    LAS unsigned char* lds;
    volatile LAS unsigned* MISC;
    gu32* ctl;
    int tid, lane, wave, vcu, G;
    const float* const* in; float* out; unsigned char* ws;
};
enum { I_XP = 0, I_XS, I_CK, I_CV, I_PT, I_SRE, I_SIM, I_NMIX, I_NFFN, I_NFIN, I_WIN, I_WOUT, I_SGN, I_SGW, I_SGB, I_LQ1, I_LK1, I_LQ2, I_LK2, I_SUBLN,
       I_ARE, I_AIM, I_LDT, I_BRE, I_BIM, I_CRE, I_CIM, I_SD, I_WGLU, I_BGLU, I_WFI, I_WFO };

__device__ __forceinline__ int map_row(int n0, int NH) { if (NH == 0) return n0; const int hi = n0 >= NH ? 1 : 0, n2 = n0 - hi * NH; return 256 * (n2 >> 7) + 128 * hi + (n2 & 127); }
__device__ __forceinline__ void p0_transpose_item(const float* W, int K, int N, bf16* WT, int NH, const float* gain, LAS float* scr, int item, int lane) {
    const int nblk = N / 32, kb = item / nblk, nb = item % nblk, k0 = 64 * kb, n0 = 32 * nb;
#pragma unroll 8
    for (int i = 0; i < 32; ++i) { const int kk = 2 * i + (lane >> 5); float w = W[(size_t)(k0 + kk) * N + n0 + (lane & 31)]; if (gain) w *= gain[k0 + kk]; scr[kk * 33 + (lane & 31)] = w; }
    LDS_WAIT(); asm volatile("" ::: "memory");
    const int c = lane & 7, r0 = map_row(n0, NH);
#pragma unroll
    for (int j = 0; j < 4; ++j) { const int n = (lane >> 3) + 8 * j; const LAS float* s = scr + (8 * c) * 33 + n;
        v4u o; o.x = pk2(s[0 * 33], s[1 * 33]); o.y = pk2(s[2 * 33], s[3 * 33]); o.z = pk2(s[4 * 33], s[5 * 33]); o.w = pk2(s[6 * 33], s[7 * 33]);
        *(GAS v4u*)(WT + (size_t)(r0 + n) * K + k0 + 8 * c) = o; }
    LDS_WAIT(); asm volatile("" ::: "memory");
}
__device__ __forceinline__ void p0_row(Frame& F, const float* xrow, bf16* orow, float* r) {
    const GAS f32x4* xr = (const GAS f32x4*)xrow + F.lane;
    f32x4 v[4]; float s = 0.f;
#pragma unroll
    for (int j = 0; j < 4; ++j) { v[j] = xr[64 * j]; s += (v[j].x * v[j].x + v[j].y * v[j].y) + (v[j].z * v[j].z + v[j].w * v[j].w); }
    s = wave_sum(s);
    GAS unsigned long long* o8 = (GAS unsigned long long*)orow + F.lane;
#pragma unroll
    for (int j = 0; j < 4; ++j) o8[64 * j] = (unsigned long long)pk2(v[j].x, v[j].y) | ((unsigned long long)pk2(v[j].z, v[j].w) << 32);
    if (F.lane == 0) *r = 1.0f / sqrtf(s * (1.0f / 1024.0f) + EPS);
}
__device__ __forceinline__ void p0_ssm_tables(Frame& F, int g, int q) {
    LAS f32x2_t* pw = (LAS f32x2_t*)(F.lds);
    LAS f32x2_t* cb = pw + 17 * 64;
    LAS f32x2_t* cc = cb + 64 * 16;
    LAS float* KJ = (LAS float*)(cc + 16 * 64);
    LAS f32x2_t* cf = (LAS f32x2_t*)(KJ + 4096);
    const int tid = F.tid;
    const float* a_re = F.in[I_ARE] + g * 64; const float* a_im = F.in[I_AIM] + g * 64;
    const float dt = expf(F.in[I_LDT][g]);
    if (tid < 64) {
        const int p = tid; const float ar = a_re[p], ai = a_im[p], xr = ar * dt, xi = ai * dt;
#pragma unroll 1
        for (int j = 0; j <= 16; ++j) { const float mag = expf((float)j * xr), ang = (float)j * xi; pw[j * 64 + p] = (f32x2_t){mag * cosf(ang), mag * sinf(ang)}; }
        const float sh = sinf(0.5f * xi), nr = expm1f(xr) * cosf(xi) - 2.0f * sh * sh, ni = expf(xr) * sinf(xi), den = 1.0f / (ar * ar + ai * ai);
        cf[p] = (f32x2_t){(nr * ar + ni * ai) * den, (ni * ar - nr * ai) * den};
    }
    __syncthreads();
    const float* b_re = F.in[I_BRE] + (size_t)g * 1024; const float* b_im = F.in[I_BIM] + (size_t)g * 1024;
    const float* c_re = F.in[I_CRE] + (size_t)g * 1024; const float* c_im = F.in[I_CIM] + (size_t)g * 1024;
    for (int i = tid; i < 1024; i += 512) {
        const int p = i >> 4; const f32x2_t c = cf[p]; const float br = b_re[i], bi = b_im[i];
        cb[i] = (f32x2_t){c.x * br - c.y * bi, c.x * bi + c.y * br};
        cc[i] = (f32x2_t){c_re[i], c_im[i]};
    }
    __syncthreads();
    const float* dsk = F.in[I_SD] + g * 16;
#pragma unroll 1
    for (int o = tid; o < 4096; o += 512) {
        const int j = o >> 8, c = (o >> 4) & 15, c2 = o & 15; float s = 0.f;
#pragma unroll 4
        for (int p = 0; p < 64; ++p) { const f32x2_t a = pw[j * 64 + p], b = cb[p * 16 + c2], cv = cc[c * 64 + p];
            const float wr_ = a.x * b.x - a.y * b.y, wi_ = a.x * b.y + a.y * b.x; s += cv.x * wr_ - cv.y * wi_; }
        if (j == 0 && c == c2) s += dsk[c];
        KJ[o] = s;
    }
    __syncthreads();
    const float* g1 = F.in[I_NMIX] + 1024 + g * 16;
    bf16* Tg = (bf16*)(F.ws + WS_T) + (size_t)g * 65536; bf16* Eg = (bf16*)(F.ws + WS_E) + (size_t)g * 32768; bf16* Fg = (bf16*)(F.ws + WS_F) + (size_t)g * 32768;
#pragma unroll 1
    for (int i = 0; i < 4; ++i) { const int idx = tid + 512 * i, row = 64 * q + (idx >> 5), kc = idx & 31, t = row >> 4, c = row & 15, tau = kc >> 1, c0 = 8 * (kc & 1);
        float v[8];
#pragma unroll
        for (int e = 0; e < 8; ++e) v[e] = (t >= tau) ? KJ[((t - tau) * 16 + c) * 16 + c0 + e] * g1[c0 + e] : 0.f;
        v4u o; o.x = pk2(v[0], v[1]); o.y = pk2(v[2], v[3]); o.z = pk2(v[4], v[5]); o.w = pk2(v[6], v[7]);
        *(GAS v4u*)(Tg + (size_t)row * 256 + kc * 8) = o; }
#pragma unroll 1
    for (int i = 0; i < 2; ++i) { const int idx = tid + 512 * i, row = 32 * q + (idx >> 5), kc = idx & 31, ri = row >> 6, p = row & 63, tau = kc >> 1, c0 = 8 * (kc & 1);
        const f32x2_t a = pw[(15 - tau) * 64 + p]; float v[8];
#pragma unroll
        for (int e = 0; e < 8; ++e) { const f32x2_t b = cb[p * 16 + c0 + e]; const float zr = a.x * b.x - a.y * b.y, zi = a.x * b.y + a.y * b.x; v[e] = (ri ? zi : zr) * g1[c0 + e]; }
        v4u o; o.x = pk2(v[0], v[1]); o.y = pk2(v[2], v[3]); o.z = pk2(v[4], v[5]); o.w = pk2(v[6], v[7]);
        *(GAS v4u*)(Eg + (size_t)row * 256 + kc * 8) = o; }
#pragma unroll 1
    for (int i = 0; i < 2; ++i) { const int idx = tid + 512 * i, row = 64 * q + (idx >> 4), kc = idx & 15, t = row >> 4, c = row & 15, ri = kc >> 3, p0 = 8 * (kc & 7);
        float v[8];
#pragma unroll
        for (int e = 0; e < 8; ++e) { const f32x2_t a = pw[(t + 1) * 64 + p0 + e], cv = cc[c * 64 + p0 + e]; const float zr = cv.x * a.x - cv.y * a.y, zi = cv.x * a.y + cv.y * a.x; v[e] = ri ? -zi : zr; }
        v4u o; o.x = pk2(v[0], v[1]); o.y = pk2(v[2], v[3]); o.z = pk2(v[4], v[5]); o.w = pk2(v[6], v[7]);
        *(GAS v4u*)(Fg + (size_t)row * 128 + kc * 8) = o; }
    if (q == 0) {
        f32x2_t* PW1 = (f32x2_t*)(F.ws + WS_PW1) + g * 64; f32x2_t* PW16 = (f32x2_t*)(F.ws + WS_PW16) + g * 64; f32x2_t* BB = (f32x2_t*)(F.ws + WS_BBAR) + (size_t)g * 1024;
        if (tid < 64) { PW1[tid] = pw[64 + tid]; PW16[tid] = pw[16 * 64 + tid]; }
        for (int i = tid; i < 1024; i += 512) BB[i] = cb[i];
    }
    __syncthreads();
}
__device__ __forceinline__ void p0_prologue(Frame& F) {
    const int gw = F.vcu * NWAVES + F.wave, NGW = F.G * NWAVES;
    for (int u = F.vcu; u < 256; u += F.G) p0_ssm_tables(F, u >> 2, u & 3);
    LAS float* scr = (LAS float*)(F.lds + RING_OFF + F.wave * 16384);
    constexpr int I1 = 16 * (2560 / 32), I2 = 16 * (1024 / 32), I5 = 16 * (2048 / 32), I3 = 16 * (5632 / 32), I4 = 44 * (1024 / 32);
    constexpr int NITEMS = I1 + I2 + I5 + 2 * I3 + 2 * I4;
    for (int it = gw; it < NITEMS; it += NGW) {
        int r = it;
        if (r < I1) { p0_transpose_item(F.in[I_WIN], 1024, 2560, (bf16*)(F.ws + WS_W1), 0, F.in[I_NMIX], scr, r, F.lane); continue; } r -= I1;
        if (r < I2) { p0_transpose_item(F.in[I_WOUT], 1024, 1024, (bf16*)(F.ws + WS_W2), 0, nullptr, scr, r, F.lane); continue; } r -= I2;
        if (r < I5) { p0_transpose_item(F.in[I_WGLU], 1024, 2048, (bf16*)(F.ws + WS_W5), 1024, nullptr, scr, r, F.lane); continue; } r -= I5;
        if (r < I3) { p0_transpose_item(F.in[I_WFI], 1024, 5632, (bf16*)(F.ws + WS_W3), 2816, F.in[I_NFFN], scr, r, F.lane); continue; } r -= I3;
        if (r < I3) { p0_transpose_item(F.in[I_WFI] + (size_t)1024 * 5632, 1024, 5632, (bf16*)(F.ws + WS_W6), 2816, F.in[I_NFFN] + 1024, scr, r, F.lane); continue; } r -= I3;
        if (r < I4) { p0_transpose_item(F.in[I_WFO], 2816, 1024, (bf16*)(F.ws + WS_W4), 0, nullptr, scr, r, F.lane); continue; } r -= I4;
        p0_transpose_item(F.in[I_WFO] + (size_t)2816 * 1024, 2816, 1024, (bf16*)(F.ws + WS_W7), 0, nullptr, scr, r, F.lane);
    }
    bf16* XB = (bf16*)(F.ws + WS_XB); float* R0 = (float*)(F.ws + WS_R0);
    for (int m = gw; m < NTOK; m += NGW) p0_row(F, m < NP ? F.in[I_XP] + (size_t)m * 1024 : F.in[I_XS] + (size_t)(m - NP) * 1024, XB + (size_t)m * 1024, R0 + m);
    bf16* WT = (bf16*)(F.ws + WS_WTRIL); const float* sw = F.in[I_SGW];
    for (int i = gw * 64 + F.lane; i < 8192; i += NGW * 64) { const int e0 = i * 8, t = (e0 >> 7) & 127, s0 = e0 & 127; float v[8];
#pragma unroll
        for (int e = 0; e < 8; ++e) v[e] = (s0 + e <= t) ? sw[e0 + e] : 0.f;
        v4u o; o.x = pk2(v[0], v[1]); o.y = pk2(v[2], v[3]); o.z = pk2(v[4], v[5]); o.w = pk2(v[6], v[7]); *(GAS v4u*)(WT + e0) = o; }
}
__device__ __forceinline__ float lambda_val(Frame& F) {
    const int l = F.lane; const float a = wave_sum(F.in[I_LQ1][l] * F.in[I_LK1][l]), b = wave_sum(F.in[I_LQ2][l] * F.in[I_LK2][l]);
    return expf(a) - expf(b) + LAM_INIT;
}
#define LAUNDER_TID() int tid = F.tid; asm volatile("" : "+v"(tid)); const int lane = tid & 63, wave = __builtin_amdgcn_readfirstlane(tid >> 6); (void)lane; (void)wave
__device__ __forceinline__ void sgu_prompt_unit(Frame& F, int chunk, int g) {
    LAUNDER_TID();
    const bf16* U = (const bf16*)(F.ws + WS_U); const bf16* VR = (const bf16*)(F.ws + WS_VR); bf16* CB = (bf16*)(F.ws + WS_CB);
    const unsigned long long* vss = (const unsigned long long*)(F.ws + WS_SS);
    const bf16* WT = (const bf16*)(F.ws + WS_WTRIL) + (size_t)g * 16384;
    const float* gn = F.in[I_SGN] + g * 128; const float* bias = F.in[I_SGB] + g * 128;
    LAS unsigned short* vT = (LAS unsigned short*)F.lds;
    const size_t tok0 = (size_t)chunk * 128;
    {
        const int s = tid >> 2, c0 = 32 * (tid & 3); const float rv = ss_rinv(vss + tok0 + s, 1.0f / 512.0f);
        const v4u* src = (const v4u*)(VR + (tok0 + s) * 512 + g * 128 + c0);
#pragma unroll
        for (int i = 0; i < 4; ++i) { const v4u w = src[i]; const unsigned ww[4] = {w.x, w.y, w.z, w.w};
#pragma unroll
            for (int e = 0; e < 4; ++e) { const int c = c0 + 8 * i + 2 * e; const float a = bflo(ww[e]) * rv * gn[c], b = bfhi(ww[e]) * rv * gn[c + 1];
                vT[c * 136 + s] = (unsigned short)f2bf(a); vT[(c + 1) * 136 + s] = (unsigned short)f2bf(b); } }
    }
    __syncthreads();
    const int mb = wave & 3, nh = wave >> 2, r32 = lane & 31, hi = lane >> 5;
    f32x16 acc[2]; acc[0] = (f32x16){}; acc[1] = (f32x16){};
    for (int ks = 0; ks < 2 * mb + 2; ++ks) {
        const bf16x8 a = *(const bf16x8*)(WT + (32 * mb + r32) * 128 + 16 * ks + 8 * hi);
#pragma unroll
        for (int j = 0; j < 2; ++j) { const bf16x8 b = *(const LAS bf16x8*)((const LAS unsigned char*)vT + ((64 * nh + 32 * j + r32) * 136 + 16 * ks + 8 * hi) * 2); acc[j] = mfma32(a, b, acc[j]); }
    }
#pragma unroll
    for (int j = 0; j < 2; ++j) { const int d = g * 128 + 64 * nh + 32 * j + r32;
#pragma unroll
        for (int r = 0; r < 16; ++r) { const int t = 32 * mb + (r & 3) + 8 * (r >> 2) + 4 * hi; const size_t o = (tok0 + t) * 512 + d;
            const float val = bf2f(U[o]) * (acc[j][r] + bias[t]); CB[(tok0 + t) * 1024 + d] = (bf16)f2bf(val); } }
    __syncthreads();
}
__device__ __forceinline__ void sgu_sample_unit(Frame& F, int b) {
    LAUNDER_TID(); const int c = tid, g = c >> 7; const bf16* U = (const bf16*)(F.ws + WS_U); const bf16* VR = (const bf16*)(F.ws + WS_VR); bf16* CB = (bf16*)(F.ws + WS_CB);
    const unsigned long long* vss = (const unsigned long long*)(F.ws + WS_SS);
    const float gn = F.in[I_SGN][c]; const float* W = F.in[I_SGW] + (size_t)g * 16384; const float* bias = F.in[I_SGB] + g * 128;
    float v[8];
#pragma unroll
    for (int t = 0; t < 8; ++t) { const size_t tok = NP + 8 * b + t; v[t] = bf2f(VR[tok * 512 + c]) * ss_rinv(vss + tok, 1.0f / 512.0f) * gn; F.out[OFF_CV + (size_t)(8 * b + t) * 512 + c] = v[t]; }
#pragma unroll
    for (int t = 0; t < 8; ++t) { float s = bias[t];
#pragma unroll
        for (int k = 0; k <= t; ++k) s += W[t * 128 + k] * v[k];
        const size_t tok = NP + 8 * b + t; CB[tok * 1024 + c] = (bf16)f2bf(bf2f(U[tok * 512 + c]) * s); }
}

struct Soft16 { float m, l; };
__device__ __forceinline__ void smax_update(f32x4 (&s)[4], Soft16& st, f32x4 (&O)[8], bf16x8& pf0, bf16x8& pf1) {
    float mx = fmaxf(fmaxf(s[0][0], s[0][1]), fmaxf(s[0][2], s[0][3]));
#pragma unroll
    for (int i = 1; i < 4; ++i) mx = fmaxf(mx, fmaxf(fmaxf(s[i][0], s[i][1]), fmaxf(s[i][2], s[i][3])));
    mx = fmaxf(mx, __shfl_xor(mx, 16)); mx = fmaxf(mx, __shfl_xor(mx, 32));
    const float mn = fmaxf(st.m, mx), al = ex2(st.m - mn); st.m = mn; float sum = 0.f;
#pragma unroll
    for (int i = 0; i < 4; ++i)
#pragma unroll
        for (int r = 0; r < 4; ++r) { s[i][r] = ex2(s[i][r] - mn); sum += s[i][r]; }
    st.l = st.l * al + sum;
#pragma unroll
    for (int nb = 0; nb < 8; ++nb) O[nb] = O[nb] * al;
    pf0 = pack_bf8(s[0], s[1]); pf1 = pack_bf8(s[2], s[3]);
}
__device__ __forceinline__ void attn_prompt_unit(Frame& F, float lam, int b, int h, int qb) {
    LAUNDER_TID(); const int g = lane >> 4, li = lane & 15;
    const bf16* QB = (const bf16*)(F.ws + WS_QB); const bf16* KB = (const bf16*)(F.ws + WS_KB); const bf16* VB = (const bf16*)(F.ws + WS_VB); bf16* CB = (bf16*)(F.ws + WS_CB);
    const size_t rowbase = (size_t)b * SEQ; const int qrel = 16 * wave + li; const size_t qtok = rowbase + 128 * qb + qrel;
    bf16x8 qf[4];
#pragma unroll
    for (int s = 0; s < 4; ++s) qf[s] = *(const bf16x8*)(QB + qtok * 512 + h * 128 + 32 * s + 8 * g);
    const int nt = 2 * qb + 2;
    const int skey = tid >> 4, sch = tid & 15;
    const bf16* kg = KB + (rowbase + skey) * 512 + h * 128 + 8 * sch; const bf16* vg = VB + (rowbase + skey) * 512 + h * 128 + 8 * sch;
    const int kw0 = skey * 256 + ((sch ^ (skey & 15)) << 4), vw0 = skey * 256 + (((sch >> 1) ^ (skey & 7)) << 5) + (sch & 1) * 16;
    LAS unsigned char* L = F.lds;
    int kad[4];
#pragma unroll
    for (int s = 0; s < 4; ++s) kad[s] = li * 256 + (((4 * s + g) ^ li) << 4);
    const int vq = li >> 2, vp = li & 3, vk7 = (4 * g + vq) & 7; int vad[8];
#pragma unroll
    for (int nb = 0; nb < 8; ++nb) vad[nb] = (4 * g + vq) * 256 + ((nb ^ vk7) << 5) + 8 * vp;
    f32x4 O1[8], O2[8]; Soft16 st1{-1e30f, 0.f}, st2{-1e30f, 0.f};
#pragma unroll
    for (int nb = 0; nb < 8; ++nb) { O1[nb] = (f32x4){0.f, 0.f, 0.f, 0.f}; O2[nb] = (f32x4){0.f, 0.f, 0.f, 0.f}; }
    v4u kr0, kr1, vr0, vr1;
    kr0 = *(const v4u*)kg; kr1 = *(const v4u*)(kg + 32 * 512); vr0 = *(const v4u*)vg; vr1 = *(const v4u*)(vg + 32 * 512);
    *(LAS v4u*)(L + kw0) = kr0; *(LAS v4u*)(L + kw0 + 32 * 256) = kr1; *(LAS v4u*)(L + 16384 + vw0) = vr0; *(LAS v4u*)(L + 16384 + vw0 + 32 * 256) = vr1;
    __syncthreads();
    for (int t = 0; t < nt; ++t) {
        const int bo = (t & 1) * 32768;
        if (t + 1 < nt) { const size_t go = (size_t)(t + 1) * 64 * 512; kr0 = *(const v4u*)(kg + go); kr1 = *(const v4u*)(kg + go + 32 * 512); vr0 = *(const v4u*)(vg + go); vr1 = *(const v4u*)(vg + go + 32 * 512); }
        if (!(t == nt - 1 && wave < 4)) {
            const LAS unsigned char* Kt = L + bo; const LAS unsigned char* Vt = L + bo + 16384;
            f32x4 s1[4], s2[4];
#pragma unroll
            for (int sub = 0; sub < 4; ++sub) {
                const bf16x8 k0 = *(const LAS bf16x8*)(Kt + sub * 4096 + kad[0]), k1 = *(const LAS bf16x8*)(Kt + sub * 4096 + kad[1]);
                const bf16x8 k2 = *(const LAS bf16x8*)(Kt + sub * 4096 + kad[2]), k3 = *(const LAS bf16x8*)(Kt + sub * 4096 + kad[3]);
                s1[sub] = mfma16(k0, qf[0], (f32x4){0.f, 0.f, 0.f, 0.f}); s1[sub] = mfma16(k1, qf[1], s1[sub]);
                s2[sub] = mfma16(k2, qf[2], (f32x4){0.f, 0.f, 0.f, 0.f}); s2[sub] = mfma16(k3, qf[3], s2[sub]);
            }
            if (t >= nt - 2) {
                const int kb0 = 64 * (t - 2 * qb) + 4 * g;
#pragma unroll
                for (int sub = 0; sub < 4; ++sub)
#pragma unroll
                    for (int r = 0; r < 4; ++r) if (kb0 + 16 * sub + r > qrel) { s1[sub][r] = -__builtin_inff(); s2[sub][r] = -__builtin_inff(); }
            }
            bf16x8 p1a, p1b, p2a, p2b;
            smax_update(s1, st1, O1, p1a, p1b); smax_update(s2, st2, O2, p2a, p2b);
#pragma unroll
            for (int nb = 0; nb < 8; ++nb) {
                const bf16x8 va = tr_pair(Vt + vad[nb], Vt + vad[nb] + 16 * 256), vb = tr_pair(Vt + vad[nb] + 32 * 256, Vt + vad[nb] + 48 * 256);
                O1[nb] = mfma16(va, p1a, O1[nb]); O2[nb] = mfma16(va, p2a, O2[nb]);
                O1[nb] = mfma16(vb, p1b, O1[nb]); O2[nb] = mfma16(vb, p2b, O2[nb]);
            }
        }
        if (t + 1 < nt) { const int wo = ((t + 1) & 1) * 32768; *(LAS v4u*)(L + wo + kw0) = kr0; *(LAS v4u*)(L + wo + kw0 + 32 * 256) = kr1; *(LAS v4u*)(L + wo + 16384 + vw0) = vr0; *(LAS v4u*)(L + wo + 16384 + vw0 + 32 * 256) = vr1; }
        __syncthreads();
    }
    float l1 = st1.l; l1 += __shfl_xor(l1, 16); l1 += __shfl_xor(l1, 32);
    float l2 = st2.l; l2 += __shfl_xor(l2, 16); l2 += __shfl_xor(l2, 32);
    const float i1 = 1.0f / l1, i2 = lam / l2; float ssq = 0.f;
#pragma unroll
    for (int nb = 0; nb < 8; ++nb)
#pragma unroll
        for (int r = 0; r < 4; ++r) { const float o = O1[nb][r] * i1 - O2[nb][r] * i2; O1[nb][r] = o; ssq += o * o; }
    ssq += __shfl_xor(ssq, 16); ssq += __shfl_xor(ssq, 32);
    const float rn = (1.0f - LAM_INIT) / sqrtf(ssq * (1.0f / 128.0f) + EPS);
    const float* sub = F.in[I_SUBLN];
#pragma unroll
    for (int nb = 0; nb < 8; ++nb) { const int dv = 16 * nb + 4 * g; const f32x4 sg = *(const f32x4*)(sub + dv);
        const unsigned w0 = cvtpk(O1[nb][0] * rn * sg[0], O1[nb][1] * rn * sg[1]), w1 = cvtpk(O1[nb][2] * rn * sg[2], O1[nb][3] * rn * sg[3]);
        *(unsigned long long*)(CB + qtok * 1024 + 512 + h * 128 + dv) = (unsigned long long)w0 | ((unsigned long long)w1 << 32); }
}

__device__ __forceinline__ void attn_sample_unit(Frame& F, int b, int rg) {
    LAUNDER_TID(); const int g = lane >> 4, li = lane & 15, head = wave & 3, hf = wave >> 2;
    const bf16* QB = (const bf16*)(F.ws + WS_QB); const float* CK = F.in[I_CK]; const float* CV = F.in[I_CV]; const int* PT = (const int*)F.in[I_PT] + b * 64 + 8 * rg + 4 * hf;
    bf16x8 qf[4];
    { const int qi = li & 7, half = li >> 3; const bf16* qrow = QB + (size_t)(NP + 8 * b + qi) * 512 + head * 128;
#pragma unroll
      for (int s = 0; s < 4; ++s) { bf16x8 z = (bf16x8){0, 0, 0, 0, 0, 0, 0, 0}; if ((s >> 1) == half) z = *(const bf16x8*)(qrow + 32 * s + 8 * g); qf[s] = z; } }
    LAS unsigned char* Kt = F.lds + wave * 16384; LAS unsigned char* Vt = Kt + 8192;
    const int l31 = lane & 31, lh = lane >> 5;
    const int kwr = ((l31 >> 1) << 4) + (l31 & 1) * 8;
    const int vwu = l31 >> 2, vwo = (l31 & 3) * 8;
    int kad[4];
#pragma unroll
    for (int s = 0; s < 4; ++s) kad[s] = li * 256 + (((4 * s + g) ^ li) << 4);
    const int vq = li >> 2, vp = li & 3, vk7 = (4 * g + vq) & 7; int vad[8];
#pragma unroll
    for (int nb = 0; nb < 8; ++nb) vad[nb] = (4 * g + vq) * 256 + ((nb ^ vk7) << 5) + 8 * vp;
    f32x4 O[8]; Soft16 st{-1e30f, 0.f};
#pragma unroll
    for (int nb = 0; nb < 8; ++nb) O[nb] = (f32x4){0.f, 0.f, 0.f, 0.f};
    f32x4 kr[16], vr[16];
#define SLOAD(t) do { const int phys_ = __builtin_amdgcn_readfirstlane(PT[(t) >> 2]); const size_t e0_ = (((size_t)phys_ * 128 + 32 * ((t) & 3) + lh) * 4 + head) * 128 + 4 * l31; \
        _Pragma("unroll") for (int i_ = 0; i_ < 16; ++i_) { kr[i_] = __builtin_nontemporal_load((const f32x4*)(CK + e0_ + (size_t)i_ * 1024)); vr[i_] = __builtin_nontemporal_load((const f32x4*)(CV + e0_ + (size_t)i_ * 1024)); } } while (0)
    SLOAD(0);
#pragma unroll 1
    for (int t = 0; t < 16; ++t) {
#pragma unroll
        for (int i = 0; i < 16; ++i) { const int key = 2 * i + lh;
            *(LAS unsigned long long*)(Kt + key * 256 + (kwr ^ ((key & 15) << 4))) = (unsigned long long)cvtpk(kr[i][0], kr[i][1]) | ((unsigned long long)cvtpk(kr[i][2], kr[i][3]) << 32);
            *(LAS unsigned long long*)(Vt + key * 256 + ((vwu ^ (key & 7)) << 5) + vwo) = (unsigned long long)cvtpk(vr[i][0], vr[i][1]) | ((unsigned long long)cvtpk(vr[i][2], vr[i][3]) << 32); }
        if (t + 1 < 16) SLOAD(t + 1);
        f32x4 s[2];
#pragma unroll
        for (int sub = 0; sub < 2; ++sub) {
            s[sub] = (f32x4){0.f, 0.f, 0.f, 0.f};
#pragma unroll
            for (int ks = 0; ks < 4; ++ks) s[sub] = mfma16(*(const LAS bf16x8*)(Kt + sub * 4096 + kad[ks]), qf[ks], s[sub]);
        }
        float mx = fmaxf(fmaxf(fmaxf(s[0][0], s[0][1]), fmaxf(s[0][2], s[0][3])), fmaxf(fmaxf(s[1][0], s[1][1]), fmaxf(s[1][2], s[1][3])));
        mx = fmaxf(mx, __shfl_xor(mx, 16)); mx = fmaxf(mx, __shfl_xor(mx, 32));
        const float mn = fmaxf(st.m, mx), al = ex2(st.m - mn); st.m = mn; float sum = 0.f;
#pragma unroll
        for (int i = 0; i < 2; ++i)
#pragma unroll
            for (int r = 0; r < 4; ++r) { s[i][r] = ex2(s[i][r] - mn); sum += s[i][r]; }
        st.l = st.l * al + sum;
        const bf16x8 pf = pack_bf8(s[0], s[1]);
#pragma unroll
        for (int nb = 0; nb < 8; ++nb) { const bf16x8 va = tr_pair(Vt + vad[nb], Vt + vad[nb] + 16 * 256); O[nb] = mfma16(va, pf, O[nb] * al); }
    }
#undef SLOAD
    float l = st.l; l += __shfl_xor(l, 16); l += __shfl_xor(l, 32);
    float* P = (float*)(F.ws + WS_PART) + ((size_t)(b * 4 + head) * 16 + 2 * rg + hf) * PART_STRIDE;
    if (g == 0) { P[li] = st.m; P[16 + li] = l; }
#pragma unroll
    for (int nb = 0; nb < 8; ++nb) *(f32x4*)(P + 32 + li * 128 + 16 * nb + 4 * g) = O[nb];
}
__device__ __forceinline__ void attn_sample_combine(Frame& F, float lam, int b, int head) {
    LAUNDER_TID(); const int qp = tid >> 5, dvc = tid & 31, qi = qp & 7, half = qp >> 3, dv = 4 * dvc;
    const bf16* QB = (const bf16*)(F.ws + WS_QB); const bf16* KB = (const bf16*)(F.ws + WS_KB); const bf16* VB = (const bf16*)(F.ws + WS_VB); bf16* CB = (bf16*)(F.ws + WS_CB);
    const float* P = (const float*)(F.ws + WS_PART) + (size_t)(b * 4 + head) * 16 * PART_STRIDE;
    float M = -1e30f;
    for (int sl = 0; sl < 16; ++sl) M = fmaxf(M, P[sl * PART_STRIDE + qp]);
    const size_t tq = NP + 8 * b + qi; const bf16* qrow = QB + tq * 512 + head * 128 + 64 * half;
    float sc[8];
#pragma unroll
    for (int j = 0; j < 8; ++j) { const bf16* krow = KB + (size_t)(NP + 8 * b + j) * 512 + head * 128 + 64 * half; float d = 0.f;
#pragma unroll 2
        for (int e = 0; e < 8; ++e) { const v4u a = *(const v4u*)(qrow + 8 * e), k = *(const v4u*)(krow + 8 * e);
            d += (bflo(a.x) * bflo(k.x) + bfhi(a.x) * bfhi(k.x)) + (bflo(a.y) * bflo(k.y) + bfhi(a.y) * bfhi(k.y)) + (bflo(a.z) * bflo(k.z) + bfhi(a.z) * bfhi(k.z)) + (bflo(a.w) * bflo(k.w) + bfhi(a.w) * bfhi(k.w)); }
        sc[j] = (j <= qi) ? d : -__builtin_inff(); M = fmaxf(M, sc[j]); }
    float Lacc = 0.f; f32x4 Oa = (f32x4){0.f, 0.f, 0.f, 0.f};
    for (int sl = 0; sl < 16; ++sl) { const float w = ex2(P[sl * PART_STRIDE + qp] - M); Lacc += w * P[sl * PART_STRIDE + 16 + qp]; Oa = Oa + *(const f32x4*)(P + sl * PART_STRIDE + 32 + qp * 128 + dv) * w; }
#pragma unroll
    for (int j = 0; j < 8; ++j) { const float p = ex2(sc[j] - M); Lacc += p; const float pb = bf2f((unsigned short)f2bf(p));
        const bf16* vrow = VB + (size_t)(NP + 8 * b + j) * 512 + head * 128 + dv;
        Oa[0] += pb * bf2f(vrow[0]); Oa[1] += pb * bf2f(vrow[1]); Oa[2] += pb * bf2f(vrow[2]); Oa[3] += pb * bf2f(vrow[3]); }
    LAS float* buf = (LAS float*)F.lds;
    const float inv = 1.0f / Lacc;
    *(LAS f32x4*)(buf + (half * 8 + qi) * 128 + dv) = Oa * inv;
    __syncthreads();
    if (half == 0) {
        const f32x4 a = *(const LAS f32x4*)(buf + qi * 128 + dv), c = *(const LAS f32x4*)(buf + (8 + qi) * 128 + dv); const f32x4 o = a - c * lam;
        float ssq = (o[0] * o[0] + o[1] * o[1]) + (o[2] * o[2] + o[3] * o[3]);
#pragma unroll
        for (int x = 1; x < 32; x <<= 1) ssq += __shfl_xor(ssq, x);
        const float rn = (1.0f - LAM_INIT) / sqrtf(ssq * (1.0f / 128.0f) + EPS); const f32x4 sg = *(const f32x4*)(F.in[I_SUBLN] + dv);
        const unsigned w0 = cvtpk(o[0] * rn * sg[0], o[1] * rn * sg[1]), w1 = cvtpk(o[2] * rn * sg[2], o[3] * rn * sg[3]);
        *(unsigned long long*)(CB + tq * 1024 + 512 + head * 128 + dv) = (unsigned long long)w0 | ((unsigned long long)w1 << 32);
    }
    __syncthreads();
}

__device__ __forceinline__ void ssm_prompt_unit(Frame& F, int b, int g) {
    LAUNDER_TID(); const int n = lane & 31, hi = lane >> 5, chunk = 32 * wave + n;
    const bf16* XB = (const bf16*)(F.ws + WS_XB); bf16* G = (bf16*)(F.ws + WS_CB);
    const unsigned long long* ss2 = (const unsigned long long*)(F.ws + WS_SS) + 2 * (size_t)NTOK;
    const bf16* Tg = (const bf16*)(F.ws + WS_T) + (size_t)g * 65536; const bf16* Eg = (const bf16*)(F.ws + WS_E) + (size_t)g * 32768; const bf16* Fg = (const bf16*)(F.ws + WS_F) + (size_t)g * 32768;
    LAS float* S = (LAS float*)F.lds;
    const size_t tok0 = (size_t)b * SEQ + 16 * chunk;
    bf16x8 uf[16];
#pragma unroll
    for (int ks = 0; ks < 16; ++ks) { const size_t tok = tok0 + ks; const v4u w = *(const v4u*)(XB + tok * 1024 + 16 * g + 8 * hi); const float r = ss_rinv(ss2 + tok, 1.0f / 1024.0f);
        v4u o; o.x = cvtpk(bflo(w.x) * r, bfhi(w.x) * r); o.y = cvtpk(bflo(w.y) * r, bfhi(w.y) * r); o.z = cvtpk(bflo(w.z) * r, bfhi(w.z) * r); o.w = cvtpk(bflo(w.w) * r, bfhi(w.w) * r);
        uf[ks] = __builtin_bit_cast(bf16x8, o); }
#pragma unroll 1
    for (int mb = 0; mb < 4; ++mb) {
        f32x16 acc = (f32x16){};
#pragma unroll
        for (int ks = 0; ks < 16; ++ks) acc = mfma32(*(const bf16x8*)(Eg + (32 * mb + n) * 256 + 16 * ks + 8 * hi), uf[ks], acc);
#pragma unroll
        for (int i = 0; i < 4; ++i) *(LAS f32x4*)(S + chunk * 132 + 32 * mb + 8 * i + 4 * hi) = (f32x4){acc[4 * i], acc[4 * i + 1], acc[4 * i + 2], acc[4 * i + 3]};
    }
    __syncthreads();
    if (wave == 0) {
        const f32x2_t aL = ((const f32x2_t*)(F.ws + WS_PW16))[g * 64 + lane]; float sr = 0.f, si = 0.f;
#pragma unroll 8
        for (int c = 0; c < 256; ++c) { const float lr = S[c * 132 + lane], li_ = S[c * 132 + 64 + lane]; S[c * 132 + lane] = sr; S[c * 132 + 64 + lane] = si;
            const float nr = aL.x * sr - aL.y * si + lr, ni = aL.x * si + aL.y * sr + li_; sr = nr; si = ni; }
        F.out[OFF_SRP + (size_t)(b * 64 + g) * 64 + lane] = sr; F.out[OFF_SIP + (size_t)(b * 64 + g) * 64 + lane] = si;
    }
    __syncthreads();
    bf16x8 sf[8];
#pragma unroll
    for (int ks = 0; ks < 8; ++ks) { const f32x4 a = *(const LAS f32x4*)(S + chunk * 132 + 16 * ks + 8 * hi), c = *(const LAS f32x4*)(S + chunk * 132 + 16 * ks + 8 * hi + 4); sf[ks] = pack_bf8(a, c); }
#pragma unroll
    for (int mb = 0; mb < 8; ++mb) {
        f32x16 acc = (f32x16){};
#pragma unroll
        for (int ks = 0; ks < 16; ++ks) if (ks <= 2 * mb + 1) acc = mfma32(*(const bf16x8*)(Tg + (32 * mb + n) * 256 + 16 * ks + 8 * hi), uf[ks], acc);
#pragma unroll
        for (int ks = 0; ks < 8; ++ks) acc = mfma32(*(const bf16x8*)(Fg + (32 * mb + n) * 128 + 16 * ks + 8 * hi), sf[ks], acc);
#pragma unroll
        for (int i = 0; i < 4; ++i) { const int t = 2 * mb + (i >> 1), c = 8 * (i & 1) + 4 * hi;
            const unsigned w0 = cvtpk(gelu_t(acc[4 * i]), gelu_t(acc[4 * i + 1])), w1 = cvtpk(gelu_t(acc[4 * i + 2]), gelu_t(acc[4 * i + 3]));
            *(unsigned long long*)(G + (tok0 + t) * 1024 + 16 * g + c) = (unsigned long long)w0 | ((unsigned long long)w1 << 32); }
    }
    __syncthreads();
}
__device__ __forceinline__ void ssm_sample_unit(Frame& F, int b, int g) {
    LAUNDER_TID(); const int p = lane; const bf16* XB = (const bf16*)(F.ws + WS_XB); bf16* G = (bf16*)(F.ws + WS_CB);
    const unsigned long long* ss2 = (const unsigned long long*)(F.ws + WS_SS) + 2 * (size_t)NTOK;
    const f32x2_t a = ((const f32x2_t*)(F.ws + WS_PW1))[g * 64 + p]; const f32x2_t* BB = (const f32x2_t*)(F.ws + WS_BBAR) + (size_t)g * 1024 + p * 16;
    const float* c_re = F.in[I_CRE] + (size_t)g * 1024; const float* c_im = F.in[I_CIM] + (size_t)g * 1024; const float* g1 = F.in[I_NMIX] + 1024 + 16 * g; const float* dsk = F.in[I_SD] + 16 * g;
    float sr = F.in[I_SRE][(size_t)(b * 64 + g) * 64 + p], si = F.in[I_SIM][(size_t)(b * 64 + g) * 64 + p];
    f32x2_t bb[16];
#pragma unroll
    for (int c = 0; c < 16; ++c) bb[c] = BB[c];
#pragma unroll 1
    for (int t = 0; t < 8; ++t) {
        const size_t tok = NP + 8 * b + t; const float r = ss_rinv(ss2 + tok, 1.0f / 1024.0f); float u[16]; float br = 0.f, bi = 0.f;
#pragma unroll
        for (int c = 0; c < 16; ++c) { u[c] = bf2f(XB[tok * 1024 + 16 * g + c]) * r * g1[c]; br += bb[c].x * u[c]; bi += bb[c].y * u[c]; }
        const float nr = a.x * sr - a.y * si + br, ni = a.x * si + a.y * sr + bi; sr = nr; si = ni;
        float yv = 0.f;
#pragma unroll
        for (int c = 0; c < 16; ++c) { const float y = wave_sum(c_re[c * 64 + p] * sr - c_im[c * 64 + p] * si) + dsk[c] * u[c]; if (p == c) yv = y; }
        if (p < 16) G[tok * 1024 + 16 * g + p] = (bf16)f2bf(gelu_t(yv));
    }
    F.out[OFF_SRS + (size_t)(b * 64 + g) * 64 + p] = sr; F.out[OFF_SIS + (size_t)(b * 64 + g) * 64 + p] = si;
}
__device__ __forceinline__ void final_norm_row(Frame& F, int m) {
    LAUNDER_TID(); const float* X = (const float*)(F.ws + WS_X) + (size_t)m * 1024; const unsigned long long* ss4 = (const unsigned long long*)(F.ws + WS_SS) + 4 * (size_t)NTOK;
    const float r = ss_rinv(ss4 + m, 1.0f / 1024.0f); const float* gf = F.in[I_NFIN]; float* o = F.out + OFF_YP + (size_t)m * 1024;
#pragma unroll
    for (int j = 0; j < 4; ++j) { const int c = 4 * lane + 256 * j; const f32x4 v = *(const f32x4*)(X + c), gg = *(const f32x4*)(gf + c); *(f32x4*)(o + c) = v * gg * r; }
}
#ifndef MK_LAST_PHASE
#define MK_LAST_PHASE 99
#endif
struct Args { const float* in[32]; float* out; unsigned char* ws; };
__global__ void __launch_bounds__(NWAVES * 64, 2) hyb_fwd(Args args) {
    extern __shared__ __attribute__((aligned(16))) unsigned char lds[];
    Frame F;
    F.lds = (LAS unsigned char*)lds;
    F.MISC = (volatile LAS unsigned*)(F.lds + MISC_OFF);
    F.tid = threadIdx.x; F.lane = F.tid & 63; F.wave = __builtin_amdgcn_readfirstlane(F.tid >> 6);
    F.G = gridDim.x; { const int bx = blockIdx.x; F.vcu = (F.G % 8 == 0) ? (bx % 8) * (F.G / 8) + bx / 8 : bx; }
    F.in = args.in;
    F.out = args.out; F.ws = args.ws; F.ctl = (gu32*)(args.ws + WS_CTL);
    for (int u = F.tid; u < (LDS_BYTES - LDSCTL_OFF) / 4; u += NWAVES * 64) ((LAS unsigned*)(F.lds + LDSCTL_OFF))[u] = 0u;
    __syncthreads();
    XcdBarrier bar = xcd_barrier_post((unsigned*)(F.ctl + CW_BAR), F.MISC + 8);
#define GRID_BAR() xcd_barrier(bar)
    unsigned char* ws = F.ws;
    bf16* XB = (bf16*)(ws + WS_XB); float* X = (float*)(ws + WS_X); bf16* CB = (bf16*)(ws + WS_CB); bf16* ACT = (bf16*)(ws + WS_ACT);
    unsigned long long* SS = (unsigned long long*)(ws + WS_SS);
    const int gw = F.vcu * NWAVES + F.wave, NGW = F.G * NWAVES;

    p0_prologue(F);
    GRID_BAR();
    if (MK_LAST_PHASE >= 1) {
        pg8::Gemm g{XB, (const bf16*)(ws + WS_W1), NTOK, 2560, 1024}; pg8::StaticOrder S; S.init(NTOK, 2560, F.G, (int)blockIdx.x);
        pg8::EpiInProj E{(const float*)(ws + WS_R0), (bf16*)(ws + WS_U), (bf16*)(ws + WS_VR), (bf16*)(ws + WS_QB), (bf16*)(ws + WS_KB), (bf16*)(ws + WS_VB), SS, F.out};
        pg8::gemm_phase<pg8::EpiInProj, pg8::StaticOrder, true, true>(F.lds + RING_OFF, g, S, E);
    }
    GRID_BAR();
    const float lam = lambda_val(F);
    if (MK_LAST_PHASE >= 2) {
        for (int u = F.vcu; u < 256; u += F.G) { const int bh = u >> 4, s = u & 15; attn_prompt_unit(F, lam, bh >> 2, bh & 3, s); attn_prompt_unit(F, lam, bh >> 2, bh & 3, 31 - s); }
        for (int u = F.vcu; u < 256; u += F.G) attn_sample_unit(F, u >> 3, u & 7);
        __syncthreads();
        for (int u = F.vcu; u < 512; u += F.G) sgu_prompt_unit(F, u >> 2, u & 3);
        for (int u = F.vcu; u < 32; u += F.G) sgu_sample_unit(F, u);
    }
    GRID_BAR();
    if (MK_LAST_PHASE >= 2) { for (int u = F.vcu; u < 128; u += F.G) attn_sample_combine(F, lam, u >> 2, u & 3); }
    GRID_BAR();
    if (MK_LAST_PHASE >= 3) {
        pg8::Gemm g{CB, (const bf16*)(ws + WS_W2), NTOK, 1024, 1024}; pg8::StaticOrder S; S.init(NTOK, 1024, F.G, (int)blockIdx.x);
        pg8::EpiResid E{F.in[I_XP], F.in[I_XS], X, XB, SS + 1 * (size_t)NTOK};
        pg8::gemm_phase<pg8::EpiResid, pg8::StaticOrder, true, true>(F.lds + RING_OFF, g, S, E);
    }
    GRID_BAR();
    if (MK_LAST_PHASE >= 4) {
        pg8::Gemm g{XB, (const bf16*)(ws + WS_W3), NTOK, 5632, 1024}; pg8::StaticOrder S; S.init(NTOK, 5632, F.G, (int)blockIdx.x);
        pg8::EpiSwiGLU E{SS + 1 * (size_t)NTOK, ACT};
        pg8::gemm_phase<pg8::EpiSwiGLU, pg8::StaticOrder, true, true>(F.lds + RING_OFF, g, S, E);
    }
    GRID_BAR();
    if (MK_LAST_PHASE >= 5) {
        pg8::Gemm g{ACT, (const bf16*)(ws + WS_W4), NTOK, 1024, 2816}; pg8::StaticOrder S; S.init(NTOK, 1024, F.G, (int)blockIdx.x);
        pg8::EpiResid E{X, X + (size_t)NP * 1024, X, XB, SS + 2 * (size_t)NTOK};
        pg8::gemm_phase<pg8::EpiResid, pg8::StaticOrder, true, true>(F.lds + RING_OFF, g, S, E);
    }
    GRID_BAR();
    if (MK_LAST_PHASE >= 6) {
        for (int u = F.vcu; u < 256; u += F.G) ssm_prompt_unit(F, u >> 6, u & 63);
        for (int w = gw; w < 2048; w += NGW) ssm_sample_unit(F, w >> 6, w & 63);
    }
    GRID_BAR();
    if (MK_LAST_PHASE >= 7) {
        pg8::Gemm g{CB, (const bf16*)(ws + WS_W5), NTOK, 2048, 1024}; pg8::StaticOrder S; S.init(NTOK, 2048, F.G, (int)blockIdx.x);
        pg8::EpiGLU E{F.in[I_BGLU], X, XB, SS + 3 * (size_t)NTOK};
        pg8::gemm_phase<pg8::EpiGLU, pg8::StaticOrder, true, true>(F.lds + RING_OFF, g, S, E);
    }
    GRID_BAR();
    if (MK_LAST_PHASE >= 8) {
        pg8::Gemm g{XB, (const bf16*)(ws + WS_W6), NTOK, 5632, 1024}; pg8::StaticOrder S; S.init(NTOK, 5632, F.G, (int)blockIdx.x);
        pg8::EpiSwiGLU E{SS + 3 * (size_t)NTOK, ACT};
        pg8::gemm_phase<pg8::EpiSwiGLU, pg8::StaticOrder, true, true>(F.lds + RING_OFF, g, S, E);
    }
    GRID_BAR();
    if (MK_LAST_PHASE >= 9) {
        pg8::Gemm g{ACT, (const bf16*)(ws + WS_W7), NTOK, 1024, 2816}; pg8::StaticOrder S; S.init(NTOK, 1024, F.G, (int)blockIdx.x);
        pg8::EpiResid E{X, X + (size_t)NP * 1024, X, nullptr, SS + 4 * (size_t)NTOK};
        pg8::gemm_phase<pg8::EpiResid, pg8::StaticOrder, true, true>(F.lds + RING_OFF, g, S, E);
    }
    GRID_BAR();
    if (MK_LAST_PHASE >= 10) { for (int m = gw; m < NTOK; m += NGW) final_norm_row(F, m); }
}

extern "C" void kernel_launch(void* const* d_in, const int* in_sizes, int n_in, void* d_out, int out_size, void* d_ws, size_t ws_size, hipStream_t stream) {
    static int grid = 0;
    if (grid == 0) {
        if (n_in != 32 || (size_t)out_size != OUT_TOTAL || ws_size < WS_END) { fprintf(stderr, "kernel_launch: shape mismatch (n_in %d, out %d, ws %zu); nothing launched\n", n_in, out_size, ws_size); grid = -1; return; }
        int dev = 0, cus = 0, per_cu = 0;
        if (hipGetDevice(&dev) != hipSuccess || hipDeviceGetAttribute(&cus, hipDeviceAttributeMultiprocessorCount, dev) != hipSuccess) { grid = -1; return; }
        if (hipFuncSetAttribute((const void*)hyb_fwd, hipFuncAttributeMaxDynamicSharedMemorySize, LDS_BYTES) != hipSuccess) { fprintf(stderr, "kernel_launch: hipFuncSetAttribute failed\n"); grid = -1; return; }
        if (hipOccupancyMaxActiveBlocksPerMultiprocessor(&per_cu, (const void*)hyb_fwd, NWAVES * 64, LDS_BYTES) != hipSuccess || per_cu < 1) { fprintf(stderr, "kernel_launch: occupancy query says %d blocks per CU\n", per_cu); }
        (void)hipGetLastError();
        grid = cus;
    }
    if (grid < 0) return;
    if (hipMemsetAsync((char*)d_ws + WS_CTL, 0, CTL_ZERO_BYTES, stream) != hipSuccess) { fprintf(stderr, "kernel_launch: memset failed\n"); return; }
    Args a{};
    for (int i = 0; i < 32; ++i) a.in[i] = (const float*)d_in[i];
    a.out = (float*)d_out; a.ws = (unsigned char*)d_ws;
    hipLaunchKernelGGL(hyb_fwd, dim3(grid), dim3(NWAVES * 64), LDS_BYTES, stream, a);
    const hipError_t le = hipPeekAtLastError();
    if (le != hipSuccess) fprintf(stderr, "kernel_launch: launch failed: %s\n", hipGetErrorName(le));
}
```

```cpp
#include <hip/hip_runtime.h>
#include <cstdio>
#include <cstdint>
namespace pg8 {
#define PG8_LAS __attribute__((address_space(3)))
typedef unsigned short bf16_t;
typedef short bf16x8 __attribute__((ext_vector_type(8)));
typedef float f32x4 __attribute__((ext_vector_type(4)));
typedef unsigned u32x4 __attribute__((ext_vector_type(4)));
constexpr int BM = 256, BK = 64, HALF = 128, HTB = HALF * BK * 2  , STAGE_BYTES = 8 * HTB, NXCD = 8, WGM = 8;

__host__ __device__ __forceinline__ int lds_byte(int r, int c) { const int st = (r >> 4) * 2 + (c >> 5), rr = r & 15, cc = c & 31, ob = rr * 64 + cc * 2; return st * 1024 + (ob ^ (((ob >> 9) & 1) << 5)); }
__host__ __device__ __forceinline__ void stage_rc(int b, int& R, int& C) { const int st = b / 1024, sb = b % 1024, swz = sb ^ (((sb >> 9) & 1) << 5); R = (st >> 1) * 16 + swz / 64; C = (st & 1) * 32 + (swz % 64) / 2; }
__host__ __device__ __forceinline__ int perm32(int rho) { const int n = rho >> 4, i = rho & 15; return 8 * (i >> 2) + 4 * n + (i & 3); }

struct Unit { int pm, pn; };
struct Gemm { const bf16_t* A; const bf16_t* Bt; int M, N, K; };

struct StaticOrder {
    int nM, nN, nwg, G, c;
    __host__ __device__ void init(int M, int N, int G_, int c_) { nM = M / BM; nN = N / BM; nwg = nM * nN; G = G_; c = c_; }
    __host__ __device__ bool next(int i, Unit& u) const {
        const long L = (long)i * G + c; if (L >= nwg) return false;
        int wgid = (int)L; { const int q = nwg / NXCD, r = nwg % NXCD, xcd = wgid % NXCD, off = wgid / NXCD; wgid = (xcd < r ? xcd * (q + 1) : r * (q + 1) + (xcd - r) * q) + off; }
        const int nig = WGM * nN, gid = wgid / nig, fm = gid * WGM, gsz = (nM - fm) < WGM ? (nM - fm) : WGM;
        u.pm = fm + ((wgid % nig) % gsz); u.pn = (wgid % nig) / gsz; return true;
    }
    __device__ __forceinline__ void a_ready(const Unit&) const {}
    __device__ __forceinline__ void done(const Unit&) const {}
};

__device__ __forceinline__ unsigned cvt_pk_bf16(float lo, float hi) { unsigned r; asm volatile("v_cvt_pk_bf16_f32 %0, %1, %2" : "=v"(r) : "v"(lo), "v"(hi)); return r; }
typedef float f32x2 __attribute__((ext_vector_type(2)));
constexpr int NP_ = 16384, NS_ = 256;
constexpr size_t OFF_YP = 0, OFF_YS = OFF_YP + (size_t)NP_ * 1024, OFF_KP = OFF_YS + (size_t)NS_ * 1024, OFF_VP = OFF_KP + (size_t)NP_ * 512, OFF_KS = OFF_VP + (size_t)NP_ * 512,
                 OFF_VS = OFF_KS + (size_t)NS_ * 512, OFF_CV = OFF_VS + (size_t)NS_ * 512, OFF_SRP = OFF_CV + (size_t)NS_ * 512, OFF_SIP = OFF_SRP + 4 * 64 * 64, OFF_SRS = OFF_SIP + 4 * 64 * 64,
                 OFF_SIS = OFF_SRS + 32 * 64 * 64, OUT_TOTAL = OFF_SIS + 32 * 64 * 64;
constexpr float QSCALE = 0.125f * 1.4426950408889634f;
#define PG8_RLXA __ATOMIC_RELAXED, __HIP_MEMORY_SCOPE_AGENT
__device__ __forceinline__ void ss_add(unsigned long long* p, float v) { __hip_atomic_fetch_add(p, (unsigned long long)(v * 1048576.0f + 0.5f), PG8_RLXA); }
__device__ __forceinline__ float ss_rinv(const unsigned long long* p, float inv_n) { const unsigned long long w = __hip_atomic_load(p, PG8_RLXA); return __builtin_amdgcn_rsqf((float)w * (inv_n * (1.0f / 1048576.0f)) + 1e-6f); }
__device__ __forceinline__ float gelu_t(float x) { const float t = x * (1.0f + 0.044715f * x * x); return x * __builtin_amdgcn_rcpf(1.0f + __builtin_amdgcn_exp2f(-2.302208198f * t)); }
__device__ __forceinline__ float sigm(float x) { return __builtin_amdgcn_rcpf(1.0f + __builtin_amdgcn_exp2f(-1.4426950409f * x)); }
__device__ __forceinline__ float quad_sum(float s) { s += __shfl_xor(s, 16); s += __shfl_xor(s, 32); return s; }
__device__ __forceinline__ u32x4 pack8(const f32x4 a, const f32x4 b) { u32x4 w; w.x = cvt_pk_bf16(a[0], a[1]); w.y = cvt_pk_bf16(a[2], a[3]); w.z = cvt_pk_bf16(b[0], b[1]); w.w = cvt_pk_bf16(b[2], b[3]); return w; }

struct EpiInProj {
    static constexpr bool PERM = true, AFTER_DRAIN = false;
    const float* r0; bf16_t* U; bf16_t* VR; bf16_t* QB; bf16_t* KB; bf16_t* VB; unsigned long long* vss; float* out;
    __device__ __forceinline__ void operator()(const f32x4 (&acc)[2][2][4][2], const Unit& u, int wr, int wc, int fr, int fq) const {
        const int row0 = u.pm * BM + wr * 64 + fr, seg = u.pn >> 1, col0 = (u.pn & 1) * 256 + wc * 32 + 8 * fq;
        bf16_t* dstb = seg == 0 ? U : seg == 1 ? VR : seg == 2 ? QB : seg == 3 ? KB : VB;
        const bool prompt = u.pm < NP_ / BM;
        float* dstf = out + (prompt ? (seg == 3 ? OFF_KP : OFF_VP) : (seg == 3 ? OFF_KS : OFF_VS));
#pragma unroll
        for (int ai = 0; ai < 2; ++ai)
#pragma unroll
            for (int m = 0; m < 4; ++m) {
                const int row = row0 + ai * HALF + m * 16; const float r = r0[row]; float ssq = 0.f;
                const int orow = prompt ? row : row - NP_;
#pragma unroll
                for (int bj = 0; bj < 2; ++bj) {
                    f32x4 v0 = acc[ai][bj][m][0] * r, v1 = acc[ai][bj][m][1] * r; const int col = col0 + bj * HALF;
                    if (seg <= 1) {
#pragma unroll
                        for (int i = 0; i < 4; ++i) { v0[i] = gelu_t(v0[i]); v1[i] = gelu_t(v1[i]); }
                        if (seg == 1) ssq += (v0[0] * v0[0] + v0[1] * v0[1]) + (v0[2] * v0[2] + v0[3] * v0[3]) + (v1[0] * v1[0] + v1[1] * v1[1]) + (v1[2] * v1[2] + v1[3] * v1[3]);
                    } else if (seg == 2) { v0 = v0 * QSCALE; v1 = v1 * QSCALE; }
                    else { float* o = dstf + (size_t)orow * 512 + col; *(f32x4*)o = v0; *(f32x4*)(o + 4) = v1; }
                    *(u32x4*)(dstb + (size_t)row * 512 + col) = pack8(v0, v1);
                }
                if (seg == 1) { ssq = quad_sum(ssq); if (fq == 0) ss_add(vss + row, ssq); }
            }
    }
};
struct EpiResid {
    static constexpr bool PERM = true, AFTER_DRAIN = false;
    const float* resP; const float* resS; float* X; bf16_t* XB; unsigned long long* ss;
    __device__ __forceinline__ void operator()(const f32x4 (&acc)[2][2][4][2], const Unit& u, int wr, int wc, int fr, int fq) const {
        const int row0 = u.pm * BM + wr * 64 + fr, col0 = u.pn * BM + wc * 32 + 8 * fq; const bool prompt = u.pm < NP_ / BM;
#pragma unroll
        for (int ai = 0; ai < 2; ++ai)
#pragma unroll
            for (int m = 0; m < 4; ++m) {
                const int row = row0 + ai * HALF + m * 16; float ssq = 0.f;
                const float* rp = (prompt ? resP + (size_t)row * 1024 : resS + (size_t)(row - NP_) * 1024) + col0;
#pragma unroll
                for (int bj = 0; bj < 2; ++bj) {
                    const f32x4 o0 = acc[ai][bj][m][0] + *(const f32x4*)(rp + bj * HALF), o1 = acc[ai][bj][m][1] + *(const f32x4*)(rp + bj * HALF + 4);
                    float* xo = X + (size_t)row * 1024 + col0 + bj * HALF; *(f32x4*)xo = o0; *(f32x4*)(xo + 4) = o1;
                    if (XB) *(u32x4*)(XB + (size_t)row * 1024 + col0 + bj * HALF) = pack8(o0, o1);
                    ssq += (o0[0] * o0[0] + o0[1] * o0[1]) + (o0[2] * o0[2] + o0[3] * o0[3]) + (o1[0] * o1[0] + o1[1] * o1[1]) + (o1[2] * o1[2] + o1[3] * o1[3]);
                }
                ssq = quad_sum(ssq); if (fq == 0) ss_add(ss + row, ssq);
            }
    }
};
struct EpiSwiGLU {
    static constexpr bool PERM = true, AFTER_DRAIN = false;
    const unsigned long long* ss; bf16_t* ACT;
    __device__ __forceinline__ void operator()(const f32x4 (&acc)[2][2][4][2], const Unit& u, int wr, int wc, int fr, int fq) const {
        const int row0 = u.pm * BM + wr * 64 + fr, col0 = u.pn * HALF + wc * 32 + 8 * fq;
#pragma unroll
        for (int ai = 0; ai < 2; ++ai)
#pragma unroll
            for (int m = 0; m < 4; ++m) {
                const int row = row0 + ai * HALF + m * 16; const float r = ss_rinv(ss + row, 1.0f / 1024.0f);
                f32x4 a[2];
#pragma unroll
                for (int n = 0; n < 2; ++n) { const f32x4 g = acc[ai][0][m][n] * r, up = acc[ai][1][m][n] * r;
#pragma unroll
                    for (int i = 0; i < 4; ++i) a[n][i] = g[i] * sigm(g[i]) * up[i]; }
                *(u32x4*)(ACT + (size_t)row * 2816 + col0) = pack8(a[0], a[1]);
            }
    }
};
struct EpiGLU {
    static constexpr bool PERM = true, AFTER_DRAIN = false;
    const float* bglu; float* X; bf16_t* XB; unsigned long long* ss;
    __device__ __forceinline__ void operator()(const f32x4 (&acc)[2][2][4][2], const Unit& u, int wr, int wc, int fr, int fq) const {
        const int row0 = u.pm * BM + wr * 64 + fr, col0 = u.pn * HALF + wc * 32 + 8 * fq;
        f32x4 bv[2], bg[2];
#pragma unroll
        for (int n = 0; n < 2; ++n) { bv[n] = *(const f32x4*)(bglu + col0 + 4 * n); bg[n] = *(const f32x4*)(bglu + 1024 + col0 + 4 * n); }
#pragma unroll
        for (int ai = 0; ai < 2; ++ai)
#pragma unroll
            for (int m = 0; m < 4; ++m) {
                const int row = row0 + ai * HALF + m * 16; float* xp = X + (size_t)row * 1024 + col0; f32x4 o[2]; float ssq = 0.f;
#pragma unroll
                for (int n = 0; n < 2; ++n) { const f32x4 zv = acc[ai][0][m][n] + bv[n], zg = acc[ai][1][m][n] + bg[n], x = *(const f32x4*)(xp + 4 * n);
#pragma unroll
                    for (int i = 0; i < 4; ++i) { o[n][i] = x[i] + zv[i] * sigm(zg[i]); ssq += o[n][i] * o[n][i]; } }
                *(f32x4*)xp = o[0]; *(f32x4*)(xp + 4) = o[1];
                *(u32x4*)(XB + (size_t)row * 1024 + col0) = pack8(o[0], o[1]);
                ssq = quad_sum(ssq); if (fq == 0) ss_add(ss + row, ssq);
            }
    }
};
template <class Epi, class Sched, bool ALIGN_EPI = false, bool SP2 = false>
__device__ __forceinline__ void gemm_phase(PG8_LAS unsigned char* lds, const Gemm g, const Sched& S, const Epi& E) {
    int tid_ = threadIdx.x; asm volatile("" : "+v"(tid_));
    const int tid = tid_, wid = __builtin_amdgcn_readfirstlane(tid >> 6), lane = tid & 63, wr = wid >> 2, wc = wid & 3, fr = lane & 15, fq = lane >> 4;
    const int K = g.K, nt = K / BK;
    unsigned voffA[2], voffB[2];
#pragma unroll
    for (int i = 0; i < 2; ++i) { int R, C; stage_rc(tid * 16 + i * 8192, R, C); const int Rb = Epi::PERM ? ((R & ~31) + perm32(R & 31)) : R;
        voffA[i] = (unsigned)(R * K + C) * 2u; voffB[i] = (unsigned)(Rb * K + C) * 2u; }
    const size_t kstep = (size_t)(BK * 2);
    const size_t hstep = (size_t)HALF * K * 2;
    const size_t tstep = 2 * hstep;
    const unsigned ldsw = (unsigned)wid * 1024u;
    const int aoff = lds_byte(wr * 64 + fr, fq * 8), boff = lds_byte(wc * 32 + fr, fq * 8);
#define PG8_SA(b, h) (((b) * 2 + (h)) * HTB)
#define PG8_SB(b, h) ((4 + (b) * 2 + (h)) * HTB)
#define PG8_STAGE(bufoff, gbase, voff) do { _Pragma("unroll") for (int _i = 0; _i < 2; ++_i) \
        __builtin_amdgcn_global_load_lds((const unsigned*)((const char*)(gbase) + (voff)[_i]), (PG8_LAS unsigned*)(lds + (bufoff) + ldsw + _i * 8192), 16, 0, 0); } while (0)
#define PG8_LDA(dst, b, h) do { _Pragma("unroll") for (int m = 0; m < 4; ++m) _Pragma("unroll") for (int k = 0; k < 2; ++k) dst[m][k] = *(const PG8_LAS bf16x8*)(lds + PG8_SA(b, h) + aoff + m * 2048 + k * 1024); } while (0)
#define PG8_LDB(dst, b, h) do { _Pragma("unroll") for (int n = 0; n < 2; ++n) _Pragma("unroll") for (int k = 0; k < 2; ++k) dst[n][k] = *(const PG8_LAS bf16x8*)(lds + PG8_SB(b, h) + boff + n * 2048 + k * 1024); } while (0)
#define PG8_MMA(ai, bj, At, Bt) do { __builtin_amdgcn_s_setprio(1); _Pragma("unroll") for (int m = 0; m < 4; ++m) _Pragma("unroll") for (int n = 0; n < 2; ++n) _Pragma("unroll") for (int k = 0; k < 2; ++k) \
        acc[ai][bj][m][n] = __builtin_amdgcn_mfma_f32_16x16x32_bf16(Bt[n][k], At[m][k], acc[ai][bj][m][n], 0, 0, 0); __builtin_amdgcn_s_setprio(0); } while (0)
#define PG8_WAIT_V(n) asm volatile("s_waitcnt vmcnt(" #n ")" ::: "memory")
#define PG8_WAIT_L(n) asm volatile("s_waitcnt lgkmcnt(" #n ")" ::: "memory")
#define PG8_BAR __builtin_amdgcn_s_barrier()
#define PG8_SCHED __builtin_amdgcn_sched_barrier(0)
    Unit cur, nxt; int ui = 0;
    if (!S.next(0, cur)) return;
    f32x4 acc[2][2][4][2];
#pragma unroll
    for (int a = 0; a < 2; ++a)
#pragma unroll
        for (int b = 0; b < 2; ++b)
#pragma unroll
            for (int m = 0; m < 4; ++m)
#pragma unroll
                for (int n = 0; n < 2; ++n) acc[a][b][m][n] = (f32x4){0.f, 0.f, 0.f, 0.f};
    bf16x8 At[4][2], B0[2][2], B1[2][2];
    const char* cA = (const char*)g.A + (size_t)cur.pm * tstep; const char* cB = (const char*)g.Bt + (size_t)cur.pn * tstep;
    S.a_ready(cur);
    if constexpr (SP2) {
        PG8_STAGE(PG8_SB(0, 0), cB, voffB); PG8_STAGE(PG8_SB(0, 1), cB + hstep, voffB); PG8_STAGE(PG8_SA(0, 0), cA, voffA); PG8_STAGE(PG8_SA(0, 1), cA + hstep, voffA);
        if (wr == 1) PG8_BAR;
        PG8_WAIT_V(2); PG8_BAR;
        PG8_STAGE(PG8_SB(1, 0), cB + kstep, voffB); PG8_STAGE(PG8_SA(1, 0), cA + kstep, voffA); PG8_STAGE(PG8_SB(1, 1), cB + hstep + kstep, voffB);
        PG8_WAIT_V(6); PG8_BAR;
    } else {
        PG8_STAGE(PG8_SB(0, 0), cB, voffB); PG8_STAGE(PG8_SA(0, 0), cA, voffA); PG8_STAGE(PG8_SB(0, 1), cB + hstep, voffB); PG8_STAGE(PG8_SA(0, 1), cA + hstep, voffA);
        if (wr == 1) PG8_BAR;
        PG8_WAIT_V(4); PG8_BAR;
        PG8_STAGE(PG8_SB(1, 0), cB + kstep, voffB); PG8_STAGE(PG8_SA(1, 0), cA + kstep, voffA); PG8_STAGE(PG8_SB(1, 1), cB + hstep + kstep, voffB);
        PG8_WAIT_V(6); PG8_BAR;
    }
    for (;;) {
        const bool has_next = S.next(ui + 1, nxt);
        const char* nA = has_next ? (const char*)g.A + (size_t)nxt.pm * tstep : cA; const char* nB = has_next ? (const char*)g.Bt + (size_t)nxt.pn * tstep : cB;
        for (int t = 0; t < nt; t += 2) {
            const bool last = (t == nt - 2);
            const char* a1 = cA + (size_t)(t + 1) * kstep;
            const char* a2 = last ? nA : cA + (size_t)(t + 2) * kstep; const char* b2 = last ? nB : cB + (size_t)(t + 2) * kstep;
            const char* a3 = a2 + kstep; const char* b3 = b2 + kstep;
            if (last && has_next) S.a_ready(nxt);
            if constexpr (SP2) {
            PG8_LDB(B0, 0, 0); PG8_LDB(B1, 0, 1); PG8_SCHED; PG8_LDA(At, 0, 0); PG8_STAGE(PG8_SA(1, 1), a1 + hstep, voffA);
            PG8_WAIT_V(8); PG8_WAIT_L(0); PG8_BAR; PG8_MMA(0, 0, At, B0); PG8_MMA(0, 1, At, B1); PG8_BAR; PG8_SCHED;
            PG8_LDA(At, 0, 1); PG8_STAGE(PG8_SB(0, 0), b2, voffB); PG8_STAGE(PG8_SB(0, 1), b2 + hstep, voffB); PG8_STAGE(PG8_SA(0, 0), a2, voffA);
            PG8_WAIT_V(8); PG8_WAIT_L(0); PG8_BAR; PG8_MMA(1, 0, At, B0); PG8_MMA(1, 1, At, B1); PG8_BAR; PG8_SCHED;
            PG8_LDB(B0, 1, 0); PG8_LDB(B1, 1, 1); PG8_SCHED; PG8_LDA(At, 1, 0); PG8_STAGE(PG8_SA(0, 1), a2 + hstep, voffA);
            PG8_WAIT_V(8); PG8_WAIT_L(0); PG8_BAR; PG8_MMA(0, 0, At, B0); PG8_MMA(0, 1, At, B1); PG8_BAR; PG8_SCHED;
            PG8_LDA(At, 1, 1); PG8_STAGE(PG8_SB(1, 0), b3, voffB); PG8_STAGE(PG8_SB(1, 1), b3 + hstep, voffB); PG8_STAGE(PG8_SA(1, 0), a3, voffA);
            PG8_WAIT_V(8); PG8_WAIT_L(0); PG8_BAR; PG8_MMA(1, 0, At, B0); PG8_MMA(1, 1, At, B1); PG8_BAR; PG8_SCHED;
            } else {
            PG8_LDB(B0, 0, 0); PG8_SCHED; PG8_LDA(At, 0, 0); PG8_STAGE(PG8_SA(1, 1), a1 + hstep, voffA);
            PG8_WAIT_L(8); PG8_BAR; PG8_WAIT_L(0); PG8_MMA(0, 0, At, B0); PG8_BAR; PG8_SCHED;
            PG8_LDB(B1, 0, 1); PG8_STAGE(PG8_SB(0, 0), b2, voffB);
            PG8_BAR; PG8_WAIT_L(0); PG8_MMA(0, 1, At, B1); PG8_BAR;
            PG8_LDA(At, 0, 1); PG8_STAGE(PG8_SA(0, 0), a2, voffA);
            PG8_BAR; PG8_WAIT_L(0); PG8_MMA(1, 0, At, B0); PG8_BAR; PG8_SCHED;
            PG8_STAGE(PG8_SB(0, 1), b2 + hstep, voffB);
            PG8_WAIT_V(6); PG8_BAR; PG8_MMA(1, 1, At, B1); PG8_BAR;
            PG8_LDB(B0, 1, 0); PG8_SCHED; PG8_LDA(At, 1, 0); PG8_STAGE(PG8_SA(0, 1), a2 + hstep, voffA);
            PG8_WAIT_L(8); PG8_BAR; PG8_WAIT_L(0); PG8_MMA(0, 0, At, B0); PG8_BAR; PG8_SCHED;
            PG8_LDB(B1, 1, 1); PG8_STAGE(PG8_SB(1, 0), b3, voffB);
            PG8_BAR; PG8_WAIT_L(0); PG8_MMA(0, 1, At, B1); PG8_BAR;
            PG8_LDA(At, 1, 1); PG8_STAGE(PG8_SA(1, 0), a3, voffA);
            PG8_BAR; PG8_WAIT_L(0); PG8_MMA(1, 0, At, B0); PG8_BAR; PG8_SCHED;
            PG8_STAGE(PG8_SB(1, 1), b3 + hstep, voffB);
            PG8_WAIT_V(6); PG8_BAR; PG8_MMA(1, 1, At, B1); PG8_BAR;
            }
        }
        if constexpr (ALIGN_EPI) { if (wr == 0) PG8_BAR; }
        if constexpr (!Epi::AFTER_DRAIN) { E(acc, cur, wr, wc, fr, fq); S.done(cur); }
        if (!has_next) break;
#pragma unroll
        for (int a = 0; a < 2; ++a)
#pragma unroll
            for (int b = 0; b < 2; ++b)
#pragma unroll
                for (int m = 0; m < 4; ++m)
#pragma unroll
                    for (int n = 0; n < 2; ++n) acc[a][b][m][n] = (f32x4){0.f, 0.f, 0.f, 0.f};
        cur = nxt; cA = nA; cB = nB; ++ui;
        if constexpr (ALIGN_EPI) { if (wr == 1) PG8_BAR; }
    }
    PG8_WAIT_V(0);
    if constexpr (!ALIGN_EPI) { if (wr == 0) PG8_BAR; }
    PG8_BAR;
    if constexpr (Epi::AFTER_DRAIN) { E.fused(acc, cur, wr, wc, fr, fq, lds, wid, lane); S.done(cur); }
#undef PG8_SA
#undef PG8_SB
#undef PG8_STAGE
#undef PG8_LDA
#undef PG8_LDB
#undef PG8_MMA
#undef PG8_WAIT_V
#undef PG8_WAIT_L
#undef PG8_BAR
#undef PG8_SCHED
}
}
#define GAS __attribute__((address_space(1)))
#define LAS __attribute__((address_space(3)))
typedef unsigned short bf16;
typedef unsigned v4u __attribute__((ext_vector_type(4)));
typedef float f32x4 __attribute__((ext_vector_type(4)));
typedef short bf16x8 __attribute__((ext_vector_type(8)));
typedef GAS unsigned gu32;
typedef GAS unsigned long long gu64;
#define RLX_AGENT __ATOMIC_RELAXED, __HIP_MEMORY_SCOPE_AGENT
#define LDS_WAIT() asm volatile("s_waitcnt lgkmcnt(0)" ::: "memory")
#define VM_WAIT() asm volatile("s_waitcnt vmcnt(0)" ::: "memory")
__device__ __forceinline__ unsigned long long rt() { return __builtin_amdgcn_s_memrealtime(); }
__device__ __forceinline__ unsigned f2bf(float f) { unsigned u = __builtin_bit_cast(unsigned, f); return (u + 0x7fffu + ((u >> 16) & 1u)) >> 16; }
__device__ __forceinline__ unsigned pk2(float lo, float hi) { return f2bf(lo) | (f2bf(hi) << 16); }

#define XB_TMO      128
#define XB_XCNT(j)  (256  + 64 * (j))
#define XB_XSUB(j)  (1280 + 64 * (j))
#define XB_XGEN(j)  (2304 + 64 * (j))
#define XB_TOP      3328
#define XB_TOPGEN   3392
#define XCD_BAR_WORDS 3456
#define XB_SPIN_CAP (1u << 18)

__device__ __forceinline__ unsigned xb_ld(unsigned* p)              { return __hip_atomic_load(p, __ATOMIC_RELAXED, __HIP_MEMORY_SCOPE_AGENT); }
__device__ __forceinline__ unsigned xb_add(unsigned* p, unsigned v) { return __hip_atomic_fetch_add(p, v, __ATOMIC_RELAXED, __HIP_MEMORY_SCOPE_AGENT); }
__device__ __forceinline__ unsigned xb_xcc_id() { return (unsigned)__builtin_amdgcn_s_getreg((3 << 11) | 20) & 0xFu; }
#define XB_SPIN(cond, bar) do { unsigned _sp = 0; while (cond) { __builtin_amdgcn_s_sleep(1); \
    if ((++_sp & 255u) == 0u) { if (xb_ld(&(bar)[XB_TMO])) break; if (_sp > XB_SPIN_CAP) { atomicAdd(&(bar)[XB_TMO], 1u); break; } } } } while (0)

struct XcdBarrier {
    unsigned* bar; unsigned x;
    volatile LAS unsigned* st;
};

__device__ __forceinline__ XcdBarrier xcd_barrier_post(unsigned* bar, volatile LAS unsigned* st) {
    XcdBarrier b; b.bar = bar; b.x = xb_xcc_id(); b.st = st;
    if (threadIdx.x == 0) (void)xb_add(&bar[XB_XCNT(b.x)], 1u);
    return b;
}
__device__ __forceinline__ void xcd_barrier_complete(unsigned* bar, unsigned x, unsigned& nloc, unsigned& nx) {
    const unsigned G = gridDim.x * gridDim.y * gridDim.z;
    unsigned sum, cnt, mine, sp = 0u;
    for (;;) {
        sum = 0u; cnt = 0u; mine = 0u;
#pragma unroll
        for (unsigned j = 0; j < 16; ++j) { const unsigned c = xb_ld(&bar[XB_XCNT(j)]); sum += c; cnt += (c > 0u) ? 1u : 0u; mine = (j == x) ? c : mine; }
        if (sum == G) break;
        __builtin_amdgcn_s_sleep(1);
        if ((++sp & 255u) == 0u) { if (xb_ld(&bar[XB_TMO])) break; if (sp > XB_SPIN_CAP) { atomicAdd(&bar[XB_TMO], 1u); break; } }
    }
    nloc = mine > 0u ? mine : 1u; nx = cnt > 0u ? cnt : 1u;
}

__device__ __forceinline__ void xcd_barrier(const XcdBarrier& b) {
    asm volatile("s_waitcnt vmcnt(0)" ::: "memory");
    __syncthreads();
    if (threadIdx.x == 0) {
        unsigned* bar = b.bar;
        __builtin_amdgcn_s_waitcnt(0);
        unsigned nloc = b.st[0], nx = b.st[1];
        if (nloc == 0u) { xcd_barrier_complete(bar, b.x, nloc, nx); b.st[0] = nloc; b.st[1] = nx; }
        const unsigned old = xb_add(&bar[XB_XSUB(b.x)], 1u);
        const unsigned gen = old / nloc;
        if (old + 1u == (gen + 1u) * nloc) {
            __builtin_amdgcn_fence(__ATOMIC_RELEASE, "agent");
            asm volatile("s_waitcnt vmcnt(0)" ::: "memory");
            const unsigned og = xb_add(&bar[XB_TOP], 1u);
            const unsigned tg = og / nx;
            if (og + 1u == (tg + 1u) * nx) xb_add(&bar[XB_TOPGEN], 1u);
            else XB_SPIN(xb_ld(&bar[XB_TOPGEN]) == tg, bar);
            __builtin_amdgcn_fence(__ATOMIC_ACQUIRE, "agent");
            xb_add(&bar[XB_XGEN(b.x)], 1u);
            asm volatile("s_waitcnt vmcnt(0)" ::: "memory");
        } else {
            XB_SPIN(xb_ld(&bar[XB_XGEN(b.x)]) == gen, bar);
            __builtin_amdgcn_fence(__ATOMIC_ACQUIRE, "agent");
            asm volatile("s_waitcnt vmcnt(0)" ::: "memory");
        }
    }
    __syncthreads();
}
constexpr int NWAVES = 8;
constexpr int NP = 16384, NS = 256, NTOK = NP + NS, DM = 1024, DFF = 2816, SEQ = 4096;
constexpr float EPS = 1e-6f, LAM_INIT = 0.2f;
using pg8::OFF_YP; using pg8::OFF_CV; using pg8::OFF_SRP; using pg8::OFF_SIP; using pg8::OFF_SRS; using pg8::OFF_SIS; using pg8::OUT_TOTAL;
constexpr size_t MiB = 1u << 20;
constexpr size_t WS_CTL = 0, CTL_ZERO_BYTES = 2 * MiB;
constexpr int CW_BAR = 4096;
constexpr size_t WS_SS = 64 * 1024;
constexpr size_t WS_R0 = 2 * MiB;
constexpr size_t WS_PW1 = 2 * MiB + 128 * 1024, WS_PW16 = WS_PW1 + 32 * 1024;
constexpr size_t WS_BBAR = 2 * MiB + 256 * 1024;
constexpr size_t WS_WTRIL = 3 * MiB;
constexpr size_t WS_T = 4 * MiB, WS_E = 12 * MiB, WS_F = 16 * MiB;
constexpr size_t WS_W1 = 24 * MiB, WS_W2 = 29 * MiB, WS_W3 = 31 * MiB, WS_W4 = 42 * MiB, WS_W5 = 48 * MiB, WS_W6 = 52 * MiB, WS_W7 = 63 * MiB;
constexpr size_t WS_XB = 70 * MiB, WS_X = 104 * MiB, WS_U = 170 * MiB, WS_VR = 187 * MiB, WS_QB = 204 * MiB, WS_KB = 221 * MiB, WS_VB = 238 * MiB;
constexpr size_t WS_CB = 256 * MiB, WS_ACT = 290 * MiB, WS_PART = 380 * MiB, WS_END = 400 * MiB;
constexpr int PART_STRIDE = 32 + 16 * 128;
static_assert(WS_W7 + (size_t)1024 * 2816 * 2 <= WS_XB && WS_XB + (size_t)NTOK * 1024 * 2 <= WS_X && WS_X + (size_t)NTOK * 1024 * 4 <= WS_U && WS_VB + (size_t)NTOK * 512 * 2 <= WS_CB &&
              WS_CB + (size_t)NTOK * 1024 * 2 <= WS_ACT && WS_ACT + (size_t)NTOK * 2816 * 2 <= WS_PART && WS_PART + (size_t)32 * 4 * 16 * PART_STRIDE * 4 <= WS_END && WS_SS + 5 * (size_t)NTOK * 8 <= CTL_ZERO_BYTES, "d_ws map");
constexpr int RING_OFF = 0, SCRATCH_BYTES = 147456;
constexpr int LDSCTL_OFF = SCRATCH_BYTES, MISC_OFF = LDSCTL_OFF + 320;
constexpr int LDS_BYTES = SCRATCH_BYTES + 1024;

typedef short s16x4 __attribute__((ext_vector_type(4)));
typedef float f32x16 __attribute__((ext_vector_type(16)));
typedef float f32x2_t __attribute__((ext_vector_type(2))); typedef __bf16 bf16x2_t __attribute__((ext_vector_type(2)));
__device__ __forceinline__ unsigned cvtpk(float lo, float hi) { f32x2_t v = {lo, hi}; bf16x2_t b = __builtin_convertvector(v, bf16x2_t); return __builtin_bit_cast(unsigned, b); }
__device__ __forceinline__ float bf2f(unsigned short h) { return __uint_as_float((unsigned)h << 16); }
__device__ __forceinline__ float bflo(unsigned w) { return __uint_as_float(w << 16); }
__device__ __forceinline__ float bfhi(unsigned w) { return __uint_as_float(w & 0xffff0000u); }
__device__ __forceinline__ float ex2(float x) { return __builtin_amdgcn_exp2f(x); }
__device__ __forceinline__ float wave_sum(float v) {
#pragma unroll
    for (int o = 1; o < 64; o <<= 1) v += __shfl_xor(v, o);
    return v;
}
__device__ __forceinline__ f32x4 mfma16(bf16x8 a, bf16x8 b, f32x4 c) { return __builtin_amdgcn_mfma_f32_16x16x32_bf16(a, b, c, 0, 0, 0); }
__device__ __forceinline__ f32x16 mfma32(bf16x8 a, bf16x8 b, f32x16 c) { return __builtin_amdgcn_mfma_f32_32x32x16_bf16(a, b, c, 0, 0, 0); }
typedef short v4i16_t __attribute__((ext_vector_type(4)));
__device__ __forceinline__ bf16x8 tr_pair(const LAS unsigned char* p0, const LAS unsigned char* p1) {
    const s16x4 lo = __builtin_bit_cast(s16x4, __builtin_amdgcn_ds_read_tr16_b64_v4i16((LAS v4i16_t*)p0));
    const s16x4 hi = __builtin_bit_cast(s16x4, __builtin_amdgcn_ds_read_tr16_b64_v4i16((LAS v4i16_t*)p1));
    return (bf16x8){lo[0], lo[1], lo[2], lo[3], hi[0], hi[1], hi[2], hi[3]};
}
__device__ __forceinline__ bf16x8 pack_bf8(const f32x4 a, const f32x4 b) { v4u w; w.x = cvtpk(a[0], a[1]); w.y = cvtpk(a[2], a[3]); w.z = cvtpk(b[0], b[1]); w.w = cvtpk(b[2], b[3]); return __builtin_bit_cast(bf16x8, w); }
using pg8::ss_rinv; using pg8::gelu_t;

struct Frame {
    LAS unsigned char* lds;
    volatile LAS unsigned* MISC;
    gu32* ctl;
    int tid, lane, wave, vcu, G;
    const float* const* in; float* out; unsigned char* ws;
};
enum { I_XP = 0, I_XS, I_CK, I_CV, I_PT, I_SRE, I_SIM, I_NMIX, I_NFFN, I_NFIN, I_WIN, I_WOUT, I_SGN, I_SGW, I_SGB, I_LQ1, I_LK1, I_LQ2, I_LK2, I_SUBLN,
       I_ARE, I_AIM, I_LDT, I_BRE, I_BIM, I_CRE, I_CIM, I_SD, I_WGLU, I_BGLU, I_WFI, I_WFO };

__device__ __forceinline__ int map_row(int n0, int NH) { if (NH == 0) return n0; const int hi = n0 >= NH ? 1 : 0, n2 = n0 - hi * NH; return 256 * (n2 >> 7) + 128 * hi + (n2 & 127); }
__device__ __forceinline__ void p0_transpose_item(const float* W, int K, int N, bf16* WT, int NH, const float* gain, LAS float* scr, int item, int lane) {
    const int nblk = N / 32, kb = item / nblk, nb = item % nblk, k0 = 64 * kb, n0 = 32 * nb;
#pragma unroll 8
    for (int i = 0; i < 32; ++i) { const int kk = 2 * i + (lane >> 5); float w = W[(size_t)(k0 + kk) * N + n0 + (lane & 31)]; if (gain) w *= gain[k0 + kk]; scr[kk * 33 + (lane & 31)] = w; }
    LDS_WAIT(); asm volatile("" ::: "memory");
    const int c = lane & 7, r0 = map_row(n0, NH);
#pragma unroll
    for (int j = 0; j < 4; ++j) { const int n = (lane >> 3) + 8 * j; const LAS float* s = scr + (8 * c) * 33 + n;
        v4u o; o.x = pk2(s[0 * 33], s[1 * 33]); o.y = pk2(s[2 * 33], s[3 * 33]); o.z = pk2(s[4 * 33], s[5 * 33]); o.w = pk2(s[6 * 33], s[7 * 33]);
        *(GAS v4u*)(WT + (size_t)(r0 + n) * K + k0 + 8 * c) = o; }
    LDS_WAIT(); asm volatile("" ::: "memory");
}
__device__ __forceinline__ void p0_row(Frame& F, const float* xrow, bf16* orow, float* r) {
    const GAS f32x4* xr = (const GAS f32x4*)xrow + F.lane;
    f32x4 v[4]; float s = 0.f;
#pragma unroll
    for (int j = 0; j < 4; ++j) { v[j] = xr[64 * j]; s += (v[j].x * v[j].x + v[j].y * v[j].y) + (v[j].z * v[j].z + v[j].w * v[j].w); }
    s = wave_sum(s);
    GAS unsigned long long* o8 = (GAS unsigned long long*)orow + F.lane;
#pragma unroll
    for (int j = 0; j < 4; ++j) o8[64 * j] = (unsigned long long)pk2(v[j].x, v[j].y) | ((unsigned long long)pk2(v[j].z, v[j].w) << 32);
    if (F.lane == 0) *r = 1.0f / sqrtf(s * (1.0f / 1024.0f) + EPS);
}
__device__ __forceinline__ void p0_ssm_tables(Frame& F, int g, int q) {
    LAS f32x2_t* pw = (LAS f32x2_t*)(F.lds);
    LAS f32x2_t* cb = pw + 17 * 64;
    LAS f32x2_t* cc = cb + 64 * 16;
    LAS float* KJ = (LAS float*)(cc + 16 * 64);
    LAS f32x2_t* cf = (LAS f32x2_t*)(KJ + 4096);
    const int tid = F.tid;
    const float* a_re = F.in[I_ARE] + g * 64; const float* a_im = F.in[I_AIM] + g * 64;
    const float dt = expf(F.in[I_LDT][g]);
    if (tid < 64) {
        const int p = tid; const float ar = a_re[p], ai = a_im[p], xr = ar * dt, xi = ai * dt;
#pragma unroll 1
        for (int j = 0; j <= 16; ++j) { const float mag = expf((float)j * xr), ang = (float)j * xi; pw[j * 64 + p] = (f32x2_t){mag * cosf(ang), mag * sinf(ang)}; }
        const float sh = sinf(0.5f * xi), nr = expm1f(xr) * cosf(xi) - 2.0f * sh * sh, ni = expf(xr) * sinf(xi), den = 1.0f / (ar * ar + ai * ai);
        cf[p] = (f32x2_t){(nr * ar + ni * ai) * den, (ni * ar - nr * ai) * den};
    }
    __syncthreads();
    const float* b_re = F.in[I_BRE] + (size_t)g * 1024; const float* b_im = F.in[I_BIM] + (size_t)g * 1024;
    const float* c_re = F.in[I_CRE] + (size_t)g * 1024; const float* c_im = F.in[I_CIM] + (size_t)g * 1024;
    for (int i = tid; i < 1024; i += 512) {
        const int p = i >> 4; const f32x2_t c = cf[p]; const float br = b_re[i], bi = b_im[i];
        cb[i] = (f32x2_t){c.x * br - c.y * bi, c.x * bi + c.y * br};
        cc[i] = (f32x2_t){c_re[i], c_im[i]};
    }
    __syncthreads();
    const float* dsk = F.in[I_SD] + g * 16;
#pragma unroll 1
    for (int o = tid; o < 4096; o += 512) {
        const int j = o >> 8, c = (o >> 4) & 15, c2 = o & 15; float s = 0.f;
#pragma unroll 4
        for (int p = 0; p < 64; ++p) { const f32x2_t a = pw[j * 64 + p], b = cb[p * 16 + c2], cv = cc[c * 64 + p];
            const float wr_ = a.x * b.x - a.y * b.y, wi_ = a.x * b.y + a.y * b.x; s += cv.x * wr_ - cv.y * wi_; }
        if (j == 0 && c == c2) s += dsk[c];
        KJ[o] = s;
    }
    __syncthreads();
    const float* g1 = F.in[I_NMIX] + 1024 + g * 16;
    bf16* Tg = (bf16*)(F.ws + WS_T) + (size_t)g * 65536; bf16* Eg = (bf16*)(F.ws + WS_E) + (size_t)g * 32768; bf16* Fg = (bf16*)(F.ws + WS_F) + (size_t)g * 32768;
#pragma unroll 1
    for (int i = 0; i < 4; ++i) { const int idx = tid + 512 * i, row = 64 * q + (idx >> 5), kc = idx & 31, t = row >> 4, c = row & 15, tau = kc >> 1, c0 = 8 * (kc & 1);
        float v[8];
#pragma unroll
        for (int e = 0; e < 8; ++e) v[e] = (t >= tau) ? KJ[((t - tau) * 16 + c) * 16 + c0 + e] * g1[c0 + e] : 0.f;
        v4u o; o.x = pk2(v[0], v[1]); o.y = pk2(v[2], v[3]); o.z = pk2(v[4], v[5]); o.w = pk2(v[6], v[7]);
        *(GAS v4u*)(Tg + (size_t)row * 256 + kc * 8) = o; }
#pragma unroll 1
    for (int i = 0; i < 2; ++i) { const int idx = tid + 512 * i, row = 32 * q + (idx >> 5), kc = idx & 31, ri = row >> 6, p = row & 63, tau = kc >> 1, c0 = 8 * (kc & 1);
        const f32x2_t a = pw[(15 - tau) * 64 + p]; float v[8];
#pragma unroll
        for (int e = 0; e < 8; ++e) { const f32x2_t b = cb[p * 16 + c0 + e]; const float zr = a.x * b.x - a.y * b.y, zi = a.x * b.y + a.y * b.x; v[e] = (ri ? zi : zr) * g1[c0 + e]; }
        v4u o; o.x = pk2(v[0], v[1]); o.y = pk2(v[2], v[3]); o.z = pk2(v[4], v[5]); o.w = pk2(v[6], v[7]);
        *(GAS v4u*)(Eg + (size_t)row * 256 + kc * 8) = o; }
#pragma unroll 1
    for (int i = 0; i < 2; ++i) { const int idx = tid + 512 * i, row = 64 * q + (idx >> 4), kc = idx & 15, t = row >> 4, c = row & 15, ri = kc >> 3, p0 = 8 * (kc & 7);
        float v[8];
#pragma unroll
        for (int e = 0; e < 8; ++e) { const f32x2_t a = pw[(t + 1) * 64 + p0 + e], cv = cc[c * 64 + p0 + e]; const float zr = cv.x * a.x - cv.y * a.y, zi = cv.x * a.y + cv.y * a.x; v[e] = ri ? -zi : zr; }
        v4u o; o.x = pk2(v[0], v[1]); o.y = pk2(v[2], v[3]); o.z = pk2(v[4], v[5]); o.w = pk2(v[6], v[7]);
        *(GAS v4u*)(Fg + (size_t)row * 128 + kc * 8) = o; }
    if (q == 0) {
        f32x2_t* PW1 = (f32x2_t*)(F.ws + WS_PW1) + g * 64; f32x2_t* PW16 = (f32x2_t*)(F.ws + WS_PW16) + g * 64; f32x2_t* BB = (f32x2_t*)(F.ws + WS_BBAR) + (size_t)g * 1024;
        if (tid < 64) { PW1[tid] = pw[64 + tid]; PW16[tid] = pw[16 * 64 + tid]; }
        for (int i = tid; i < 1024; i += 512) BB[i] = cb[i];
    }
    __syncthreads();
}
__device__ __forceinline__ void p0_prologue(Frame& F) {
    const int gw = F.vcu * NWAVES + F.wave, NGW = F.G * NWAVES;
    for (int u = F.vcu; u < 256; u += F.G) p0_ssm_tables(F, u >> 2, u & 3);
    LAS float* scr = (LAS float*)(F.lds + RING_OFF + F.wave * 16384);
    constexpr int I1 = 16 * (2560 / 32), I2 = 16 * (1024 / 32), I5 = 16 * (2048 / 32), I3 = 16 * (5632 / 32), I4 = 44 * (1024 / 32);
    constexpr int NITEMS = I1 + I2 + I5 + 2 * I3 + 2 * I4;
    for (int it = gw; it < NITEMS; it += NGW) {
        int r = it;
        if (r < I1) { p0_transpose_item(F.in[I_WIN], 1024, 2560, (bf16*)(F.ws + WS_W1), 0, F.in[I_NMIX], scr, r, F.lane); continue; } r -= I1;
        if (r < I2) { p0_transpose_item(F.in[I_WOUT], 1024, 1024, (bf16*)(F.ws + WS_W2), 0, nullptr, scr, r, F.lane); continue; } r -= I2;
        if (r < I5) { p0_transpose_item(F.in[I_WGLU], 1024, 2048, (bf16*)(F.ws + WS_W5), 1024, nullptr, scr, r, F.lane); continue; } r -= I5;
        if (r < I3) { p0_transpose_item(F.in[I_WFI], 1024, 5632, (bf16*)(F.ws + WS_W3), 2816, F.in[I_NFFN], scr, r, F.lane); continue; } r -= I3;
        if (r < I3) { p0_transpose_item(F.in[I_WFI] + (size_t)1024 * 5632, 1024, 5632, (bf16*)(F.ws + WS_W6), 2816, F.in[I_NFFN] + 1024, scr, r, F.lane); continue; } r -= I3;
        if (r < I4) { p0_transpose_item(F.in[I_WFO], 2816, 1024, (bf16*)(F.ws + WS_W4), 0, nullptr, scr, r, F.lane); continue; } r -= I4;
        p0_transpose_item(F.in[I_WFO] + (size_t)2816 * 1024, 2816, 1024, (bf16*)(F.ws + WS_W7), 0, nullptr, scr, r, F.lane);
    }
    bf16* XB = (bf16*)(F.ws + WS_XB); float* R0 = (float*)(F.ws + WS_R0);
    for (int m = gw; m < NTOK; m += NGW) p0_row(F, m < NP ? F.in[I_XP] + (size_t)m * 1024 : F.in[I_XS] + (size_t)(m - NP) * 1024, XB + (size_t)m * 1024, R0 + m);
    bf16* WT = (bf16*)(F.ws + WS_WTRIL); const float* sw = F.in[I_SGW];
    for (int i = gw * 64 + F.lane; i < 8192; i += NGW * 64) { const int e0 = i * 8, t = (e0 >> 7) & 127, s0 = e0 & 127; float v[8];
#pragma unroll
        for (int e = 0; e < 8; ++e) v[e] = (s0 + e <= t) ? sw[e0 + e] : 0.f;
        v4u o; o.x = pk2(v[0], v[1]); o.y = pk2(v[2], v[3]); o.z = pk2(v[4], v[5]); o.w = pk2(v[6], v[7]); *(GAS v4u*)(WT + e0) = o; }
}
__device__ __forceinline__ float lambda_val(Frame& F) {
    const int l = F.lane; const float a = wave_sum(F.in[I_LQ1][l] * F.in[I_LK1][l]), b = wave_sum(F.in[I_LQ2][l] * F.in[I_LK2][l]);
    return expf(a) - expf(b) + LAM_INIT;
}
#define LAUNDER_TID() int tid = F.tid; asm volatile("" : "+v"(tid)); const int lane = tid & 63, wave = __builtin_amdgcn_readfirstlane(tid >> 6); (void)lane; (void)wave
__device__ __forceinline__ void sgu_prompt_unit(Frame& F, int chunk, int g) {
    LAUNDER_TID();
    const bf16* U = (const bf16*)(F.ws + WS_U); const bf16* VR = (const bf16*)(F.ws + WS_VR); bf16* CB = (bf16*)(F.ws + WS_CB);
    const unsigned long long* vss = (const unsigned long long*)(F.ws + WS_SS);
    const bf16* WT = (const bf16*)(F.ws + WS_WTRIL) + (size_t)g * 16384;
    const float* gn = F.in[I_SGN] + g * 128; const float* bias = F.in[I_SGB] + g * 128;
    LAS unsigned short* vT = (LAS unsigned short*)F.lds;
    const size_t tok0 = (size_t)chunk * 128;
    {
        const int s = tid >> 2, c0 = 32 * (tid & 3); const float rv = ss_rinv(vss + tok0 + s, 1.0f / 512.0f);
        const v4u* src = (const v4u*)(VR + (tok0 + s) * 512 + g * 128 + c0);
#pragma unroll
        for (int i = 0; i < 4; ++i) { const v4u w = src[i]; const unsigned ww[4] = {w.x, w.y, w.z, w.w};
#pragma unroll
            for (int e = 0; e < 4; ++e) { const int c = c0 + 8 * i + 2 * e; const float a = bflo(ww[e]) * rv * gn[c], b = bfhi(ww[e]) * rv * gn[c + 1];
                vT[c * 136 + s] = (unsigned short)f2bf(a); vT[(c + 1) * 136 + s] = (unsigned short)f2bf(b); } }
    }
    __syncthreads();
    const int mb = wave & 3, nh = wave >> 2, r32 = lane & 31, hi = lane >> 5;
    f32x16 acc[2]; acc[0] = (f32x16){}; acc[1] = (f32x16){};
    for (int ks = 0; ks < 2 * mb + 2; ++ks) {
        const bf16x8 a = *(const bf16x8*)(WT + (32 * mb + r32) * 128 + 16 * ks + 8 * hi);
#pragma unroll
        for (int j = 0; j < 2; ++j) { const bf16x8 b = *(const LAS bf16x8*)((const LAS unsigned char*)vT + ((64 * nh + 32 * j + r32) * 136 + 16 * ks + 8 * hi) * 2); acc[j] = mfma32(a, b, acc[j]); }
    }
#pragma unroll
    for (int j = 0; j < 2; ++j) { const int d = g * 128 + 64 * nh + 32 * j + r32;
#pragma unroll
        for (int r = 0; r < 16; ++r) { const int t = 32 * mb + (r & 3) + 8 * (r >> 2) + 4 * hi; const size_t o = (tok0 + t) * 512 + d;
            const float val = bf2f(U[o]) * (acc[j][r] + bias[t]); CB[(tok0 + t) * 1024 + d] = (bf16)f2bf(val); } }
    __syncthreads();
}
__device__ __forceinline__ void sgu_sample_unit(Frame& F, int b) {
    LAUNDER_TID(); const int c = tid, g = c >> 7; const bf16* U = (const bf16*)(F.ws + WS_U); const bf16* VR = (const bf16*)(F.ws + WS_VR); bf16* CB = (bf16*)(F.ws + WS_CB);
    const unsigned long long* vss = (const unsigned long long*)(F.ws + WS_SS);
    const float gn = F.in[I_SGN][c]; const float* W = F.in[I_SGW] + (size_t)g * 16384; const float* bias = F.in[I_SGB] + g * 128;
    float v[8];
#pragma unroll
    for (int t = 0; t < 8; ++t) { const size_t tok = NP + 8 * b + t; v[t] = bf2f(VR[tok * 512 + c]) * ss_rinv(vss + tok, 1.0f / 512.0f) * gn; F.out[OFF_CV + (size_t)(8 * b + t) * 512 + c] = v[t]; }
#pragma unroll
    for (int t = 0; t < 8; ++t) { float s = bias[t];
#pragma unroll
        for (int k = 0; k <= t; ++k) s += W[t * 128 + k] * v[k];
        const size_t tok = NP + 8 * b + t; CB[tok * 1024 + c] = (bf16)f2bf(bf2f(U[tok * 512 + c]) * s); }
}

struct Soft16 { float m, l; };
__device__ __forceinline__ void smax_update(f32x4 (&s)[4], Soft16& st, f32x4 (&O)[8], bf16x8& pf0, bf16x8& pf1) {
    float mx = fmaxf(fmaxf(s[0][0], s[0][1]), fmaxf(s[0][2], s[0][3]));
#pragma unroll
    for (int i = 1; i < 4; ++i) mx = fmaxf(mx, fmaxf(fmaxf(s[i][0], s[i][1]), fmaxf(s[i][2], s[i][3])));
    mx = fmaxf(mx, __shfl_xor(mx, 16)); mx = fmaxf(mx, __shfl_xor(mx, 32));
    const float mn = fmaxf(st.m, mx), al = ex2(st.m - mn); st.m = mn; float sum = 0.f;
#pragma unroll
    for (int i = 0; i < 4; ++i)
#pragma unroll
        for (int r = 0; r < 4; ++r) { s[i][r] = ex2(s[i][r] - mn); sum += s[i][r]; }
    st.l = st.l * al + sum;
#pragma unroll
    for (int nb = 0; nb < 8; ++nb) O[nb] = O[nb] * al;
    pf0 = pack_bf8(s[0], s[1]); pf1 = pack_bf8(s[2], s[3]);
}
__device__ __forceinline__ void attn_prompt_unit(Frame& F, float lam, int b, int h, int qb) {
    LAUNDER_TID(); const int g = lane >> 4, li = lane & 15;
    const bf16* QB = (const bf16*)(F.ws + WS_QB); const bf16* KB = (const bf16*)(F.ws + WS_KB); const bf16* VB = (const bf16*)(F.ws + WS_VB); bf16* CB = (bf16*)(F.ws + WS_CB);
    const size_t rowbase = (size_t)b * SEQ; const int qrel = 16 * wave + li; const size_t qtok = rowbase + 128 * qb + qrel;
    bf16x8 qf[4];
#pragma unroll
    for (int s = 0; s < 4; ++s) qf[s] = *(const bf16x8*)(QB + qtok * 512 + h * 128 + 32 * s + 8 * g);
    const int nt = 2 * qb + 2;
    const int skey = tid >> 4, sch = tid & 15;
    const bf16* kg = KB + (rowbase + skey) * 512 + h * 128 + 8 * sch; const bf16* vg = VB + (rowbase + skey) * 512 + h * 128 + 8 * sch;
    const int kw0 = skey * 256 + ((sch ^ (skey & 15)) << 4), vw0 = skey * 256 + (((sch >> 1) ^ (skey & 7)) << 5) + (sch & 1) * 16;
    LAS unsigned char* L = F.lds;
    int kad[4];
#pragma unroll
    for (int s = 0; s < 4; ++s) kad[s] = li * 256 + (((4 * s + g) ^ li) << 4);
    const int vq = li >> 2, vp = li & 3, vk7 = (4 * g + vq) & 7; int vad[8];
#pragma unroll
    for (int nb = 0; nb < 8; ++nb) vad[nb] = (4 * g + vq) * 256 + ((nb ^ vk7) << 5) + 8 * vp;
    f32x4 O1[8], O2[8]; Soft16 st1{-1e30f, 0.f}, st2{-1e30f, 0.f};
#pragma unroll
    for (int nb = 0; nb < 8; ++nb) { O1[nb] = (f32x4){0.f, 0.f, 0.f, 0.f}; O2[nb] = (f32x4){0.f, 0.f, 0.f, 0.f}; }
    v4u kr0, kr1, vr0, vr1;
    kr0 = *(const v4u*)kg; kr1 = *(const v4u*)(kg + 32 * 512); vr0 = *(const v4u*)vg; vr1 = *(const v4u*)(vg + 32 * 512);
    *(LAS v4u*)(L + kw0) = kr0; *(LAS v4u*)(L + kw0 + 32 * 256) = kr1; *(LAS v4u*)(L + 16384 + vw0) = vr0; *(LAS v4u*)(L + 16384 + vw0 + 32 * 256) = vr1;
    __syncthreads();
    for (int t = 0; t < nt; ++t) {
        const int bo = (t & 1) * 32768;
        if (t + 1 < nt) { const size_t go = (size_t)(t + 1) * 64 * 512; kr0 = *(const v4u*)(kg + go); kr1 = *(const v4u*)(kg + go + 32 * 512); vr0 = *(const v4u*)(vg + go); vr1 = *(const v4u*)(vg + go + 32 * 512); }
        if (!(t == nt - 1 && wave < 4)) {
            const LAS unsigned char* Kt = L + bo; const LAS unsigned char* Vt = L + bo + 16384;
            f32x4 s1[4], s2[4];
#pragma unroll
            for (int sub = 0; sub < 4; ++sub) {
                const bf16x8 k0 = *(const LAS bf16x8*)(Kt + sub * 4096 + kad[0]), k1 = *(const LAS bf16x8*)(Kt + sub * 4096 + kad[1]);
                const bf16x8 k2 = *(const LAS bf16x8*)(Kt + sub * 4096 + kad[2]), k3 = *(const LAS bf16x8*)(Kt + sub * 4096 + kad[3]);
                s1[sub] = mfma16(k0, qf[0], (f32x4){0.f, 0.f, 0.f, 0.f}); s1[sub] = mfma16(k1, qf[1], s1[sub]);
                s2[sub] = mfma16(k2, qf[2], (f32x4){0.f, 0.f, 0.f, 0.f}); s2[sub] = mfma16(k3, qf[3], s2[sub]);
            }
            if (t >= nt - 2) {
                const int kb0 = 64 * (t - 2 * qb) + 4 * g;
#pragma unroll
                for (int sub = 0; sub < 4; ++sub)
#pragma unroll
                    for (int r = 0; r < 4; ++r) if (kb0 + 16 * sub + r > qrel) { s1[sub][r] = -__builtin_inff(); s2[sub][r] = -__builtin_inff(); }
            }
            bf16x8 p1a, p1b, p2a, p2b;
            smax_update(s1, st1, O1, p1a, p1b); smax_update(s2, st2, O2, p2a, p2b);
#pragma unroll
            for (int nb = 0; nb < 8; ++nb) {
                const bf16x8 va = tr_pair(Vt + vad[nb], Vt + vad[nb] + 16 * 256), vb = tr_pair(Vt + vad[nb] + 32 * 256, Vt + vad[nb] + 48 * 256);
                O1[nb] = mfma16(va, p1a, O1[nb]); O2[nb] = mfma16(va, p2a, O2[nb]);
                O1[nb] = mfma16(vb, p1b, O1[nb]); O2[nb] = mfma16(vb, p2b, O2[nb]);
            }
        }
        if (t + 1 < nt) { const int wo = ((t + 1) & 1) * 32768; *(LAS v4u*)(L + wo + kw0) = kr0; *(LAS v4u*)(L + wo + kw0 + 32 * 256) = kr1; *(LAS v4u*)(L + wo + 16384 + vw0) = vr0; *(LAS v4u*)(L + wo + 16384 + vw0 + 32 * 256) = vr1; }
        __syncthreads();
    }
    float l1 = st1.l; l1 += __shfl_xor(l1, 16); l1 += __shfl_xor(l1, 32);
    float l2 = st2.l; l2 += __shfl_xor(l2, 16); l2 += __shfl_xor(l2, 32);
    const float i1 = 1.0f / l1, i2 = lam / l2; float ssq = 0.f;
#pragma unroll
    for (int nb = 0; nb < 8; ++nb)
#pragma unroll
        for (int r = 0; r < 4; ++r) { const float o = O1[nb][r] * i1 - O2[nb][r] * i2; O1[nb][r] = o; ssq += o * o; }
    ssq += __shfl_xor(ssq, 16); ssq += __shfl_xor(ssq, 32);
    const float rn = (1.0f - LAM_INIT) / sqrtf(ssq * (1.0f / 128.0f) + EPS);
    const float* sub = F.in[I_SUBLN];
#pragma unroll
    for (int nb = 0; nb < 8; ++nb) { const int dv = 16 * nb + 4 * g; const f32x4 sg = *(const f32x4*)(sub + dv);
        const unsigned w0 = cvtpk(O1[nb][0] * rn * sg[0], O1[nb][1] * rn * sg[1]), w1 = cvtpk(O1[nb][2] * rn * sg[2], O1[nb][3] * rn * sg[3]);
        *(unsigned long long*)(CB + qtok * 1024 + 512 + h * 128 + dv) = (unsigned long long)w0 | ((unsigned long long)w1 << 32); }
}

__device__ __forceinline__ void attn_sample_unit(Frame& F, int b, int rg) {
    LAUNDER_TID(); const int g = lane >> 4, li = lane & 15, head = wave & 3, hf = wave >> 2;
    const bf16* QB = (const bf16*)(F.ws + WS_QB); const float* CK = F.in[I_CK]; const float* CV = F.in[I_CV]; const int* PT = (const int*)F.in[I_PT] + b * 64 + 8 * rg + 4 * hf;
    bf16x8 qf[4];
    { const int qi = li & 7, half = li >> 3; const bf16* qrow = QB + (size_t)(NP + 8 * b + qi) * 512 + head * 128;
#pragma unroll
      for (int s = 0; s < 4; ++s) { bf16x8 z = (bf16x8){0, 0, 0, 0, 0, 0, 0, 0}; if ((s >> 1) == half) z = *(const bf16x8*)(qrow + 32 * s + 8 * g); qf[s] = z; } }
    LAS unsigned char* Kt = F.lds + wave * 16384; LAS unsigned char* Vt = Kt + 8192;
    const int l31 = lane & 31, lh = lane >> 5;
    const int kwr = ((l31 >> 1) << 4) + (l31 & 1) * 8;
    const int vwu = l31 >> 2, vwo = (l31 & 3) * 8;
    int kad[4];
#pragma unroll
    for (int s = 0; s < 4; ++s) kad[s] = li * 256 + (((4 * s + g) ^ li) << 4);
    const int vq = li >> 2, vp = li & 3, vk7 = (4 * g + vq) & 7; int vad[8];
#pragma unroll
    for (int nb = 0; nb < 8; ++nb) vad[nb] = (4 * g + vq) * 256 + ((nb ^ vk7) << 5) + 8 * vp;
    f32x4 O[8]; Soft16 st{-1e30f, 0.f};
#pragma unroll
    for (int nb = 0; nb < 8; ++nb) O[nb] = (f32x4){0.f, 0.f, 0.f, 0.f};
    f32x4 kr[16], vr[16];
#define SLOAD(t) do { const int phys_ = __builtin_amdgcn_readfirstlane(PT[(t) >> 2]); const size_t e0_ = (((size_t)phys_ * 128 + 32 * ((t) & 3) + lh) * 4 + head) * 128 + 4 * l31; \
        _Pragma("unroll") for (int i_ = 0; i_ < 16; ++i_) { kr[i_] = __builtin_nontemporal_load((const f32x4*)(CK + e0_ + (size_t)i_ * 1024)); vr[i_] = __builtin_nontemporal_load((const f32x4*)(CV + e0_ + (size_t)i_ * 1024)); } } while (0)
    SLOAD(0);
#pragma unroll 1
    for (int t = 0; t < 16; ++t) {
#pragma unroll
        for (int i = 0; i < 16; ++i) { const int key = 2 * i + lh;
            *(LAS unsigned long long*)(Kt + key * 256 + (kwr ^ ((key & 15) << 4))) = (unsigned long long)cvtpk(kr[i][0], kr[i][1]) | ((unsigned long long)cvtpk(kr[i][2], kr[i][3]) << 32);
            *(LAS unsigned long long*)(Vt + key * 256 + ((vwu ^ (key & 7)) << 5) + vwo) = (unsigned long long)cvtpk(vr[i][0], vr[i][1]) | ((unsigned long long)cvtpk(vr[i][2], vr[i][3]) << 32); }
        if (t + 1 < 16) SLOAD(t + 1);
        f32x4 s[2];
#pragma unroll
        for (int sub = 0; sub < 2; ++sub) {
            s[sub] = (f32x4){0.f, 0.f, 0.f, 0.f};
#pragma unroll
            for (int ks = 0; ks < 4; ++ks) s[sub] = mfma16(*(const LAS bf16x8*)(Kt + sub * 4096 + kad[ks]), qf[ks], s[sub]);
        }
        float mx = fmaxf(fmaxf(fmaxf(s[0][0], s[0][1]), fmaxf(s[0][2], s[0][3])), fmaxf(fmaxf(s[1][0], s[1][1]), fmaxf(s[1][2], s[1][3])));
        mx = fmaxf(mx, __shfl_xor(mx, 16)); mx = fmaxf(mx, __shfl_xor(mx, 32));
        const float mn = fmaxf(st.m, mx), al = ex2(st.m - mn); st.m = mn; float sum = 0.f;
#pragma unroll
        for (int i = 0; i < 2; ++i)
#pragma unroll
            for (int r = 0; r < 4; ++r) { s[i][r] = ex2(s[i][r] - mn); sum += s[i][r]; }
        st.l = st.l * al + sum;
        const bf16x8 pf = pack_bf8(s[0], s[1]);
#pragma unroll
        for (int nb = 0; nb < 8; ++nb) { const bf16x8 va = tr_pair(Vt + vad[nb], Vt + vad[nb] + 16 * 256); O[nb] = mfma16(va, pf, O[nb] * al); }
    }
#undef SLOAD
    float l = st.l; l += __shfl_xor(l, 16); l += __shfl_xor(l, 32);
    float* P = (float*)(F.ws + WS_PART) + ((size_t)(b * 4 + head) * 16 + 2 * rg + hf) * PART_STRIDE;
    if (g == 0) { P[li] = st.m; P[16 + li] = l; }
#pragma unroll
    for (int nb = 0; nb < 8; ++nb) *(f32x4*)(P + 32 + li * 128 + 16 * nb + 4 * g) = O[nb];
}
__device__ __forceinline__ void attn_sample_combine(Frame& F, float lam, int b, int head) {
    LAUNDER_TID(); const int qp = tid >> 5, dvc = tid & 31, qi = qp & 7, half = qp >> 3, dv = 4 * dvc;
    const bf16* QB = (const bf16*)(F.ws + WS_QB); const bf16* KB = (const bf16*)(F.ws + WS_KB); const bf16* VB = (const bf16*)(F.ws + WS_VB); bf16* CB = (bf16*)(F.ws + WS_CB);
    const float* P = (const float*)(F.ws + WS_PART) + (size_t)(b * 4 + head) * 16 * PART_STRIDE;
    float M = -1e30f;
    for (int sl = 0; sl < 16; ++sl) M = fmaxf(M, P[sl * PART_STRIDE + qp]);
    const size_t tq = NP + 8 * b + qi; const bf16* qrow = QB + tq * 512 + head * 128 + 64 * half;
    float sc[8];
#pragma unroll
    for (int j = 0; j < 8; ++j) { const bf16* krow = KB + (size_t)(NP + 8 * b + j) * 512 + head * 128 + 64 * half; float d = 0.f;
#pragma unroll 2
        for (int e = 0; e < 8; ++e) { const v4u a = *(const v4u*)(qrow + 8 * e), k = *(const v4u*)(krow + 8 * e);
            d += (bflo(a.x) * bflo(k.x) + bfhi(a.x) * bfhi(k.x)) + (bflo(a.y) * bflo(k.y) + bfhi(a.y) * bfhi(k.y)) + (bflo(a.z) * bflo(k.z) + bfhi(a.z) * bfhi(k.z)) + (bflo(a.w) * bflo(k.w) + bfhi(a.w) * bfhi(k.w)); }
        sc[j] = (j <= qi) ? d : -__builtin_inff(); M = fmaxf(M, sc[j]); }
    float Lacc = 0.f; f32x4 Oa = (f32x4){0.f, 0.f, 0.f, 0.f};
    for (int sl = 0; sl < 16; ++sl) { const float w = ex2(P[sl * PART_STRIDE + qp] - M); Lacc += w * P[sl * PART_STRIDE + 16 + qp]; Oa = Oa + *(const f32x4*)(P + sl * PART_STRIDE + 32 + qp * 128 + dv) * w; }
#pragma unroll
    for (int j = 0; j < 8; ++j) { const float p = ex2(sc[j] - M); Lacc += p; const float pb = bf2f((unsigned short)f2bf(p));
        const bf16* vrow = VB + (size_t)(NP + 8 * b + j) * 512 + head * 128 + dv;
        Oa[0] += pb * bf2f(vrow[0]); Oa[1] += pb * bf2f(vrow[1]); Oa[2] += pb * bf2f(vrow[2]); Oa[3] += pb * bf2f(vrow[3]); }
    LAS float* buf = (LAS float*)F.lds;
    const float inv = 1.0f / Lacc;
    *(LAS f32x4*)(buf + (half * 8 + qi) * 128 + dv) = Oa * inv;
    __syncthreads();
    if (half == 0) {
        const f32x4 a = *(const LAS f32x4*)(buf + qi * 128 + dv), c = *(const LAS f32x4*)(buf + (8 + qi) * 128 + dv); const f32x4 o = a - c * lam;
        float ssq = (o[0] * o[0] + o[1] * o[1]) + (o[2] * o[2] + o[3] * o[3]);
#pragma unroll
        for (int x = 1; x < 32; x <<= 1) ssq += __shfl_xor(ssq, x);
        const float rn = (1.0f - LAM_INIT) / sqrtf(ssq * (1.0f / 128.0f) + EPS); const f32x4 sg = *(const f32x4*)(F.in[I_SUBLN] + dv);
        const unsigned w0 = cvtpk(o[0] * rn * sg[0], o[1] * rn * sg[1]), w1 = cvtpk(o[2] * rn * sg[2], o[3] * rn * sg[3]);
        *(unsigned long long*)(CB + tq * 1024 + 512 + head * 128 + dv) = (unsigned long long)w0 | ((unsigned long long)w1 << 32);
    }
    __syncthreads();
}

__device__ __forceinline__ void ssm_prompt_unit(Frame& F, int b, int g) {
    LAUNDER_TID(); const int n = lane & 31, hi = lane >> 5, chunk = 32 * wave + n;
    const bf16* XB = (const bf16*)(F.ws + WS_XB); bf16* G = (bf16*)(F.ws + WS_CB);
    const unsigned long long* ss2 = (const unsigned long long*)(F.ws + WS_SS) + 2 * (size_t)NTOK;
    const bf16* Tg = (const bf16*)(F.ws + WS_T) + (size_t)g * 65536; const bf16* Eg = (const bf16*)(F.ws + WS_E) + (size_t)g * 32768; const bf16* Fg = (const bf16*)(F.ws + WS_F) + (size_t)g * 32768;
    LAS float* S = (LAS float*)F.lds;
    const size_t tok0 = (size_t)b * SEQ + 16 * chunk;
    bf16x8 uf[16];
#pragma unroll
    for (int ks = 0; ks < 16; ++ks) { const size_t tok = tok0 + ks; const v4u w = *(const v4u*)(XB + tok * 1024 + 16 * g + 8 * hi); const float r = ss_rinv(ss2 + tok, 1.0f / 1024.0f);
        v4u o; o.x = cvtpk(bflo(w.x) * r, bfhi(w.x) * r); o.y = cvtpk(bflo(w.y) * r, bfhi(w.y) * r); o.z = cvtpk(bflo(w.z) * r, bfhi(w.z) * r); o.w = cvtpk(bflo(w.w) * r, bfhi(w.w) * r);
        uf[ks] = __builtin_bit_cast(bf16x8, o); }
#pragma unroll 1
    for (int mb = 0; mb < 4; ++mb) {
        f32x16 acc = (f32x16){};
#pragma unroll
        for (int ks = 0; ks < 16; ++ks) acc = mfma32(*(const bf16x8*)(Eg + (32 * mb + n) * 256 + 16 * ks + 8 * hi), uf[ks], acc);
#pragma unroll
        for (int i = 0; i < 4; ++i) *(LAS f32x4*)(S + chunk * 132 + 32 * mb + 8 * i + 4 * hi) = (f32x4){acc[4 * i], acc[4 * i + 1], acc[4 * i + 2], acc[4 * i + 3]};
    }
    __syncthreads();
    if (wave == 0) {
        const f32x2_t aL = ((const f32x2_t*)(F.ws + WS_PW16))[g * 64 + lane]; float sr = 0.f, si = 0.f;
#pragma unroll 8
        for (int c = 0; c < 256; ++c) { const float lr = S[c * 132 + lane], li_ = S[c * 132 + 64 + lane]; S[c * 132 + lane] = sr; S[c * 132 + 64 + lane] = si;
            const float nr = aL.x * sr - aL.y * si + lr, ni = aL.x * si + aL.y * sr + li_; sr = nr; si = ni; }
        F.out[OFF_SRP + (size_t)(b * 64 + g) * 64 + lane] = sr; F.out[OFF_SIP + (size_t)(b * 64 + g) * 64 + lane] = si;
    }
    __syncthreads();
    bf16x8 sf[8];
#pragma unroll
    for (int ks = 0; ks < 8; ++ks) { const f32x4 a = *(const LAS f32x4*)(S + chunk * 132 + 16 * ks + 8 * hi), c = *(const LAS f32x4*)(S + chunk * 132 + 16 * ks + 8 * hi + 4); sf[ks] = pack_bf8(a, c); }
#pragma unroll
    for (int mb = 0; mb < 8; ++mb) {
        f32x16 acc = (f32x16){};
#pragma unroll
        for (int ks = 0; ks < 16; ++ks) if (ks <= 2 * mb + 1) acc = mfma32(*(const bf16x8*)(Tg + (32 * mb + n) * 256 + 16 * ks + 8 * hi), uf[ks], acc);
#pragma unroll
        for (int ks = 0; ks < 8; ++ks) acc = mfma32(*(const bf16x8*)(Fg + (32 * mb + n) * 128 + 16 * ks + 8 * hi), sf[ks], acc);
#pragma unroll
        for (int i = 0; i < 4; ++i) { const int t = 2 * mb + (i >> 1), c = 8 * (i & 1) + 4 * hi;
            const unsigned w0 = cvtpk(gelu_t(acc[4 * i]), gelu_t(acc[4 * i + 1])), w1 = cvtpk(gelu_t(acc[4 * i + 2]), gelu_t(acc[4 * i + 3]));
            *(unsigned long long*)(G + (tok0 + t) * 1024 + 16 * g + c) = (unsigned long long)w0 | ((unsigned long long)w1 << 32); }
    }
    __syncthreads();
}
__device__ __forceinline__ void ssm_sample_unit(Frame& F, int b, int g) {
    LAUNDER_TID(); const int p = lane; const bf16* XB = (const bf16*)(F.ws + WS_XB); bf16* G = (bf16*)(F.ws + WS_CB);
    const unsigned long long* ss2 = (const unsigned long long*)(F.ws + WS_SS) + 2 * (size_t)NTOK;
    const f32x2_t a = ((const f32x2_t*)(F.ws + WS_PW1))[g * 64 + p]; const f32x2_t* BB = (const f32x2_t*)(F.ws + WS_BBAR) + (size_t)g * 1024 + p * 16;
    const float* c_re = F.in[I_CRE] + (size_t)g * 1024; const float* c_im = F.in[I_CIM] + (size_t)g * 1024; const float* g1 = F.in[I_NMIX] + 1024 + 16 * g; const float* dsk = F.in[I_SD] + 16 * g;
    float sr = F.in[I_SRE][(size_t)(b * 64 + g) * 64 + p], si = F.in[I_SIM][(size_t)(b * 64 + g) * 64 + p];
    f32x2_t bb[16];
#pragma unroll
    for (int c = 0; c < 16; ++c) bb[c] = BB[c];
#pragma unroll 1
    for (int t = 0; t < 8; ++t) {
        const size_t tok = NP + 8 * b + t; const float r = ss_rinv(ss2 + tok, 1.0f / 1024.0f); float u[16]; float br = 0.f, bi = 0.f;
#pragma unroll
        for (int c = 0; c < 16; ++c) { u[c] = bf2f(XB[tok * 1024 + 16 * g + c]) * r * g1[c]; br += bb[c].x * u[c]; bi += bb[c].y * u[c]; }
        const float nr = a.x * sr - a.y * si + br, ni = a.x * si + a.y * sr + bi; sr = nr; si = ni;
        float yv = 0.f;
#pragma unroll
        for (int c = 0; c < 16; ++c) { const float y = wave_sum(c_re[c * 64 + p] * sr - c_im[c * 64 + p] * si) + dsk[c] * u[c]; if (p == c) yv = y; }
        if (p < 16) G[tok * 1024 + 16 * g + p] = (bf16)f2bf(gelu_t(yv));
    }
    F.out[OFF_SRS + (size_t)(b * 64 + g) * 64 + p] = sr; F.out[OFF_SIS + (size_t)(b * 64 + g) * 64 + p] = si;
}

template <int MODE>
__device__ __forceinline__ void sample_gemm_tile(Frame& F, const bf16* A, const bf16* Bt, int K, int tile, const float* res, const float* bglu, float* X, bf16* XB, unsigned long long* ss) {
    LAUNDER_TID();
    const int rb = tile >> 5, cb = tile & 31, r32 = lane & 31, hi = lane >> 5, kper = K >> 3, k0 = wave * kper;
    const bf16* ap = A + (size_t)(32 * rb + r32) * K + k0 + 8 * hi;
    const int brow = MODE == 0 ? 32 * cb + r32 : 256 * (cb >> 2) + 32 * (cb & 3) + r32;
    const bf16* bp = Bt + (size_t)brow * K + k0 + 8 * hi;
    f32x16 acc = (f32x16){}, acc2 = (f32x16){};
    const int nks = kper >> 4;
#pragma unroll 8
    for (int ks = 0; ks < nks; ++ks) { const bf16x8 a = *(const bf16x8*)(ap + 16 * ks); const bf16x8 b = *(const bf16x8*)(bp + 16 * ks); acc = mfma32(a, b, acc);
        if (MODE == 1) { const bf16x8 b2 = *(const bf16x8*)(bp + (size_t)128 * K + 16 * ks); acc2 = mfma32(a, b2, acc2); } }
    LAS float* red = (LAS float*)F.lds;
#pragma unroll
    for (int r = 0; r < 16; ++r) { red[(wave * 16 + r) * 64 + lane] = acc[r]; if (MODE == 1) red[8192 + (wave * 16 + r) * 64 + lane] = acc2[r]; }
    __syncthreads();
#pragma unroll
    for (int h2 = 0; h2 < 2; ++h2) {
        const int r = (tid >> 6) + 8 * h2, l2 = tid & 63; float sum = 0.f, sum2 = 0.f;
#pragma unroll
        for (int w = 0; w < 8; ++w) { sum += red[(w * 16 + r) * 64 + l2]; if (MODE == 1) sum2 += red[8192 + (w * 16 + r) * 64 + l2]; }
        const int row = 32 * rb + (r & 3) + 8 * (r >> 2) + 4 * (l2 >> 5), col = 32 * cb + (l2 & 31); const size_t go = (size_t)(NP + row) * 1024 + col;
        float o;
        if (MODE == 0) o = res[(size_t)row * 1024 + col] + sum;
        else o = X[go] + (sum + bglu[col]) * pg8::sigm(sum2 + bglu[1024 + col]);
        X[go] = o; if (XB) XB[go] = (bf16)f2bf(o);
        float ssq = o * o;
#pragma unroll
        for (int x = 1; x < 32; x <<= 1) ssq += __shfl_xor(ssq, x);
        if ((l2 & 31) == 0) pg8::ss_add(ss + NP + row, ssq);
    }
    __syncthreads();
}
__device__ __forceinline__ void final_norm_row(Frame& F, int m) {
    LAUNDER_TID(); const float* X = (const float*)(F.ws + WS_X) + (size_t)m * 1024; const unsigned long long* ss4 = (const unsigned long long*)(F.ws + WS_SS) + 4 * (size_t)NTOK;
    const float r = ss_rinv(ss4 + m, 1.0f / 1024.0f); const float* gf = F.in[I_NFIN]; float* o = F.out + OFF_YP + (size_t)m * 1024;
#pragma unroll
    for (int j = 0; j < 4; ++j) { const int c = 4 * lane + 256 * j; const f32x4 v = *(const f32x4*)(X + c), gg = *(const f32x4*)(gf + c); *(f32x4*)(o + c) = v * gg * r; }
}
#ifndef MK_LAST_PHASE
#define MK_LAST_PHASE 99
#endif
#ifndef MK_REP_ATTNP
#define MK_REP_ATTNP 1
#endif
#ifndef MK_REP_ATTNS
#define MK_REP_ATTNS 1
#endif
#ifndef MK_REP_SGU
#define MK_REP_SGU 1
#endif
#ifndef MK_REP_SSM
#define MK_REP_SSM 1
#endif
#ifndef MK_REP_G3
#define MK_REP_G3 1
#endif
#ifndef MK_REP_P0
#define MK_REP_P0 1
#endif
struct Args { const float* in[32]; float* out; unsigned char* ws; };
__global__ void __launch_bounds__(NWAVES * 64, 2) hyb_fwd(Args args) {
    extern __shared__ __attribute__((aligned(16))) unsigned char lds[];
    Frame F;
    F.lds = (LAS unsigned char*)lds;
    F.MISC = (volatile LAS unsigned*)(F.lds + MISC_OFF);
    F.tid = threadIdx.x; F.lane = F.tid & 63; F.wave = __builtin_amdgcn_readfirstlane(F.tid >> 6);
    F.G = gridDim.x; { const int bx = blockIdx.x; F.vcu = (F.G % 8 == 0) ? (bx % 8) * (F.G / 8) + bx / 8 : bx; }
    F.in = args.in;
    F.out = args.out; F.ws = args.ws; F.ctl = (gu32*)(args.ws + WS_CTL);
    for (int u = F.tid; u < (LDS_BYTES - LDSCTL_OFF) / 4; u += NWAVES * 64) ((LAS unsigned*)(F.lds + LDSCTL_OFF))[u] = 0u;
    __syncthreads();
    XcdBarrier bar = xcd_barrier_post((unsigned*)(F.ctl + CW_BAR), F.MISC + 8);
#define GRID_BAR() xcd_barrier(bar)
    unsigned char* ws = F.ws;
    bf16* XB = (bf16*)(ws + WS_XB); float* X = (float*)(ws + WS_X); bf16* CB = (bf16*)(ws + WS_CB); bf16* ACT = (bf16*)(ws + WS_ACT);
    unsigned long long* SS = (unsigned long long*)(ws + WS_SS);
    const int gw = F.vcu * NWAVES + F.wave, NGW = F.G * NWAVES;

    for (int rep = 0; rep < MK_REP_P0; ++rep) { p0_prologue(F); __syncthreads(); }
    GRID_BAR();
    if (MK_LAST_PHASE >= 1) {
        pg8::Gemm g{XB, (const bf16*)(ws + WS_W1), NTOK, 2560, 1024}; pg8::StaticOrder S; S.init(NTOK, 2560, F.G, (int)blockIdx.x);
        pg8::EpiInProj E{(const float*)(ws + WS_R0), (bf16*)(ws + WS_U), (bf16*)(ws + WS_VR), (bf16*)(ws + WS_QB), (bf16*)(ws + WS_KB), (bf16*)(ws + WS_VB), SS, F.out};
        pg8::gemm_phase<pg8::EpiInProj, pg8::StaticOrder, true, true>(F.lds + RING_OFF, g, S, E);
    }
    GRID_BAR();
    const float lam = lambda_val(F);
    if (MK_LAST_PHASE >= 2) {
        for (int rep = 0; rep < MK_REP_ATTNP; ++rep)
        for (int u = F.vcu; u < 256; u += F.G) { const int bh = u >> 4, s = u & 15; attn_prompt_unit(F, lam, bh >> 2, bh & 3, s); attn_prompt_unit(F, lam, bh >> 2, bh & 3, 31 - s); }
        for (int rep = 0; rep < MK_REP_ATTNS; ++rep)
        for (int u = F.vcu; u < 256; u += F.G) attn_sample_unit(F, u >> 3, u & 7);
        __syncthreads();
        for (int rep = 0; rep < MK_REP_SGU; ++rep) {
        for (int u = F.vcu; u < 512; u += F.G) sgu_prompt_unit(F, u >> 2, u & 3);
        for (int u = F.vcu; u < 32; u += F.G) sgu_sample_unit(F, u); }
    }
    GRID_BAR();
    if (MK_LAST_PHASE >= 2) { for (int u = F.vcu; u < 128; u += F.G) attn_sample_combine(F, lam, u >> 2, u & 3); }
    GRID_BAR();
    if (MK_LAST_PHASE >= 3) {
        pg8::Gemm g{CB, (const bf16*)(ws + WS_W2), NP, 1024, 1024}; pg8::StaticOrder S; S.init(NP, 1024, F.G, (int)blockIdx.x);
        pg8::EpiResid E{F.in[I_XP], F.in[I_XS], X, XB, SS + 1 * (size_t)NTOK};
        pg8::gemm_phase<pg8::EpiResid, pg8::StaticOrder, true, true>(F.lds + RING_OFF, g, S, E);
        for (int t = F.vcu; t < 256; t += F.G) sample_gemm_tile<0>(F, CB + (size_t)NP * 1024, (const bf16*)(ws + WS_W2), 1024, t, F.in[I_XS], nullptr, X, XB, SS + 1 * (size_t)NTOK);
    }
    GRID_BAR();
    for (int rep = 0; rep < MK_REP_G3; ++rep) {
        pg8::Gemm g{XB, (const bf16*)(ws + WS_W3), NTOK, 5632, 1024}; pg8::StaticOrder S; S.init(NTOK, 5632, F.G, (int)blockIdx.x);
        pg8::EpiSwiGLU E{SS + 1 * (size_t)NTOK, ACT};
        pg8::gemm_phase<pg8::EpiSwiGLU, pg8::StaticOrder, true, true>(F.lds + RING_OFF, g, S, E);
    }
    GRID_BAR();
    if (MK_LAST_PHASE >= 5) {
        pg8::Gemm g{ACT, (const bf16*)(ws + WS_W4), NP, 1024, 2816}; pg8::StaticOrder S; S.init(NP, 1024, F.G, (int)blockIdx.x);
        pg8::EpiResid E{X, X + (size_t)NP * 1024, X, XB, SS + 2 * (size_t)NTOK};
        pg8::gemm_phase<pg8::EpiResid, pg8::StaticOrder, true, true>(F.lds + RING_OFF, g, S, E);
        for (int t = F.vcu; t < 256; t += F.G) sample_gemm_tile<0>(F, ACT + (size_t)NP * 2816, (const bf16*)(ws + WS_W4), 2816, t, X + (size_t)NP * 1024, nullptr, X, XB, SS + 2 * (size_t)NTOK);
    }
    GRID_BAR();
    if (MK_LAST_PHASE >= 6) {
        for (int rep = 0; rep < MK_REP_SSM; ++rep) {
        for (int u = F.vcu; u < 256; u += F.G) ssm_prompt_unit(F, u >> 6, u & 63);
        for (int w = gw; w < 2048; w += NGW) ssm_sample_unit(F, w >> 6, w & 63); }
    }
    GRID_BAR();
    if (MK_LAST_PHASE >= 7) {
        pg8::Gemm g{CB, (const bf16*)(ws + WS_W5), NP, 2048, 1024}; pg8::StaticOrder S; S.init(NP, 2048, F.G, (int)blockIdx.x);
        pg8::EpiGLU E{F.in[I_BGLU], X, XB, SS + 3 * (size_t)NTOK};
        pg8::gemm_phase<pg8::EpiGLU, pg8::StaticOrder, true, true>(F.lds + RING_OFF, g, S, E);
        for (int t = F.vcu; t < 256; t += F.G) sample_gemm_tile<1>(F, CB + (size_t)NP * 1024, (const bf16*)(ws + WS_W5), 1024, t, nullptr, F.in[I_BGLU], X, XB, SS + 3 * (size_t)NTOK);
    }
    GRID_BAR();
    if (MK_LAST_PHASE >= 8) {
        pg8::Gemm g{XB, (const bf16*)(ws + WS_W6), NTOK, 5632, 1024}; pg8::StaticOrder S; S.init(NTOK, 5632, F.G, (int)blockIdx.x);
        pg8::EpiSwiGLU E{SS + 3 * (size_t)NTOK, ACT};
        pg8::gemm_phase<pg8::EpiSwiGLU, pg8::StaticOrder, true, true>(F.lds + RING_OFF, g, S, E);
    }
    GRID_BAR();
    if (MK_LAST_PHASE >= 9) {
        pg8::Gemm g{ACT, (const bf16*)(ws + WS_W7), NP, 1024, 2816}; pg8::StaticOrder S; S.init(NP, 1024, F.G, (int)blockIdx.x);
        pg8::EpiResid E{X, X + (size_t)NP * 1024, X, nullptr, SS + 4 * (size_t)NTOK};
        pg8::gemm_phase<pg8::EpiResid, pg8::StaticOrder, true, true>(F.lds + RING_OFF, g, S, E);
        for (int t = F.vcu; t < 256; t += F.G) sample_gemm_tile<0>(F, ACT + (size_t)NP * 2816, (const bf16*)(ws + WS_W7), 2816, t, X + (size_t)NP * 1024, nullptr, X, nullptr, SS + 4 * (size_t)NTOK);
    }
    GRID_BAR();
    if (MK_LAST_PHASE >= 10) { for (int m = gw; m < NTOK; m += NGW) final_norm_row(F, m); }
}

extern "C" void kernel_launch(void* const* d_in, const int* in_sizes, int n_in, void* d_out, int out_size, void* d_ws, size_t ws_size, hipStream_t stream) {
    static int grid = 0;
    if (grid == 0) {
        if (n_in != 32 || (size_t)out_size != OUT_TOTAL || ws_size < WS_END) { fprintf(stderr, "kernel_launch: shape mismatch (n_in %d, out %d, ws %zu); nothing launched\n", n_in, out_size, ws_size); grid = -1; return; }
        int dev = 0, cus = 0, per_cu = 0;
        if (hipGetDevice(&dev) != hipSuccess || hipDeviceGetAttribute(&cus, hipDeviceAttributeMultiprocessorCount, dev) != hipSuccess) { grid = -1; return; }
        if (hipFuncSetAttribute((const void*)hyb_fwd, hipFuncAttributeMaxDynamicSharedMemorySize, LDS_BYTES) != hipSuccess) { fprintf(stderr, "kernel_launch: hipFuncSetAttribute failed\n"); grid = -1; return; }
        if (hipOccupancyMaxActiveBlocksPerMultiprocessor(&per_cu, (const void*)hyb_fwd, NWAVES * 64, LDS_BYTES) != hipSuccess || per_cu < 1) { fprintf(stderr, "kernel_launch: occupancy query says %d blocks per CU\n", per_cu); }
        (void)hipGetLastError();
        grid = cus;
    }
    if (grid < 0) return;
    if (hipMemsetAsync((char*)d_ws + WS_CTL, 0, CTL_ZERO_BYTES, stream) != hipSuccess) { fprintf(stderr, "kernel_launch: memset failed\n"); return; }
    Args a{};
    for (int i = 0; i < 32; ++i) a.in[i] = (const float*)d_in[i];
    a.out = (float*)d_out; a.ws = (unsigned char*)d_ws;
    hipLaunchKernelGGL(hyb_fwd, dim3(grid), dim3(NWAVES * 64), LDS_BYTES, stream, a);
    const hipError_t le = hipPeekAtLastError();
    if (le != hipSuccess) fprintf(stderr, "kernel_launch: launch failed: %s\n", hipGetErrorName(le));
}
```

```cpp
#include <hip/hip_runtime.h>
#include <cstdio>
#include <cstdint>
namespace pg8 {
#define PG8_LAS __attribute__((address_space(3)))
typedef unsigned short bf16_t;
typedef short bf16x8 __attribute__((ext_vector_type(8)));
typedef float f32x4 __attribute__((ext_vector_type(4)));
typedef unsigned u32x4 __attribute__((ext_vector_type(4)));
constexpr int BM = 256, BK = 64, HALF = 128, HTB = HALF * BK * 2  , STAGE_BYTES = 8 * HTB, NXCD = 8, WGM = 8;

__host__ __device__ __forceinline__ int lds_byte(int r, int c) { const int st = (r >> 4) * 2 + (c >> 5), rr = r & 15, cc = c & 31, ob = rr * 64 + cc * 2; return st * 1024 + (ob ^ (((ob >> 9) & 1) << 5)); }
__host__ __device__ __forceinline__ void stage_rc(int b, int& R, int& C) { const int st = b / 1024, sb = b % 1024, swz = sb ^ (((sb >> 9) & 1) << 5); R = (st >> 1) * 16 + swz / 64; C = (st & 1) * 32 + (swz % 64) / 2; }
__host__ __device__ __forceinline__ int perm32(int rho) { const int n = rho >> 4, i = rho & 15; return 8 * (i >> 2) + 4 * n + (i & 3); }

struct Unit { int pm, pn; };
struct Gemm { const bf16_t* A; const bf16_t* Bt; int M, N, K; };

struct StaticOrder {
    int nM, nN, nwg, G, c;
    __host__ __device__ void init(int M, int N, int G_, int c_) { nM = M / BM; nN = N / BM; nwg = nM * nN; G = G_; c = c_; }
    __host__ __device__ bool next(int i, Unit& u) const {
        const long L = (long)i * G + c; if (L >= nwg) return false;
        int wgid = (int)L; { const int q = nwg / NXCD, r = nwg % NXCD, xcd = wgid % NXCD, off = wgid / NXCD; wgid = (xcd < r ? xcd * (q + 1) : r * (q + 1) + (xcd - r) * q) + off; }
        const int nig = WGM * nN, gid = wgid / nig, fm = gid * WGM, gsz = (nM - fm) < WGM ? (nM - fm) : WGM;
        u.pm = fm + ((wgid % nig) % gsz); u.pn = (wgid % nig) / gsz; return true;
    }
    __device__ __forceinline__ void a_ready(const Unit&) const {}
    __device__ __forceinline__ void done(const Unit&) const {}
};

__device__ __forceinline__ unsigned cvt_pk_bf16(float lo, float hi) { unsigned r; asm volatile("v_cvt_pk_bf16_f32 %0, %1, %2" : "=v"(r) : "v"(lo), "v"(hi)); return r; }
typedef float f32x2 __attribute__((ext_vector_type(2)));
constexpr int NP_ = 16384, NS_ = 256;
constexpr size_t OFF_YP = 0, OFF_YS = OFF_YP + (size_t)NP_ * 1024, OFF_KP = OFF_YS + (size_t)NS_ * 1024, OFF_VP = OFF_KP + (size_t)NP_ * 512, OFF_KS = OFF_VP + (size_t)NP_ * 512,
                 OFF_VS = OFF_KS + (size_t)NS_ * 512, OFF_CV = OFF_VS + (size_t)NS_ * 512, OFF_SRP = OFF_CV + (size_t)NS_ * 512, OFF_SIP = OFF_SRP + 4 * 64 * 64, OFF_SRS = OFF_SIP + 4 * 64 * 64,
                 OFF_SIS = OFF_SRS + 32 * 64 * 64, OUT_TOTAL = OFF_SIS + 32 * 64 * 64;
constexpr float QSCALE = 0.125f * 1.4426950408889634f;
#define PG8_RLXA __ATOMIC_RELAXED, __HIP_MEMORY_SCOPE_AGENT
__device__ __forceinline__ void ss_add(unsigned long long* p, float v) { __hip_atomic_fetch_add(p, (unsigned long long)(v * 1048576.0f + 0.5f), PG8_RLXA); }
__device__ __forceinline__ float ss_rinv(const unsigned long long* p, float inv_n) { const unsigned long long w = __hip_atomic_load(p, PG8_RLXA); return __builtin_amdgcn_rsqf((float)w * (inv_n * (1.0f / 1048576.0f)) + 1e-6f); }
__device__ __forceinline__ float gelu_t(float x) { const float t = x * (1.0f + 0.044715f * x * x); return x * __builtin_amdgcn_rcpf(1.0f + __builtin_amdgcn_exp2f(-2.302208198f * t)); }
__device__ __forceinline__ float sigm(float x) { return __builtin_amdgcn_rcpf(1.0f + __builtin_amdgcn_exp2f(-1.4426950409f * x)); }
__device__ __forceinline__ float quad_sum(float s) { s += __shfl_xor(s, 16); s += __shfl_xor(s, 32); return s; }
__device__ __forceinline__ u32x4 pack8(const f32x4 a, const f32x4 b) { u32x4 w; w.x = cvt_pk_bf16(a[0], a[1]); w.y = cvt_pk_bf16(a[2], a[3]); w.z = cvt_pk_bf16(b[0], b[1]); w.w = cvt_pk_bf16(b[2], b[3]); return w; }

struct EpiInProj {
    static constexpr bool PERM = true, AFTER_DRAIN = false;
    const float* r0; bf16_t* U; bf16_t* VR; bf16_t* QB; bf16_t* KB; bf16_t* VB; unsigned long long* vss; float* out; bool do_ss;
    __device__ __forceinline__ void operator()(const f32x4 (&acc)[2][2][4][2], const Unit& u, int wr, int wc, int fr, int fq) const {
        const int row0 = u.pm * BM + wr * 64 + fr, seg = u.pn >> 1, col0 = (u.pn & 1) * 256 + wc * 32 + 8 * fq;
        bf16_t* dstb = seg == 0 ? U : seg == 1 ? VR : seg == 2 ? QB : seg == 3 ? KB : VB;
        const bool prompt = u.pm < NP_ / BM;
        float* dstf = out + (prompt ? (seg == 3 ? OFF_KP : OFF_VP) : (seg == 3 ? OFF_KS : OFF_VS));
#pragma unroll
        for (int ai = 0; ai < 2; ++ai)
#pragma unroll
            for (int m = 0; m < 4; ++m) {
                const int row = row0 + ai * HALF + m * 16; const float r = r0[row]; float ssq = 0.f;
                const int orow = prompt ? row : row - NP_;
#pragma unroll
                for (int bj = 0; bj < 2; ++bj) {
                    f32x4 v0 = acc[ai][bj][m][0] * r, v1 = acc[ai][bj][m][1] * r; const int col = col0 + bj * HALF;
                    if (seg <= 1) {
#pragma unroll
                        for (int i = 0; i < 4; ++i) { v0[i] = gelu_t(v0[i]); v1[i] = gelu_t(v1[i]); }
                        if (seg == 1) ssq += (v0[0] * v0[0] + v0[1] * v0[1]) + (v0[2] * v0[2] + v0[3] * v0[3]) + (v1[0] * v1[0] + v1[1] * v1[1]) + (v1[2] * v1[2] + v1[3] * v1[3]);
                    } else if (seg == 2) { v0 = v0 * QSCALE; v1 = v1 * QSCALE; }
                    else { float* o = dstf + (size_t)orow * 512 + col; *(f32x4*)o = v0; *(f32x4*)(o + 4) = v1; }
                    *(u32x4*)(dstb + (size_t)row * 512 + col) = pack8(v0, v1);
                }
                if (seg == 1 && do_ss) { ssq = quad_sum(ssq); if (fq == 0) ss_add(vss + row, ssq); }
            }
    }
};
__device__ __forceinline__ void unpack8(const u32x4 w, f32x4& a, f32x4& b) { a[0] = __uint_as_float(w.x << 16); a[1] = __uint_as_float(w.x & 0xffff0000u); a[2] = __uint_as_float(w.y << 16); a[3] = __uint_as_float(w.y & 0xffff0000u);
    b[0] = __uint_as_float(w.z << 16); b[1] = __uint_as_float(w.z & 0xffff0000u); b[2] = __uint_as_float(w.w << 16); b[3] = __uint_as_float(w.w & 0xffff0000u); }
struct EpiResid {
    static constexpr bool PERM = true, AFTER_DRAIN = false;
    bf16_t* XB; float* X; bool wxb; unsigned long long* ss;
    __device__ __forceinline__ void operator()(const f32x4 (&acc)[2][2][4][2], const Unit& u, int wr, int wc, int fr, int fq) const {
        const int row0 = u.pm * BM + wr * 64 + fr, col0 = u.pn * BM + wc * 32 + 8 * fq;
#pragma unroll
        for (int ai = 0; ai < 2; ++ai)
#pragma unroll
            for (int m = 0; m < 4; ++m) {
                const int row = row0 + ai * HALF + m * 16; float ssq = 0.f;
#pragma unroll
                for (int bj = 0; bj < 2; ++bj) {
                    bf16_t* xb = XB + (size_t)row * 1024 + col0 + bj * HALF; f32x4 r0_, r1_; unpack8(*(const u32x4*)xb, r0_, r1_);
                    const f32x4 o0 = acc[ai][bj][m][0] + r0_, o1 = acc[ai][bj][m][1] + r1_;
                    if (X) { float* xo = X + (size_t)row * 1024 + col0 + bj * HALF; *(f32x4*)xo = o0; *(f32x4*)(xo + 4) = o1; }
                    if (wxb) *(u32x4*)xb = pack8(o0, o1);
                    ssq += (o0[0] * o0[0] + o0[1] * o0[1]) + (o0[2] * o0[2] + o0[3] * o0[3]) + (o1[0] * o1[0] + o1[1] * o1[1]) + (o1[2] * o1[2] + o1[3] * o1[3]);
                }
                ssq = quad_sum(ssq); if (fq == 0) ss_add(ss + row, ssq);
            }
    }
};
struct EpiSwiGLU {
    static constexpr bool PERM = true, AFTER_DRAIN = false;
    const unsigned long long* ss; bf16_t* ACT;
    __device__ __forceinline__ void operator()(const f32x4 (&acc)[2][2][4][2], const Unit& u, int wr, int wc, int fr, int fq) const {
        const int row0 = u.pm * BM + wr * 64 + fr, col0 = u.pn * HALF + wc * 32 + 8 * fq;
#pragma unroll
        for (int ai = 0; ai < 2; ++ai)
#pragma unroll
            for (int m = 0; m < 4; ++m) {
                const int row = row0 + ai * HALF + m * 16; const float r = ss_rinv(ss + row, 1.0f / 1024.0f);
                f32x4 a[2];
#pragma unroll
                for (int n = 0; n < 2; ++n) { const f32x4 g = acc[ai][0][m][n] * r, up = acc[ai][1][m][n] * r;
#pragma unroll
                    for (int i = 0; i < 4; ++i) a[n][i] = g[i] * sigm(g[i]) * up[i]; }
                *(u32x4*)(ACT + (size_t)row * 2816 + col0) = pack8(a[0], a[1]);
            }
    }
};
struct EpiGLU {
    static constexpr bool PERM = true, AFTER_DRAIN = false;
    const float* bglu; bf16_t* XB; unsigned long long* ss;
    __device__ __forceinline__ void operator()(const f32x4 (&acc)[2][2][4][2], const Unit& u, int wr, int wc, int fr, int fq) const {
        const int row0 = u.pm * BM + wr * 64 + fr, col0 = u.pn * HALF + wc * 32 + 8 * fq;
        f32x4 bv[2], bg[2];
#pragma unroll
        for (int n = 0; n < 2; ++n) { bv[n] = *(const f32x4*)(bglu + col0 + 4 * n); bg[n] = *(const f32x4*)(bglu + 1024 + col0 + 4 * n); }
#pragma unroll
        for (int ai = 0; ai < 2; ++ai)
#pragma unroll
            for (int m = 0; m < 4; ++m) {
                const int row = row0 + ai * HALF + m * 16; bf16_t* xb = XB + (size_t)row * 1024 + col0; f32x4 x[2], o[2]; float ssq = 0.f; unpack8(*(const u32x4*)xb, x[0], x[1]);
#pragma unroll
                for (int n = 0; n < 2; ++n) { const f32x4 zv = acc[ai][0][m][n] + bv[n], zg = acc[ai][1][m][n] + bg[n];
#pragma unroll
                    for (int i = 0; i < 4; ++i) { o[n][i] = x[n][i] + zv[i] * sigm(zg[i]); ssq += o[n][i] * o[n][i]; } }
                *(u32x4*)xb = pack8(o[0], o[1]);
                ssq = quad_sum(ssq); if (fq == 0) ss_add(ss + row, ssq);
            }
    }
};
struct EpiNull {
    static constexpr bool PERM = true, AFTER_DRAIN = false;
    float* X; int never;
    __device__ __forceinline__ void operator()(const f32x4 (&acc)[2][2][4][2], const Unit& u, int wr, int wc, int fr, int fq) const {
        if (never == 0x7fffffff) {
#pragma unroll
            for (int ai = 0; ai < 2; ++ai)
#pragma unroll
                for (int m = 0; m < 4; ++m)
#pragma unroll
                    for (int bj = 0; bj < 2; ++bj) { float* xo = X + (size_t)(u.pm * BM + wr * 64 + fr + ai * HALF + m * 16) * 1024 + (u.pn & 3) * BM + wc * 32 + 8 * fq + bj * HALF; *(f32x4*)xo = acc[ai][bj][m][0]; *(f32x4*)(xo + 4) = acc[ai][bj][m][1]; }
        }
    }
};
template <class Epi, class Sched, bool ALIGN_EPI = false, bool SP2 = false>
__device__ __forceinline__ void gemm_phase(PG8_LAS unsigned char* lds, const Gemm g, const Sched& S, const Epi& E) {
    int tid_ = threadIdx.x; asm volatile("" : "+v"(tid_));
    const int tid = tid_, wid = __builtin_amdgcn_readfirstlane(tid >> 6), lane = tid & 63, wr = wid >> 2, wc = wid & 3, fr = lane & 15, fq = lane >> 4;
    const int K = g.K, nt = K / BK;
    unsigned voffA[2], voffB[2];
#pragma unroll
    for (int i = 0; i < 2; ++i) { int R, C; stage_rc(tid * 16 + i * 8192, R, C); const int Rb = Epi::PERM ? ((R & ~31) + perm32(R & 31)) : R;
        voffA[i] = (unsigned)(R * K + C) * 2u; voffB[i] = (unsigned)(Rb * K + C) * 2u; }
    const size_t kstep = (size_t)(BK * 2);
    const size_t hstep = (size_t)HALF * K * 2;
    const size_t tstep = 2 * hstep;
    const unsigned ldsw = (unsigned)wid * 1024u;
    const int aoff = lds_byte(wr * 64 + fr, fq * 8), boff = lds_byte(wc * 32 + fr, fq * 8);
#define PG8_SA(b, h) (((b) * 2 + (h)) * HTB)
#define PG8_SB(b, h) ((4 + (b) * 2 + (h)) * HTB)
#define PG8_STAGE(bufoff, gbase, voff) do { _Pragma("unroll") for (int _i = 0; _i < 2; ++_i) \
        __builtin_amdgcn_global_load_lds((const unsigned*)((const char*)(gbase) + (voff)[_i]), (PG8_LAS unsigned*)(lds + (bufoff) + ldsw + _i * 8192), 16, 0, 0); } while (0)
#define PG8_LDA(dst, b, h) do { _Pragma("unroll") for (int m = 0; m < 4; ++m) _Pragma("unroll") for (int k = 0; k < 2; ++k) dst[m][k] = *(const PG8_LAS bf16x8*)(lds + PG8_SA(b, h) + aoff + m * 2048 + k * 1024); } while (0)
#define PG8_LDB(dst, b, h) do { _Pragma("unroll") for (int n = 0; n < 2; ++n) _Pragma("unroll") for (int k = 0; k < 2; ++k) dst[n][k] = *(const PG8_LAS bf16x8*)(lds + PG8_SB(b, h) + boff + n * 2048 + k * 1024); } while (0)
#define PG8_MMA(ai, bj, At, Bt) do { __builtin_amdgcn_s_setprio(1); _Pragma("unroll") for (int m = 0; m < 4; ++m) _Pragma("unroll") for (int n = 0; n < 2; ++n) _Pragma("unroll") for (int k = 0; k < 2; ++k) \
        acc[ai][bj][m][n] = __builtin_amdgcn_mfma_f32_16x16x32_bf16(Bt[n][k], At[m][k], acc[ai][bj][m][n], 0, 0, 0); __builtin_amdgcn_s_setprio(0); } while (0)
#define PG8_WAIT_V(n) asm volatile("s_waitcnt vmcnt(" #n ")" ::: "memory")
#define PG8_WAIT_L(n) asm volatile("s_waitcnt lgkmcnt(" #n ")" ::: "memory")
#define PG8_BAR __builtin_amdgcn_s_barrier()
#define PG8_SCHED __builtin_amdgcn_sched_barrier(0)
    Unit cur, nxt; int ui = 0;
    if (!S.next(0, cur)) return;
    f32x4 acc[2][2][4][2];
#pragma unroll
    for (int a = 0; a < 2; ++a)
#pragma unroll
        for (int b = 0; b < 2; ++b)
#pragma unroll
            for (int m = 0; m < 4; ++m)
#pragma unroll
                for (int n = 0; n < 2; ++n) acc[a][b][m][n] = (f32x4){0.f, 0.f, 0.f, 0.f};
    bf16x8 At[4][2], B0[2][2], B1[2][2];
    const char* cA = (const char*)g.A + (size_t)cur.pm * tstep; const char* cB = (const char*)g.Bt + (size_t)cur.pn * tstep;
    S.a_ready(cur);
    if constexpr (SP2) {
        PG8_STAGE(PG8_SB(0, 0), cB, voffB); PG8_STAGE(PG8_SB(0, 1), cB + hstep, voffB); PG8_STAGE(PG8_SA(0, 0), cA, voffA); PG8_STAGE(PG8_SA(0, 1), cA + hstep, voffA);
        if (wr == 1) PG8_BAR;
        PG8_WAIT_V(2); PG8_BAR;
        PG8_STAGE(PG8_SB(1, 0), cB + kstep, voffB); PG8_STAGE(PG8_SA(1, 0), cA + kstep, voffA); PG8_STAGE(PG8_SB(1, 1), cB + hstep + kstep, voffB);
        PG8_WAIT_V(6); PG8_BAR;
    } else {
        PG8_STAGE(PG8_SB(0, 0), cB, voffB); PG8_STAGE(PG8_SA(0, 0), cA, voffA); PG8_STAGE(PG8_SB(0, 1), cB + hstep, voffB); PG8_STAGE(PG8_SA(0, 1), cA + hstep, voffA);
        if (wr == 1) PG8_BAR;
        PG8_WAIT_V(4); PG8_BAR;
        PG8_STAGE(PG8_SB(1, 0), cB + kstep, voffB); PG8_STAGE(PG8_SA(1, 0), cA + kstep, voffA); PG8_STAGE(PG8_SB(1, 1), cB + hstep + kstep, voffB);
        PG8_WAIT_V(6); PG8_BAR;
    }
    for (;;) {
        const bool has_next = S.next(ui + 1, nxt);
        const char* nA = has_next ? (const char*)g.A + (size_t)nxt.pm * tstep : cA; const char* nB = has_next ? (const char*)g.Bt + (size_t)nxt.pn * tstep : cB;
        for (int t = 0; t < nt; t += 2) {
            const bool last = (t == nt - 2);
            const char* a1 = cA + (size_t)(t + 1) * kstep;
            const char* a2 = last ? nA : cA + (size_t)(t + 2) * kstep; const char* b2 = last ? nB : cB + (size_t)(t + 2) * kstep;
            const char* a3 = a2 + kstep; const char* b3 = b2 + kstep;
            if (last && has_next) S.a_ready(nxt);
            if constexpr (SP2) {
            PG8_LDB(B0, 0, 0); PG8_LDB(B1, 0, 1); PG8_SCHED; PG8_LDA(At, 0, 0); PG8_STAGE(PG8_SA(1, 1), a1 + hstep, voffA);
            PG8_WAIT_V(8); PG8_WAIT_L(0); PG8_BAR; PG8_MMA(0, 0, At, B0); PG8_MMA(0, 1, At, B1); PG8_BAR; PG8_SCHED;
            PG8_LDA(At, 0, 1); PG8_STAGE(PG8_SB(0, 0), b2, voffB); PG8_STAGE(PG8_SB(0, 1), b2 + hstep, voffB); PG8_STAGE(PG8_SA(0, 0), a2, voffA);
            PG8_WAIT_V(8); PG8_WAIT_L(0); PG8_BAR; PG8_MMA(1, 0, At, B0); PG8_MMA(1, 1, At, B1); PG8_BAR; PG8_SCHED;
            PG8_LDB(B0, 1, 0); PG8_LDB(B1, 1, 1); PG8_SCHED; PG8_LDA(At, 1, 0); PG8_STAGE(PG8_SA(0, 1), a2 + hstep, voffA);
            PG8_WAIT_V(8); PG8_WAIT_L(0); PG8_BAR; PG8_MMA(0, 0, At, B0); PG8_MMA(0, 1, At, B1); PG8_BAR; PG8_SCHED;
            PG8_LDA(At, 1, 1); PG8_STAGE(PG8_SB(1, 0), b3, voffB); PG8_STAGE(PG8_SB(1, 1), b3 + hstep, voffB); PG8_STAGE(PG8_SA(1, 0), a3, voffA);
            PG8_WAIT_V(8); PG8_WAIT_L(0); PG8_BAR; PG8_MMA(1, 0, At, B0); PG8_MMA(1, 1, At, B1); PG8_BAR; PG8_SCHED;
            } else {
            PG8_LDB(B0, 0, 0); PG8_SCHED; PG8_LDA(At, 0, 0); PG8_STAGE(PG8_SA(1, 1), a1 + hstep, voffA);
            PG8_WAIT_L(8); PG8_BAR; PG8_WAIT_L(0); PG8_MMA(0, 0, At, B0); PG8_BAR; PG8_SCHED;
            PG8_LDB(B1, 0, 1); PG8_STAGE(PG8_SB(0, 0), b2, voffB);
            PG8_BAR; PG8_WAIT_L(0); PG8_MMA(0, 1, At, B1); PG8_BAR;
            PG8_LDA(At, 0, 1); PG8_STAGE(PG8_SA(0, 0), a2, voffA);
            PG8_BAR; PG8_WAIT_L(0); PG8_MMA(1, 0, At, B0); PG8_BAR; PG8_SCHED;
            PG8_STAGE(PG8_SB(0, 1), b2 + hstep, voffB);
            PG8_WAIT_V(6); PG8_BAR; PG8_MMA(1, 1, At, B1); PG8_BAR;
            PG8_LDB(B0, 1, 0); PG8_SCHED; PG8_LDA(At, 1, 0); PG8_STAGE(PG8_SA(0, 1), a2 + hstep, voffA);
            PG8_WAIT_L(8); PG8_BAR; PG8_WAIT_L(0); PG8_MMA(0, 0, At, B0); PG8_BAR; PG8_SCHED;
            PG8_LDB(B1, 1, 1); PG8_STAGE(PG8_SB(1, 0), b3, voffB);
            PG8_BAR; PG8_WAIT_L(0); PG8_MMA(0, 1, At, B1); PG8_BAR;
            PG8_LDA(At, 1, 1); PG8_STAGE(PG8_SA(1, 0), a3, voffA);
            PG8_BAR; PG8_WAIT_L(0); PG8_MMA(1, 0, At, B0); PG8_BAR; PG8_SCHED;
            PG8_STAGE(PG8_SB(1, 1), b3 + hstep, voffB);
            PG8_WAIT_V(6); PG8_BAR; PG8_MMA(1, 1, At, B1); PG8_BAR;
            }
        }
        if constexpr (ALIGN_EPI) { if (wr == 0) PG8_BAR; }
        if constexpr (!Epi::AFTER_DRAIN) { E(acc, cur, wr, wc, fr, fq); S.done(cur); }
        if (!has_next) break;
#pragma unroll
        for (int a = 0; a < 2; ++a)
#pragma unroll
            for (int b = 0; b < 2; ++b)
#pragma unroll
                for (int m = 0; m < 4; ++m)
#pragma unroll
                    for (int n = 0; n < 2; ++n) acc[a][b][m][n] = (f32x4){0.f, 0.f, 0.f, 0.f};
        cur = nxt; cA = nA; cB = nB; ++ui;
        if constexpr (ALIGN_EPI) { if (wr == 1) PG8_BAR; }
    }
    PG8_WAIT_V(0);
    if constexpr (!ALIGN_EPI) { if (wr == 0) PG8_BAR; }
    PG8_BAR;
    if constexpr (Epi::AFTER_DRAIN) { E.fused(acc, cur, wr, wc, fr, fq, lds, wid, lane); S.done(cur); }
#undef PG8_SA
#undef PG8_SB
#undef PG8_STAGE
#undef PG8_LDA
#undef PG8_LDB
#undef PG8_MMA
#undef PG8_WAIT_V
#undef PG8_WAIT_L
#undef PG8_BAR
#undef PG8_SCHED
}
}
#define GAS __attribute__((address_space(1)))
#define LAS __attribute__((address_space(3)))
typedef unsigned short bf16;
typedef unsigned v4u __attribute__((ext_vector_type(4)));
typedef float f32x4 __attribute__((ext_vector_type(4)));
typedef short bf16x8 __attribute__((ext_vector_type(8)));
typedef GAS unsigned gu32;
typedef GAS unsigned long long gu64;
#define RLX_AGENT __ATOMIC_RELAXED, __HIP_MEMORY_SCOPE_AGENT
#define LDS_WAIT() asm volatile("s_waitcnt lgkmcnt(0)" ::: "memory")
#define VM_WAIT() asm volatile("s_waitcnt vmcnt(0)" ::: "memory")
__device__ __forceinline__ unsigned long long rt() { return __builtin_amdgcn_s_memrealtime(); }
__device__ __forceinline__ unsigned f2bf(float f) { unsigned u = __builtin_bit_cast(unsigned, f); return (u + 0x7fffu + ((u >> 16) & 1u)) >> 16; }
__device__ __forceinline__ unsigned pk2(float lo, float hi) { return f2bf(lo) | (f2bf(hi) << 16); }

#define XB_TMO      128
#define XB_XCNT(j)  (256  + 64 * (j))
#define XB_XSUB(j)  (1280 + 64 * (j))
#define XB_XGEN(j)  (2304 + 64 * (j))
#define XB_TOP      3328
#define XB_TOPGEN   3392
#define XCD_BAR_WORDS 3456
#define XB_SPIN_CAP (1u << 18)

__device__ __forceinline__ unsigned xb_ld(unsigned* p)              { return __hip_atomic_load(p, __ATOMIC_RELAXED, __HIP_MEMORY_SCOPE_AGENT); }
__device__ __forceinline__ unsigned xb_add(unsigned* p, unsigned v) { return __hip_atomic_fetch_add(p, v, __ATOMIC_RELAXED, __HIP_MEMORY_SCOPE_AGENT); }
__device__ __forceinline__ unsigned xb_xcc_id() { return (unsigned)__builtin_amdgcn_s_getreg((3 << 11) | 20) & 0xFu; }
#define XB_SPIN(cond, bar) do { unsigned _sp = 0; while (cond) { __builtin_amdgcn_s_sleep(1); \
    if ((++_sp & 255u) == 0u) { if (xb_ld(&(bar)[XB_TMO])) break; if (_sp > XB_SPIN_CAP) { atomicAdd(&(bar)[XB_TMO], 1u); break; } } } } while (0)

struct XcdBarrier {
    unsigned* bar; unsigned x;
    volatile LAS unsigned* st;
};

__device__ __forceinline__ XcdBarrier xcd_barrier_post(unsigned* bar, volatile LAS unsigned* st) {
    XcdBarrier b; b.bar = bar; b.x = xb_xcc_id(); b.st = st;
    if (threadIdx.x == 0) (void)xb_add(&bar[XB_XCNT(b.x)], 1u);
    return b;
}
__device__ __forceinline__ void xcd_barrier_complete(unsigned* bar, unsigned x, unsigned& nloc, unsigned& nx) {
    const unsigned G = gridDim.x * gridDim.y * gridDim.z;
    unsigned sum, cnt, mine, sp = 0u;
    for (;;) {
        sum = 0u; cnt = 0u; mine = 0u;
#pragma unroll
        for (unsigned j = 0; j < 16; ++j) { const unsigned c = xb_ld(&bar[XB_XCNT(j)]); sum += c; cnt += (c > 0u) ? 1u : 0u; mine = (j == x) ? c : mine; }
        if (sum == G) break;
        __builtin_amdgcn_s_sleep(1);
        if ((++sp & 255u) == 0u) { if (xb_ld(&bar[XB_TMO])) break; if (sp > XB_SPIN_CAP) { atomicAdd(&bar[XB_TMO], 1u); break; } }
    }
    nloc = mine > 0u ? mine : 1u; nx = cnt > 0u ? cnt : 1u;
}

__device__ __forceinline__ void xcd_barrier(const XcdBarrier& b) {
    asm volatile("s_waitcnt vmcnt(0)" ::: "memory");
    __syncthreads();
    if (threadIdx.x == 0) {
        unsigned* bar = b.bar;
        __builtin_amdgcn_s_waitcnt(0);
        unsigned nloc = b.st[0], nx = b.st[1];
        if (nloc == 0u) { xcd_barrier_complete(bar, b.x, nloc, nx); b.st[0] = nloc; b.st[1] = nx; }
        const unsigned old = xb_add(&bar[XB_XSUB(b.x)], 1u);
        const unsigned gen = old / nloc;
        if (old + 1u == (gen + 1u) * nloc) {
            __builtin_amdgcn_fence(__ATOMIC_RELEASE, "agent");
            asm volatile("s_waitcnt vmcnt(0)" ::: "memory");
            const unsigned og = xb_add(&bar[XB_TOP], 1u);
            const unsigned tg = og / nx;
            if (og + 1u == (tg + 1u) * nx) xb_add(&bar[XB_TOPGEN], 1u);
            else XB_SPIN(xb_ld(&bar[XB_TOPGEN]) == tg, bar);
            __builtin_amdgcn_fence(__ATOMIC_ACQUIRE, "agent");
            xb_add(&bar[XB_XGEN(b.x)], 1u);
            asm volatile("s_waitcnt vmcnt(0)" ::: "memory");
        } else {
            XB_SPIN(xb_ld(&bar[XB_XGEN(b.x)]) == gen, bar);
            __builtin_amdgcn_fence(__ATOMIC_ACQUIRE, "agent");
            asm volatile("s_waitcnt vmcnt(0)" ::: "memory");
        }
    }
    __syncthreads();
}
constexpr int NWAVES = 8;
constexpr int NP = 16384, NS = 256, NTOK = NP + NS, DM = 1024, DFF = 2816, SEQ = 4096;
constexpr float EPS = 1e-6f, LAM_INIT = 0.2f;
using pg8::OFF_YP; using pg8::OFF_CV; using pg8::OFF_SRP; using pg8::OFF_SIP; using pg8::OFF_SRS; using pg8::OFF_SIS; using pg8::OUT_TOTAL;
constexpr size_t MiB = 1u << 20;
constexpr size_t WS_CTL = 0, CTL_ZERO_BYTES = 2 * MiB;
constexpr int CW_BAR = 4096;
constexpr size_t WS_SS = 64 * 1024;
constexpr size_t WS_R0 = 2 * MiB;
constexpr size_t WS_PW1 = 2 * MiB + 128 * 1024, WS_PW16 = WS_PW1 + 32 * 1024;
constexpr size_t WS_BBAR = 2 * MiB + 256 * 1024;
constexpr size_t WS_WTRIL = 3 * MiB;
constexpr size_t WS_T = 4 * MiB, WS_E = 12 * MiB, WS_F = 16 * MiB;
constexpr size_t WS_W1 = 24 * MiB, WS_W2 = 29 * MiB, WS_W3 = 31 * MiB, WS_W4 = 42 * MiB, WS_W5 = 48 * MiB, WS_W6 = 52 * MiB, WS_W7 = 63 * MiB;
constexpr size_t WS_XB = 70 * MiB, WS_X = 104 * MiB, WS_U = 170 * MiB, WS_VR = 187 * MiB, WS_QB = 204 * MiB, WS_KB = 221 * MiB, WS_VB = 238 * MiB;
constexpr size_t WS_CB = 256 * MiB, WS_ACT = 290 * MiB, WS_PART = 380 * MiB, WS_END = 400 * MiB;
constexpr int PART_STRIDE = 32 + 16 * 128;
static_assert(WS_W7 + (size_t)1024 * 2816 * 2 <= WS_XB && WS_XB + (size_t)NTOK * 1024 * 2 <= WS_X && WS_X + (size_t)NTOK * 1024 * 4 <= WS_U && WS_VB + (size_t)NTOK * 512 * 2 <= WS_CB &&
              WS_CB + (size_t)NTOK * 1024 * 2 <= WS_ACT && WS_ACT + (size_t)NTOK * 2816 * 2 <= WS_PART && WS_PART + (size_t)32 * 4 * 16 * PART_STRIDE * 4 <= WS_END && WS_SS + 5 * (size_t)NTOK * 8 <= CTL_ZERO_BYTES, "d_ws map");
constexpr int RING_OFF = 0, SCRATCH_BYTES = 147456;
constexpr int LDSCTL_OFF = SCRATCH_BYTES, MISC_OFF = LDSCTL_OFF + 320;
constexpr int LDS_BYTES = SCRATCH_BYTES + 1024;

typedef short s16x4 __attribute__((ext_vector_type(4)));
typedef float f32x16 __attribute__((ext_vector_type(16)));
typedef float f32x2_t __attribute__((ext_vector_type(2))); typedef __bf16 bf16x2_t __attribute__((ext_vector_type(2)));
__device__ __forceinline__ unsigned cvtpk(float lo, float hi) { f32x2_t v = {lo, hi}; bf16x2_t b = __builtin_convertvector(v, bf16x2_t); return __builtin_bit_cast(unsigned, b); }
__device__ __forceinline__ float bf2f(unsigned short h) { return __uint_as_float((unsigned)h << 16); }
__device__ __forceinline__ float bflo(unsigned w) { return __uint_as_float(w << 16); }
__device__ __forceinline__ float bfhi(unsigned w) { return __uint_as_float(w & 0xffff0000u); }
__device__ __forceinline__ float ex2(float x) { return __builtin_amdgcn_exp2f(x); }
__device__ __forceinline__ float wave_sum(float v) {
#pragma unroll
    for (int o = 1; o < 64; o <<= 1) v += __shfl_xor(v, o);
    return v;
}
__device__ __forceinline__ f32x4 mfma16(bf16x8 a, bf16x8 b, f32x4 c) { return __builtin_amdgcn_mfma_f32_16x16x32_bf16(a, b, c, 0, 0, 0); }
__device__ __forceinline__ f32x16 mfma32(bf16x8 a, bf16x8 b, f32x16 c) { return __builtin_amdgcn_mfma_f32_32x32x16_bf16(a, b, c, 0, 0, 0); }
typedef short v4i16_t __attribute__((ext_vector_type(4)));
__device__ __forceinline__ bf16x8 tr_pair(const LAS unsigned char* p0, const LAS unsigned char* p1) {
    const s16x4 lo = __builtin_bit_cast(s16x4, __builtin_amdgcn_ds_read_tr16_b64_v4i16((LAS v4i16_t*)p0));
    const s16x4 hi = __builtin_bit_cast(s16x4, __builtin_amdgcn_ds_read_tr16_b64_v4i16((LAS v4i16_t*)p1));
    return (bf16x8){lo[0], lo[1], lo[2], lo[3], hi[0], hi[1], hi[2], hi[3]};
}
__device__ __forceinline__ bf16x8 pack_bf8(const f32x4 a, const f32x4 b) { v4u w; w.x = cvtpk(a[0], a[1]); w.y = cvtpk(a[2], a[3]); w.z = cvtpk(b[0], b[1]); w.w = cvtpk(b[2], b[3]); return __builtin_bit_cast(bf16x8, w); }
using pg8::ss_rinv; using pg8::gelu_t;

struct Frame {
    LAS unsigned char* lds;
    volatile LAS unsigned* MISC;
    gu32* ctl;
    int tid, lane, wave, vcu, G;
    const float* const* in; float* out; unsigned char* ws;
};
enum { I_XP = 0, I_XS, I_CK, I_CV, I_PT, I_SRE, I_SIM, I_NMIX, I_NFFN, I_NFIN, I_WIN, I_WOUT, I_SGN, I_SGW, I_SGB, I_LQ1, I_LK1, I_LQ2, I_LK2, I_SUBLN,
       I_ARE, I_AIM, I_LDT, I_BRE, I_BIM, I_CRE, I_CIM, I_SD, I_WGLU, I_BGLU, I_WFI, I_WFO };

__device__ __forceinline__ int map_row(int n0, int NH) { if (NH == 0) return n0; const int hi = n0 >= NH ? 1 : 0, n2 = n0 - hi * NH; return 256 * (n2 >> 7) + 128 * hi + (n2 & 127); }
__device__ __forceinline__ void p0_transpose_item(const float* W, int K, int N, bf16* WT, int NH, const float* gain, LAS float* scr, int item, int lane) {
    const int nblk = N / 32, kb = item / nblk, nb = item % nblk, k0 = 64 * kb, n0 = 32 * nb;
#pragma unroll 8
    for (int i = 0; i < 32; ++i) { const int kk = 2 * i + (lane >> 5); float w = W[(size_t)(k0 + kk) * N + n0 + (lane & 31)]; if (gain) w *= gain[k0 + kk]; scr[kk * 33 + (lane & 31)] = w; }
    LDS_WAIT(); asm volatile("" ::: "memory");
    const int c = lane & 7, r0 = map_row(n0, NH);
#pragma unroll
    for (int j = 0; j < 4; ++j) { const int n = (lane >> 3) + 8 * j; const LAS float* s = scr + (8 * c) * 33 + n;
        v4u o; o.x = pk2(s[0 * 33], s[1 * 33]); o.y = pk2(s[2 * 33], s[3 * 33]); o.z = pk2(s[4 * 33], s[5 * 33]); o.w = pk2(s[6 * 33], s[7 * 33]);
        *(GAS v4u*)(WT + (size_t)(r0 + n) * K + k0 + 8 * c) = o; }
    LDS_WAIT(); asm volatile("" ::: "memory");
}
__device__ __forceinline__ void p0_row(Frame& F, const float* xrow, bf16* orow, float* r) {
    const GAS f32x4* xr = (const GAS f32x4*)xrow + F.lane;
    f32x4 v[4]; float s = 0.f;
#pragma unroll
    for (int j = 0; j < 4; ++j) { v[j] = xr[64 * j]; s += (v[j].x * v[j].x + v[j].y * v[j].y) + (v[j].z * v[j].z + v[j].w * v[j].w); }
    s = wave_sum(s);
    GAS unsigned long long* o8 = (GAS unsigned long long*)orow + F.lane;
#pragma unroll
    for (int j = 0; j < 4; ++j) o8[64 * j] = (unsigned long long)pk2(v[j].x, v[j].y) | ((unsigned long long)pk2(v[j].z, v[j].w) << 32);
    if (F.lane == 0) *r = 1.0f / sqrtf(s * (1.0f / 1024.0f) + EPS);
}
__device__ __forceinline__ void p0_ssm_tables(Frame& F, int g, int q) {
    LAS f32x2_t* pw = (LAS f32x2_t*)(F.lds);
    LAS f32x2_t* cb = pw + 17 * 64;
    LAS f32x2_t* cc = cb + 64 * 16;
    LAS float* KJ = (LAS float*)(cc + 16 * 64);
    LAS f32x2_t* cf = (LAS f32x2_t*)(KJ + 4096);
    const int tid = F.tid;
    const float* a_re = F.in[I_ARE] + g * 64; const float* a_im = F.in[I_AIM] + g * 64;
    const float dt = expf(F.in[I_LDT][g]);
    if (tid < 64) {
        const int p = tid; const float ar = a_re[p], ai = a_im[p], xr = ar * dt, xi = ai * dt;
#pragma unroll 1
        for (int j = 0; j <= 16; ++j) { const float mag = expf((float)j * xr), ang = (float)j * xi; pw[j * 64 + p] = (f32x2_t){mag * cosf(ang), mag * sinf(ang)}; }
        const float sh = sinf(0.5f * xi), nr = expm1f(xr) * cosf(xi) - 2.0f * sh * sh, ni = expf(xr) * sinf(xi), den = 1.0f / (ar * ar + ai * ai);
        cf[p] = (f32x2_t){(nr * ar + ni * ai) * den, (ni * ar - nr * ai) * den};
    }
    __syncthreads();
    const float* b_re = F.in[I_BRE] + (size_t)g * 1024; const float* b_im = F.in[I_BIM] + (size_t)g * 1024;
    const float* c_re = F.in[I_CRE] + (size_t)g * 1024; const float* c_im = F.in[I_CIM] + (size_t)g * 1024;
    for (int i = tid; i < 1024; i += 512) {
        const int p = i >> 4; const f32x2_t c = cf[p]; const float br = b_re[i], bi = b_im[i];
        cb[i] = (f32x2_t){c.x * br - c.y * bi, c.x * bi + c.y * br};
        cc[i] = (f32x2_t){c_re[i], c_im[i]};
    }
    __syncthreads();
    const float* dsk = F.in[I_SD] + g * 16;
#pragma unroll 1
    for (int o = tid; o < 4096; o += 512) {
        const int j = o >> 8, c = (o >> 4) & 15, c2 = o & 15; float s = 0.f;
#pragma unroll 4
        for (int p = 0; p < 64; ++p) { const f32x2_t a = pw[j * 64 + p], b = cb[p * 16 + c2], cv = cc[c * 64 + p];
            const float wr_ = a.x * b.x - a.y * b.y, wi_ = a.x * b.y + a.y * b.x; s += cv.x * wr_ - cv.y * wi_; }
        if (j == 0 && c == c2) s += dsk[c];
        KJ[o] = s;
    }
    __syncthreads();
    const float* g1 = F.in[I_NMIX] + 1024 + g * 16;
    bf16* Tg = (bf16*)(F.ws + WS_T) + (size_t)g * 65536; bf16* Eg = (bf16*)(F.ws + WS_E) + (size_t)g * 32768; bf16* Fg = (bf16*)(F.ws + WS_F) + (size_t)g * 32768;
#pragma unroll 1
    for (int i = 0; i < 4; ++i) { const int idx = tid + 512 * i, row = 64 * q + (idx >> 5), kc = idx & 31, t = row >> 4, c = row & 15, tau = kc >> 1, c0 = 8 * (kc & 1);
        float v[8];
#pragma unroll
        for (int e = 0; e < 8; ++e) v[e] = (t >= tau) ? KJ[((t - tau) * 16 + c) * 16 + c0 + e] * g1[c0 + e] : 0.f;
        v4u o; o.x = pk2(v[0], v[1]); o.y = pk2(v[2], v[3]); o.z = pk2(v[4], v[5]); o.w = pk2(v[6], v[7]);
        *(GAS v4u*)(Tg + (size_t)row * 256 + kc * 8) = o; }
#pragma unroll 1
    for (int i = 0; i < 2; ++i) { const int idx = tid + 512 * i, row = 32 * q + (idx >> 5), kc = idx & 31, ri = row >> 6, p = row & 63, tau = kc >> 1, c0 = 8 * (kc & 1);
        const f32x2_t a = pw[(15 - tau) * 64 + p]; float v[8];
#pragma unroll
        for (int e = 0; e < 8; ++e) { const f32x2_t b = cb[p * 16 + c0 + e]; const float zr = a.x * b.x - a.y * b.y, zi = a.x * b.y + a.y * b.x; v[e] = (ri ? zi : zr) * g1[c0 + e]; }
        v4u o; o.x = pk2(v[0], v[1]); o.y = pk2(v[2], v[3]); o.z = pk2(v[4], v[5]); o.w = pk2(v[6], v[7]);
        *(GAS v4u*)(Eg + (size_t)row * 256 + kc * 8) = o; }
#pragma unroll 1
    for (int i = 0; i < 2; ++i) { const int idx = tid + 512 * i, row = 64 * q + (idx >> 4), kc = idx & 15, t = row >> 4, c = row & 15, ri = kc >> 3, p0 = 8 * (kc & 7);
        float v[8];
#pragma unroll
        for (int e = 0; e < 8; ++e) { const f32x2_t a = pw[(t + 1) * 64 + p0 + e], cv = cc[c * 64 + p0 + e]; const float zr = cv.x * a.x - cv.y * a.y, zi = cv.x * a.y + cv.y * a.x; v[e] = ri ? -zi : zr; }
        v4u o; o.x = pk2(v[0], v[1]); o.y = pk2(v[2], v[3]); o.z = pk2(v[4], v[5]); o.w = pk2(v[6], v[7]);
        *(GAS v4u*)(Fg + (size_t)row * 128 + kc * 8) = o; }
    if (q == 0) {
        f32x2_t* PW1 = (f32x2_t*)(F.ws + WS_PW1) + g * 64; f32x2_t* PW16 = (f32x2_t*)(F.ws + WS_PW16) + g * 64; f32x2_t* BB = (f32x2_t*)(F.ws + WS_BBAR) + (size_t)g * 1024;
        if (tid < 64) { PW1[tid] = pw[64 + tid]; PW16[tid] = pw[16 * 64 + tid]; }
        for (int i = tid; i < 1024; i += 512) BB[i] = cb[i];
    }
    __syncthreads();
}
__device__ __forceinline__ void p0_prologue(Frame& F) {
    const int gw = F.vcu * NWAVES + F.wave, NGW = F.G * NWAVES;
    for (int u = F.vcu; u < 256; u += F.G) p0_ssm_tables(F, u >> 2, u & 3);
    LAS float* scr = (LAS float*)(F.lds + RING_OFF + F.wave * 16384);
    constexpr int I1 = 16 * (2560 / 32), I2 = 16 * (1024 / 32), I5 = 16 * (2048 / 32), I3 = 16 * (5632 / 32), I4 = 44 * (1024 / 32);
    constexpr int NITEMS = I1 + I2 + I5 + 2 * I3 + 2 * I4;
    for (int it = gw; it < NITEMS; it += NGW) {
        int r = it;
        if (r < I1) { p0_transpose_item(F.in[I_WIN], 1024, 2560, (bf16*)(F.ws + WS_W1), 0, F.in[I_NMIX], scr, r, F.lane); continue; } r -= I1;
        if (r < I2) { p0_transpose_item(F.in[I_WOUT], 1024, 1024, (bf16*)(F.ws + WS_W2), 0, nullptr, scr, r, F.lane); continue; } r -= I2;
        if (r < I5) { p0_transpose_item(F.in[I_WGLU], 1024, 2048, (bf16*)(F.ws + WS_W5), 1024, nullptr, scr, r, F.lane); continue; } r -= I5;
        if (r < I3) { p0_transpose_item(F.in[I_WFI], 1024, 5632, (bf16*)(F.ws + WS_W3), 2816, F.in[I_NFFN], scr, r, F.lane); continue; } r -= I3;
        if (r < I3) { p0_transpose_item(F.in[I_WFI] + (size_t)1024 * 5632, 1024, 5632, (bf16*)(F.ws + WS_W6), 2816, F.in[I_NFFN] + 1024, scr, r, F.lane); continue; } r -= I3;
        if (r < I4) { p0_transpose_item(F.in[I_WFO], 2816, 1024, (bf16*)(F.ws + WS_W4), 0, nullptr, scr, r, F.lane); continue; } r -= I4;
        p0_transpose_item(F.in[I_WFO] + (size_t)2816 * 1024, 2816, 1024, (bf16*)(F.ws + WS_W7), 0, nullptr, scr, r, F.lane);
    }
    bf16* XB = (bf16*)(F.ws + WS_XB); float* R0 = (float*)(F.ws + WS_R0);
    for (int m = gw; m < NTOK; m += NGW) p0_row(F, m < NP ? F.in[I_XP] + (size_t)m * 1024 : F.in[I_XS] + (size_t)(m - NP) * 1024, XB + (size_t)m * 1024, R0 + m);
    bf16* WT = (bf16*)(F.ws + WS_WTRIL); const float* sw = F.in[I_SGW];
    for (int i = gw * 64 + F.lane; i < 8192; i += NGW * 64) { const int e0 = i * 8, t = (e0 >> 7) & 127, s0 = e0 & 127; float v[8];
#pragma unroll
        for (int e = 0; e < 8; ++e) v[e] = (s0 + e <= t) ? sw[e0 + e] : 0.f;
        v4u o; o.x = pk2(v[0], v[1]); o.y = pk2(v[2], v[3]); o.z = pk2(v[4], v[5]); o.w = pk2(v[6], v[7]); *(GAS v4u*)(WT + e0) = o; }
}
__device__ __forceinline__ float lambda_val(Frame& F) {
    const int l = F.lane; const float a = wave_sum(F.in[I_LQ1][l] * F.in[I_LK1][l]), b = wave_sum(F.in[I_LQ2][l] * F.in[I_LK2][l]);
    return expf(a) - expf(b) + LAM_INIT;
}
#define LAUNDER_TID() int tid = F.tid; asm volatile("" : "+v"(tid)); const int lane = tid & 63, wave = __builtin_amdgcn_readfirstlane(tid >> 6); (void)lane; (void)wave
__device__ __forceinline__ void sgu_prompt_unit(Frame& F, int chunk, int g) {
    LAUNDER_TID();
    const bf16* U = (const bf16*)(F.ws + WS_U); const bf16* VR = (const bf16*)(F.ws + WS_VR); bf16* CB = (bf16*)(F.ws + WS_CB);
    const unsigned long long* vss = (const unsigned long long*)(F.ws + WS_SS);
    const bf16* WT = (const bf16*)(F.ws + WS_WTRIL) + (size_t)g * 16384;
    const float* gn = F.in[I_SGN] + g * 128; const float* bias = F.in[I_SGB] + g * 128;
    LAS unsigned short* vT = (LAS unsigned short*)F.lds;
    const size_t tok0 = (size_t)chunk * 128;
    {
        const int s = tid >> 2, c0 = 32 * (tid & 3); const float rv = ss_rinv(vss + tok0 + s, 1.0f / 512.0f);
        const v4u* src = (const v4u*)(VR + (tok0 + s) * 512 + g * 128 + c0);
#pragma unroll
        for (int i = 0; i < 4; ++i) { const v4u w = src[i]; const unsigned ww[4] = {w.x, w.y, w.z, w.w};
#pragma unroll
            for (int e = 0; e < 4; ++e) { const int c = c0 + 8 * i + 2 * e; const float a = bflo(ww[e]) * rv * gn[c], b = bfhi(ww[e]) * rv * gn[c + 1];
                vT[c * 136 + s] = (unsigned short)f2bf(a); vT[(c + 1) * 136 + s] = (unsigned short)f2bf(b); } }
    }
    __syncthreads();
    const int mb = wave & 3, nh = wave >> 2, r32 = lane & 31, hi = lane >> 5;
    f32x16 acc[2]; acc[0] = (f32x16){}; acc[1] = (f32x16){};
    for (int ks = 0; ks < 2 * mb + 2; ++ks) {
        const bf16x8 a = *(const bf16x8*)(WT + (32 * mb + r32) * 128 + 16 * ks + 8 * hi);
#pragma unroll
        for (int j = 0; j < 2; ++j) { const bf16x8 b = *(const LAS bf16x8*)((const LAS unsigned char*)vT + ((64 * nh + 32 * j + r32) * 136 + 16 * ks + 8 * hi) * 2); acc[j] = mfma32(a, b, acc[j]); }
    }
#pragma unroll
    for (int j = 0; j < 2; ++j) { const int d = g * 128 + 64 * nh + 32 * j + r32;
#pragma unroll
        for (int r = 0; r < 16; ++r) { const int t = 32 * mb + (r & 3) + 8 * (r >> 2) + 4 * hi; const size_t o = (tok0 + t) * 512 + d;
            const float val = bf2f(U[o]) * (acc[j][r] + bias[t]); CB[(tok0 + t) * 1024 + d] = (bf16)f2bf(val); } }
    __syncthreads();
}
__device__ __forceinline__ void sgu_sample_unit(Frame& F, int b) {
    LAUNDER_TID(); const int c = tid, g = c >> 7; const bf16* U = (const bf16*)(F.ws + WS_U); const bf16* VR = (const bf16*)(F.ws + WS_VR); bf16* CB = (bf16*)(F.ws + WS_CB);
    const unsigned long long* vss = (const unsigned long long*)(F.ws + WS_SS);
    const float gn = F.in[I_SGN][c]; const float* W = F.in[I_SGW] + (size_t)g * 16384; const float* bias = F.in[I_SGB] + g * 128;
    float v[8];
#pragma unroll
    for (int t = 0; t < 8; ++t) { const size_t tok = NP + 8 * b + t; v[t] = bf2f(VR[tok * 512 + c]) * ss_rinv(vss + tok, 1.0f / 512.0f) * gn; F.out[OFF_CV + (size_t)(8 * b + t) * 512 + c] = v[t]; }
#pragma unroll
    for (int t = 0; t < 8; ++t) { float s = bias[t];
#pragma unroll
        for (int k = 0; k <= t; ++k) s += W[t * 128 + k] * v[k];
        const size_t tok = NP + 8 * b + t; CB[tok * 1024 + c] = (bf16)f2bf(bf2f(U[tok * 512 + c]) * s); }
}

struct Soft16 { float m, l; };
__device__ __forceinline__ void smax_update(f32x4 (&s)[4], Soft16& st, f32x4 (&O)[8], bf16x8& pf0, bf16x8& pf1) {
    float mx = fmaxf(fmaxf(s[0][0], s[0][1]), fmaxf(s[0][2], s[0][3]));
#pragma unroll
    for (int i = 1; i < 4; ++i) mx = fmaxf(mx, fmaxf(fmaxf(s[i][0], s[i][1]), fmaxf(s[i][2], s[i][3])));
    mx = fmaxf(mx, __shfl_xor(mx, 16)); mx = fmaxf(mx, __shfl_xor(mx, 32));
    const float mn = fmaxf(st.m, mx), al = ex2(st.m - mn); st.m = mn; float sum = 0.f;
#pragma unroll
    for (int i = 0; i < 4; ++i)
#pragma unroll
        for (int r = 0; r < 4; ++r) { s[i][r] = ex2(s[i][r] - mn); sum += s[i][r]; }
    st.l = st.l * al + sum;
#pragma unroll
    for (int nb = 0; nb < 8; ++nb) O[nb] = O[nb] * al;
    pf0 = pack_bf8(s[0], s[1]); pf1 = pack_bf8(s[2], s[3]);
}
__device__ __forceinline__ void attn_prompt_unit(Frame& F, float lam, int b, int h, int qb) {
    LAUNDER_TID(); const int g = lane >> 4, li = lane & 15;
    const bf16* QB = (const bf16*)(F.ws + WS_QB); const bf16* KB = (const bf16*)(F.ws + WS_KB); const bf16* VB = (const bf16*)(F.ws + WS_VB); bf16* CB = (bf16*)(F.ws + WS_CB);
    const size_t rowbase = (size_t)b * SEQ; const int qrel = 16 * wave + li; const size_t qtok = rowbase + 128 * qb + qrel;
    bf16x8 qf[4];
#pragma unroll
    for (int s = 0; s < 4; ++s) qf[s] = *(const bf16x8*)(QB + qtok * 512 + h * 128 + 32 * s + 8 * g);
    const int nt = 2 * qb + 2;
    const int skey = tid >> 4, sch = tid & 15;
    const bf16* kg = KB + (rowbase + skey) * 512 + h * 128 + 8 * sch; const bf16* vg = VB + (rowbase + skey) * 512 + h * 128 + 8 * sch;
    const int kw0 = skey * 256 + ((sch ^ (skey & 15)) << 4), vw0 = skey * 256 + (((sch >> 1) ^ (skey & 7)) << 5) + (sch & 1) * 16;
    LAS unsigned char* L = F.lds;
    int kad[4];
#pragma unroll
    for (int s = 0; s < 4; ++s) kad[s] = li * 256 + (((4 * s + g) ^ li) << 4);
    const int vq = li >> 2, vp = li & 3, vk7 = (4 * g + vq) & 7; int vad[8];
#pragma unroll
    for (int nb = 0; nb < 8; ++nb) vad[nb] = (4 * g + vq) * 256 + ((nb ^ vk7) << 5) + 8 * vp;
    f32x4 O1[8], O2[8]; Soft16 st1{-1e30f, 0.f}, st2{-1e30f, 0.f};
#pragma unroll
    for (int nb = 0; nb < 8; ++nb) { O1[nb] = (f32x4){0.f, 0.f, 0.f, 0.f}; O2[nb] = (f32x4){0.f, 0.f, 0.f, 0.f}; }
    v4u kr0, kr1, vr0, vr1;
    kr0 = *(const v4u*)kg; kr1 = *(const v4u*)(kg + 32 * 512); vr0 = *(const v4u*)vg; vr1 = *(const v4u*)(vg + 32 * 512);
    *(LAS v4u*)(L + kw0) = kr0; *(LAS v4u*)(L + kw0 + 32 * 256) = kr1; *(LAS v4u*)(L + 16384 + vw0) = vr0; *(LAS v4u*)(L + 16384 + vw0 + 32 * 256) = vr1;
    __syncthreads();
    for (int t = 0; t < nt; ++t) {
        const int bo = (t & 1) * 32768;
        if (t + 1 < nt) { const size_t go = (size_t)(t + 1) * 64 * 512; kr0 = *(const v4u*)(kg + go); kr1 = *(const v4u*)(kg + go + 32 * 512); vr0 = *(const v4u*)(vg + go); vr1 = *(const v4u*)(vg + go + 32 * 512); }
        if (!(t == nt - 1 && wave < 4)) {
            const LAS unsigned char* Kt = L + bo; const LAS unsigned char* Vt = L + bo + 16384;
            f32x4 s1[4], s2[4];
#pragma unroll
            for (int sub = 0; sub < 4; ++sub) {
                const bf16x8 k0 = *(const LAS bf16x8*)(Kt + sub * 4096 + kad[0]), k1 = *(const LAS bf16x8*)(Kt + sub * 4096 + kad[1]);
                const bf16x8 k2 = *(const LAS bf16x8*)(Kt + sub * 4096 + kad[2]), k3 = *(const LAS bf16x8*)(Kt + sub * 4096 + kad[3]);
                s1[sub] = mfma16(k0, qf[0], (f32x4){0.f, 0.f, 0.f, 0.f}); s1[sub] = mfma16(k1, qf[1], s1[sub]);
                s2[sub] = mfma16(k2, qf[2], (f32x4){0.f, 0.f, 0.f, 0.f}); s2[sub] = mfma16(k3, qf[3], s2[sub]);
            }
            if (t >= nt - 2) {
                const int kb0 = 64 * (t - 2 * qb) + 4 * g;
#pragma unroll
                for (int sub = 0; sub < 4; ++sub)
#pragma unroll
                    for (int r = 0; r < 4; ++r) if (kb0 + 16 * sub + r > qrel) { s1[sub][r] = -__builtin_inff(); s2[sub][r] = -__builtin_inff(); }
            }
            bf16x8 p1a, p1b, p2a, p2b;
            smax_update(s1, st1, O1, p1a, p1b); smax_update(s2, st2, O2, p2a, p2b);
#pragma unroll
            for (int nb = 0; nb < 8; ++nb) {
                const bf16x8 va = tr_pair(Vt + vad[nb], Vt + vad[nb] + 16 * 256), vb = tr_pair(Vt + vad[nb] + 32 * 256, Vt + vad[nb] + 48 * 256);
                O1[nb] = mfma16(va, p1a, O1[nb]); O2[nb] = mfma16(va, p2a, O2[nb]);
                O1[nb] = mfma16(vb, p1b, O1[nb]); O2[nb] = mfma16(vb, p2b, O2[nb]);
            }
        }
        if (t + 1 < nt) { const int wo = ((t + 1) & 1) * 32768; *(LAS v4u*)(L + wo + kw0) = kr0; *(LAS v4u*)(L + wo + kw0 + 32 * 256) = kr1; *(LAS v4u*)(L + wo + 16384 + vw0) = vr0; *(LAS v4u*)(L + wo + 16384 + vw0 + 32 * 256) = vr1; }
        __syncthreads();
    }
    float l1 = st1.l; l1 += __shfl_xor(l1, 16); l1 += __shfl_xor(l1, 32);
    float l2 = st2.l; l2 += __shfl_xor(l2, 16); l2 += __shfl_xor(l2, 32);
    const float i1 = 1.0f / l1, i2 = lam / l2; float ssq = 0.f;
#pragma unroll
    for (int nb = 0; nb < 8; ++nb)
#pragma unroll
        for (int r = 0; r < 4; ++r) { const float o = O1[nb][r] * i1 - O2[nb][r] * i2; O1[nb][r] = o; ssq += o * o; }
    ssq += __shfl_xor(ssq, 16); ssq += __shfl_xor(ssq, 32);
    const float rn = (1.0f - LAM_INIT) / sqrtf(ssq * (1.0f / 128.0f) + EPS);
    const float* sub = F.in[I_SUBLN];
#pragma unroll
    for (int nb = 0; nb < 8; ++nb) { const int dv = 16 * nb + 4 * g; const f32x4 sg = *(const f32x4*)(sub + dv);
        const unsigned w0 = cvtpk(O1[nb][0] * rn * sg[0], O1[nb][1] * rn * sg[1]), w1 = cvtpk(O1[nb][2] * rn * sg[2], O1[nb][3] * rn * sg[3]);
        *(unsigned long long*)(CB + qtok * 1024 + 512 + h * 128 + dv) = (unsigned long long)w0 | ((unsigned long long)w1 << 32); }
}

__device__ __forceinline__ void attn_sample_unit(Frame& F, int b, int rg) {
    LAUNDER_TID(); const int g = lane >> 4, li = lane & 15, head = wave & 3, hf = wave >> 2;
    const bf16* QB = (const bf16*)(F.ws + WS_QB); const float* CK = F.in[I_CK]; const float* CV = F.in[I_CV]; const int* PT = (const int*)F.in[I_PT] + b * 64 + 8 * rg + 4 * hf;
    bf16x8 qf[4];
    { const int qi = li & 7, half = li >> 3; const bf16* qrow = QB + (size_t)(NP + 8 * b + qi) * 512 + head * 128;
#pragma unroll
      for (int s = 0; s < 4; ++s) { bf16x8 z = (bf16x8){0, 0, 0, 0, 0, 0, 0, 0}; if ((s >> 1) == half) z = *(const bf16x8*)(qrow + 32 * s + 8 * g); qf[s] = z; } }
    LAS unsigned char* Kt = F.lds + wave * 16384; LAS unsigned char* Vt = Kt + 8192;
    const int l31 = lane & 31, lh = lane >> 5;
    const int kwr = ((l31 >> 1) << 4) + (l31 & 1) * 8;
    const int vwu = l31 >> 2, vwo = (l31 & 3) * 8;
    int kad[4];
#pragma unroll
    for (int s = 0; s < 4; ++s) kad[s] = li * 256 + (((4 * s + g) ^ li) << 4);
    const int vq = li >> 2, vp = li & 3, vk7 = (4 * g + vq) & 7; int vad[8];
#pragma unroll
    for (int nb = 0; nb < 8; ++nb) vad[nb] = (4 * g + vq) * 256 + ((nb ^ vk7) << 5) + 8 * vp;
    f32x4 O[8]; Soft16 st{-1e30f, 0.f};
#pragma unroll
    for (int nb = 0; nb < 8; ++nb) O[nb] = (f32x4){0.f, 0.f, 0.f, 0.f};
    f32x4 kr[16], vr[16];
#define SLOAD(t) do { const int phys_ = __builtin_amdgcn_readfirstlane(PT[(t) >> 2]); const size_t e0_ = (((size_t)phys_ * 128 + 32 * ((t) & 3) + lh) * 4 + head) * 128 + 4 * l31; \
        _Pragma("unroll") for (int i_ = 0; i_ < 16; ++i_) { kr[i_] = __builtin_nontemporal_load((const f32x4*)(CK + e0_ + (size_t)i_ * 1024)); vr[i_] = __builtin_nontemporal_load((const f32x4*)(CV + e0_ + (size_t)i_ * 1024)); } } while (0)
    SLOAD(0);
#pragma unroll 1
    for (int t = 0; t < 16; ++t) {
#pragma unroll
        for (int i = 0; i < 16; ++i) { const int key = 2 * i + lh;
            *(LAS unsigned long long*)(Kt + key * 256 + (kwr ^ ((key & 15) << 4))) = (unsigned long long)cvtpk(kr[i][0], kr[i][1]) | ((unsigned long long)cvtpk(kr[i][2], kr[i][3]) << 32);
            *(LAS unsigned long long*)(Vt + key * 256 + ((vwu ^ (key & 7)) << 5) + vwo) = (unsigned long long)cvtpk(vr[i][0], vr[i][1]) | ((unsigned long long)cvtpk(vr[i][2], vr[i][3]) << 32); }
        if (t + 1 < 16) SLOAD(t + 1);
        f32x4 s[2];
#pragma unroll
        for (int sub = 0; sub < 2; ++sub) {
            s[sub] = (f32x4){0.f, 0.f, 0.f, 0.f};
#pragma unroll
            for (int ks = 0; ks < 4; ++ks) s[sub] = mfma16(*(const LAS bf16x8*)(Kt + sub * 4096 + kad[ks]), qf[ks], s[sub]);
        }
        float mx = fmaxf(fmaxf(fmaxf(s[0][0], s[0][1]), fmaxf(s[0][2], s[0][3])), fmaxf(fmaxf(s[1][0], s[1][1]), fmaxf(s[1][2], s[1][3])));
        mx = fmaxf(mx, __shfl_xor(mx, 16)); mx = fmaxf(mx, __shfl_xor(mx, 32));
        const float mn = fmaxf(st.m, mx), al = ex2(st.m - mn); st.m = mn; float sum = 0.f;
#pragma unroll
        for (int i = 0; i < 2; ++i)
#pragma unroll
            for (int r = 0; r < 4; ++r) { s[i][r] = ex2(s[i][r] - mn); sum += s[i][r]; }
        st.l = st.l * al + sum;
        const bf16x8 pf = pack_bf8(s[0], s[1]);
#pragma unroll
        for (int nb = 0; nb < 8; ++nb) { const bf16x8 va = tr_pair(Vt + vad[nb], Vt + vad[nb] + 16 * 256); O[nb] = mfma16(va, pf, O[nb] * al); }
    }
#undef SLOAD
    float l = st.l; l += __shfl_xor(l, 16); l += __shfl_xor(l, 32);
    float* P = (float*)(F.ws + WS_PART) + ((size_t)(b * 4 + head) * 16 + 2 * rg + hf) * PART_STRIDE;
    if (g == 0) { P[li] = st.m; P[16 + li] = l; }
#pragma unroll
    for (int nb = 0; nb < 8; ++nb) *(f32x4*)(P + 32 + li * 128 + 16 * nb + 4 * g) = O[nb];
}
__device__ __forceinline__ void attn_sample_combine(Frame& F, float lam, int b, int head) {
    LAUNDER_TID(); const int qp = tid >> 5, dvc = tid & 31, qi = qp & 7, half = qp >> 3, dv = 4 * dvc;
    const bf16* QB = (const bf16*)(F.ws + WS_QB); const bf16* KB = (const bf16*)(F.ws + WS_KB); const bf16* VB = (const bf16*)(F.ws + WS_VB); bf16* CB = (bf16*)(F.ws + WS_CB);
    const float* P = (const float*)(F.ws + WS_PART) + (size_t)(b * 4 + head) * 16 * PART_STRIDE;
    float M = -1e30f;
    for (int sl = 0; sl < 16; ++sl) M = fmaxf(M, P[sl * PART_STRIDE + qp]);
    const size_t tq = NP + 8 * b + qi; const bf16* qrow = QB + tq * 512 + head * 128 + 64 * half;
    float sc[8];
#pragma unroll
    for (int j = 0; j < 8; ++j) { const bf16* krow = KB + (size_t)(NP + 8 * b + j) * 512 + head * 128 + 64 * half; float d = 0.f;
#pragma unroll 2
        for (int e = 0; e < 8; ++e) { const v4u a = *(const v4u*)(qrow + 8 * e), k = *(const v4u*)(krow + 8 * e);
            d += (bflo(a.x) * bflo(k.x) + bfhi(a.x) * bfhi(k.x)) + (bflo(a.y) * bflo(k.y) + bfhi(a.y) * bfhi(k.y)) + (bflo(a.z) * bflo(k.z) + bfhi(a.z) * bfhi(k.z)) + (bflo(a.w) * bflo(k.w) + bfhi(a.w) * bfhi(k.w)); }
        sc[j] = (j <= qi) ? d : -__builtin_inff(); M = fmaxf(M, sc[j]); }
    float Lacc = 0.f; f32x4 Oa = (f32x4){0.f, 0.f, 0.f, 0.f};
    for (int sl = 0; sl < 16; ++sl) { const float w = ex2(P[sl * PART_STRIDE + qp] - M); Lacc += w * P[sl * PART_STRIDE + 16 + qp]; Oa = Oa + *(const f32x4*)(P + sl * PART_STRIDE + 32 + qp * 128 + dv) * w; }
#pragma unroll
    for (int j = 0; j < 8; ++j) { const float p = ex2(sc[j] - M); Lacc += p; const float pb = bf2f((unsigned short)f2bf(p));
        const bf16* vrow = VB + (size_t)(NP + 8 * b + j) * 512 + head * 128 + dv;
        Oa[0] += pb * bf2f(vrow[0]); Oa[1] += pb * bf2f(vrow[1]); Oa[2] += pb * bf2f(vrow[2]); Oa[3] += pb * bf2f(vrow[3]); }
    LAS float* buf = (LAS float*)F.lds;
    const float inv = 1.0f / Lacc;
    *(LAS f32x4*)(buf + (half * 8 + qi) * 128 + dv) = Oa * inv;
    __syncthreads();
    if (half == 0) {
        const f32x4 a = *(const LAS f32x4*)(buf + qi * 128 + dv), c = *(const LAS f32x4*)(buf + (8 + qi) * 128 + dv); const f32x4 o = a - c * lam;
        float ssq = (o[0] * o[0] + o[1] * o[1]) + (o[2] * o[2] + o[3] * o[3]);
#pragma unroll
        for (int x = 1; x < 32; x <<= 1) ssq += __shfl_xor(ssq, x);
        const float rn = (1.0f - LAM_INIT) / sqrtf(ssq * (1.0f / 128.0f) + EPS); const f32x4 sg = *(const f32x4*)(F.in[I_SUBLN] + dv);
        const unsigned w0 = cvtpk(o[0] * rn * sg[0], o[1] * rn * sg[1]), w1 = cvtpk(o[2] * rn * sg[2], o[3] * rn * sg[3]);
        *(unsigned long long*)(CB + tq * 1024 + 512 + head * 128 + dv) = (unsigned long long)w0 | ((unsigned long long)w1 << 32);
    }
    __syncthreads();
}

__device__ __forceinline__ void ssm_prompt_unit(Frame& F, int b, int g) {
    LAUNDER_TID(); const int n = lane & 31, hi = lane >> 5, chunk = 32 * wave + n;
    const bf16* XB = (const bf16*)(F.ws + WS_XB); bf16* G = (bf16*)(F.ws + WS_CB);
    const unsigned long long* ss2 = (const unsigned long long*)(F.ws + WS_SS) + 2 * (size_t)NTOK;
    const bf16* Tg = (const bf16*)(F.ws + WS_T) + (size_t)g * 65536; const bf16* Eg = (const bf16*)(F.ws + WS_E) + (size_t)g * 32768; const bf16* Fg = (const bf16*)(F.ws + WS_F) + (size_t)g * 32768;
    LAS float* S = (LAS float*)F.lds;
    const size_t tok0 = (size_t)b * SEQ + 16 * chunk;
    bf16x8 uf[16];
#pragma unroll
    for (int ks = 0; ks < 16; ++ks) { const size_t tok = tok0 + ks; const v4u w = *(const v4u*)(XB + tok * 1024 + 16 * g + 8 * hi); const float r = ss_rinv(ss2 + tok, 1.0f / 1024.0f);
        v4u o; o.x = cvtpk(bflo(w.x) * r, bfhi(w.x) * r); o.y = cvtpk(bflo(w.y) * r, bfhi(w.y) * r); o.z = cvtpk(bflo(w.z) * r, bfhi(w.z) * r); o.w = cvtpk(bflo(w.w) * r, bfhi(w.w) * r);
        uf[ks] = __builtin_bit_cast(bf16x8, o); }
#pragma unroll 1
    for (int mb = 0; mb < 4; ++mb) {
        f32x16 acc = (f32x16){};
#pragma unroll
        for (int ks = 0; ks < 16; ++ks) acc = mfma32(*(const bf16x8*)(Eg + (32 * mb + n) * 256 + 16 * ks + 8 * hi), uf[ks], acc);
#pragma unroll
        for (int i = 0; i < 4; ++i) *(LAS f32x4*)(S + chunk * 132 + 32 * mb + 8 * i + 4 * hi) = (f32x4){acc[4 * i], acc[4 * i + 1], acc[4 * i + 2], acc[4 * i + 3]};
    }
    __syncthreads();
    {
        LAS float* car = S + 256 * 132;
        const f32x2_t aL = ((const f32x2_t*)(F.ws + WS_PW16))[g * 64 + lane]; float sr = 0.f, si = 0.f;
#pragma unroll 8
        for (int c = 32 * wave; c < 32 * wave + 32; ++c) { const float lr = S[c * 132 + lane], li_ = S[c * 132 + 64 + lane]; S[c * 132 + lane] = sr; S[c * 132 + 64 + lane] = si;
            const float nr = aL.x * sr - aL.y * si + lr, ni = aL.x * si + aL.y * sr + li_; sr = nr; si = ni; }
        car[wave * 128 + lane] = sr; car[wave * 128 + 64 + lane] = si;
        __syncthreads();
        float ar = aL.x, ai = aL.y;
#pragma unroll
        for (int q = 0; q < 5; ++q) { const float nr = ar * ar - ai * ai, ni = 2.f * ar * ai; ar = nr; ai = ni; }
        float cr = 0.f, ci = 0.f;
        for (int w2 = 0; w2 < wave; ++w2) { const float lr = car[w2 * 128 + lane], li_ = car[w2 * 128 + 64 + lane]; const float nr = ar * cr - ai * ci + lr, ni = ar * ci + ai * cr + li_; cr = nr; ci = ni; }
        float pr = 1.f, pi = 0.f;
#pragma unroll 8
        for (int c = 32 * wave; c < 32 * wave + 32; ++c) { S[c * 132 + lane] += pr * cr - pi * ci; S[c * 132 + 64 + lane] += pr * ci + pi * cr;
            const float nr = pr * aL.x - pi * aL.y, ni = pr * aL.y + pi * aL.x; pr = nr; pi = ni; }
        if (wave == 7) { const float fr_ = ar * cr - ai * ci + sr, fi_ = ar * ci + ai * cr + si;
            F.out[OFF_SRP + (size_t)(b * 64 + g) * 64 + lane] = fr_; F.out[OFF_SIP + (size_t)(b * 64 + g) * 64 + lane] = fi_; }
    }
    __syncthreads();
    bf16x8 sf[8];
#pragma unroll
    for (int ks = 0; ks < 8; ++ks) { const f32x4 a = *(const LAS f32x4*)(S + chunk * 132 + 16 * ks + 8 * hi), c = *(const LAS f32x4*)(S + chunk * 132 + 16 * ks + 8 * hi + 4); sf[ks] = pack_bf8(a, c); }
#pragma unroll
    for (int mb = 0; mb < 8; ++mb) {
        f32x16 acc = (f32x16){};
#pragma unroll
        for (int ks = 0; ks < 16; ++ks) if (ks <= 2 * mb + 1) acc = mfma32(*(const bf16x8*)(Tg + (32 * mb + n) * 256 + 16 * ks + 8 * hi), uf[ks], acc);
#pragma unroll
        for (int ks = 0; ks < 8; ++ks) acc = mfma32(*(const bf16x8*)(Fg + (32 * mb + n) * 128 + 16 * ks + 8 * hi), sf[ks], acc);
#pragma unroll
        for (int i = 0; i < 4; ++i) { const int t = 2 * mb + (i >> 1), c = 8 * (i & 1) + 4 * hi;
            const unsigned w0 = cvtpk(gelu_t(acc[4 * i]), gelu_t(acc[4 * i + 1])), w1 = cvtpk(gelu_t(acc[4 * i + 2]), gelu_t(acc[4 * i + 3]));
            *(unsigned long long*)(G + (tok0 + t) * 1024 + 16 * g + c) = (unsigned long long)w0 | ((unsigned long long)w1 << 32); }
    }
    __syncthreads();
}
__device__ __forceinline__ void ssm_sample_unit(Frame& F, int b, int g) {
    LAUNDER_TID(); const int p = lane; const bf16* XB = (const bf16*)(F.ws + WS_XB); bf16* G = (bf16*)(F.ws + WS_CB);
    const unsigned long long* ss2 = (const unsigned long long*)(F.ws + WS_SS) + 2 * (size_t)NTOK;
    const f32x2_t a = ((const f32x2_t*)(F.ws + WS_PW1))[g * 64 + p]; const f32x2_t* BB = (const f32x2_t*)(F.ws + WS_BBAR) + (size_t)g * 1024 + p * 16;
    const float* c_re = F.in[I_CRE] + (size_t)g * 1024; const float* c_im = F.in[I_CIM] + (size_t)g * 1024; const float* g1 = F.in[I_NMIX] + 1024 + 16 * g; const float* dsk = F.in[I_SD] + 16 * g;
    LAS float* sh = (LAS float*)(F.lds + wave * 4096);
    float sr = F.in[I_SRE][(size_t)(b * 64 + g) * 64 + p], si = F.in[I_SIM][(size_t)(b * 64 + g) * 64 + p];
    f32x2_t bb[16];
#pragma unroll
    for (int c = 0; c < 16; ++c) bb[c] = BB[c];
#pragma unroll
    for (int t = 0; t < 8; ++t) {
        const size_t tok = NP + 8 * b + t; const float r = ss_rinv(ss2 + tok, 1.0f / 1024.0f); float br = 0.f, bi = 0.f;
        const v4u w0 = *(const v4u*)(XB + tok * 1024 + 16 * g), w1 = *(const v4u*)(XB + tok * 1024 + 16 * g + 8); const unsigned ww[8] = {w0.x, w0.y, w0.z, w0.w, w1.x, w1.y, w1.z, w1.w};
#pragma unroll
        for (int c = 0; c < 16; ++c) { const float u = ((c & 1) ? bfhi(ww[c >> 1]) : bflo(ww[c >> 1])) * r * g1[c]; br += bb[c].x * u; bi += bb[c].y * u; }
        const float nr = a.x * sr - a.y * si + br, ni = a.x * si + a.y * sr + bi; sr = nr; si = ni;
        sh[t * 128 + p] = sr; sh[t * 128 + 64 + p] = si;
    }
    F.out[OFF_SRS + (size_t)(b * 64 + g) * 64 + p] = sr; F.out[OFF_SIS + (size_t)(b * 64 + g) * 64 + p] = si;
    LDS_WAIT(); asm volatile("" ::: "memory");
    {   const int t = lane >> 3, c0 = 2 * (lane & 7); const size_t tok = NP + 8 * b + t; float y0 = 0.f, y1 = 0.f;
        const float* cr0 = c_re + c0 * 64; const float* ci0 = c_im + c0 * 64;
#pragma unroll 4
        for (int q = 0; q < 16; ++q) { const f32x4 xr = *(const LAS f32x4*)(sh + t * 128 + 4 * q), xi = *(const LAS f32x4*)(sh + t * 128 + 64 + 4 * q);
            const f32x4 a0 = *(const f32x4*)(cr0 + 4 * q), b0 = *(const f32x4*)(ci0 + 4 * q), a1 = *(const f32x4*)(cr0 + 64 + 4 * q), b1 = *(const f32x4*)(ci0 + 64 + 4 * q);
#pragma unroll
            for (int e = 0; e < 4; ++e) { y0 += a0[e] * xr[e] - b0[e] * xi[e]; y1 += a1[e] * xr[e] - b1[e] * xi[e]; } }
        const float r = ss_rinv(ss2 + tok, 1.0f / 1024.0f); const unsigned xw = *(const unsigned*)(XB + tok * 1024 + 16 * g + c0);
        y0 += dsk[c0] * (bflo(xw) * r * g1[c0]); y1 += dsk[c0 + 1] * (bfhi(xw) * r * g1[c0 + 1]);
        *(unsigned*)(G + tok * 1024 + 16 * g + c0) = cvtpk(gelu_t(y0), gelu_t(y1));
    }
    LDS_WAIT(); asm volatile("" ::: "memory");
}

template <int MODE, int K>
__device__ __forceinline__ void sample_gemm_tile(Frame& F, const bf16* A, const bf16* Bt, int tile, const float* bglu, float* X, bf16* XB, bool wxb, unsigned long long* ss) {
    LAUNDER_TID();
    constexpr int kper = K / 8, nks = kper / 16;
    const int rb = tile >> 5, cb = tile & 31, r32 = lane & 31, hi = lane >> 5, k0 = wave * kper;
    const bf16* ap = A + (size_t)(32 * rb + r32) * K + k0 + 8 * hi;
    const int brow = MODE == 0 ? 32 * cb + r32 : 256 * (cb >> 2) + 32 * (cb & 3) + r32;
    const bf16* bp = Bt + (size_t)brow * K + k0 + 8 * hi;
    f32x16 acc = (f32x16){}, acc2 = (f32x16){};
#pragma unroll
    for (int ks = 0; ks < nks; ++ks) { const bf16x8 a = *(const bf16x8*)(ap + 16 * ks); const bf16x8 b = *(const bf16x8*)(bp + 16 * ks); acc = mfma32(a, b, acc);
        if (MODE == 1) { const bf16x8 b2 = *(const bf16x8*)(bp + (size_t)128 * K + 16 * ks); acc2 = mfma32(a, b2, acc2); } }
    LAS float* red = (LAS float*)F.lds;
#pragma unroll
    for (int r = 0; r < 16; ++r) { red[(wave * 16 + r) * 64 + lane] = acc[r]; if (MODE == 1) red[8192 + (wave * 16 + r) * 64 + lane] = acc2[r]; }
    __syncthreads();
#pragma unroll
    for (int h2 = 0; h2 < 2; ++h2) {
        const int r = (tid >> 6) + 8 * h2, l2 = tid & 63; float sum = 0.f, sum2 = 0.f;
#pragma unroll
        for (int w = 0; w < 8; ++w) { sum += red[(w * 16 + r) * 64 + l2]; if (MODE == 1) sum2 += red[8192 + (w * 16 + r) * 64 + l2]; }
        const int row = 32 * rb + (r & 3) + 8 * (r >> 2) + 4 * (l2 >> 5), col = 32 * cb + (l2 & 31); const size_t go = (size_t)(NP + row) * 1024 + col;
        float o = bf2f(XB[go]);
        if (MODE == 0) o += sum; else o += (sum + bglu[col]) * pg8::sigm(sum2 + bglu[1024 + col]);
        if (X) X[go] = o;
        if (wxb) XB[go] = (bf16)f2bf(o);
        float ssq = o * o;
#pragma unroll
        for (int x = 1; x < 32; x <<= 1) ssq += __shfl_xor(ssq, x);
        if ((l2 & 31) == 0) pg8::ss_add(ss + NP + row, ssq);
    }
    __syncthreads();
}
__device__ __forceinline__ void final_norm_row(Frame& F, int m) {
    LAUNDER_TID(); const float* X = (const float*)(F.ws + WS_X) + (size_t)m * 1024; const unsigned long long* ss4 = (const unsigned long long*)(F.ws + WS_SS) + 4 * (size_t)NTOK;
    const float r = ss_rinv(ss4 + m, 1.0f / 1024.0f); const float* gf = F.in[I_NFIN]; float* o = F.out + OFF_YP + (size_t)m * 1024;
#pragma unroll
    for (int j = 0; j < 4; ++j) { const int c = 4 * lane + 256 * j; const f32x4 v = *(const f32x4*)(X + c), gg = *(const f32x4*)(gf + c); *(f32x4*)(o + c) = v * gg * r; }
}
#ifndef MK_LAST_PHASE
#define MK_LAST_PHASE 99
#endif
#ifndef MK_REP_ATTNP
#define MK_REP_ATTNP 1
#endif
#ifndef MK_REP_ATTNS
#define MK_REP_ATTNS 1
#endif
#ifndef MK_REP_SGU
#define MK_REP_SGU 1
#endif
#ifndef MK_REP_SSM
#define MK_REP_SSM 1
#endif
#ifndef MK_REP_G3
#define MK_REP_G3 1
#endif
#ifndef MK_REP_P0
#define MK_REP_P0 1
#endif
#ifndef MK_REP_G1
#define MK_REP_G1 1
#endif
#ifndef MK_REP_FIN
#define MK_REP_FIN 1
#endif
#ifndef MK_PROBE_GEMMS
#define MK_PROBE_GEMMS 0
#endif
#ifndef MK_TMASK
#define MK_TMASK 0
#endif
#define MK_TMULT 4
struct Args { const float* in[32]; float* out; unsigned char* ws; };
__global__ void __launch_bounds__(NWAVES * 64, 2) hyb_fwd(Args args) {
    extern __shared__ __attribute__((aligned(16))) unsigned char lds[];
    Frame F;
    F.lds = (LAS unsigned char*)lds;
    F.MISC = (volatile LAS unsigned*)(F.lds + MISC_OFF);
    F.tid = threadIdx.x; F.lane = F.tid & 63; F.wave = __builtin_amdgcn_readfirstlane(F.tid >> 6);
    F.G = gridDim.x; { const int bx = blockIdx.x; F.vcu = (F.G % 8 == 0) ? (bx % 8) * (F.G / 8) + bx / 8 : bx; }
    F.in = args.in;
    F.out = args.out; F.ws = args.ws; F.ctl = (gu32*)(args.ws + WS_CTL);
    for (int u = F.tid; u < (LDS_BYTES - LDSCTL_OFF) / 4; u += NWAVES * 64) ((LAS unsigned*)(F.lds + LDSCTL_OFF))[u] = 0u;
    __syncthreads();
    XcdBarrier bar = xcd_barrier_post((unsigned*)(F.ctl + CW_BAR), F.MISC + 8);
#define GRID_BAR() xcd_barrier(bar)
    unsigned long long t_prev = 0, t_acc = 0; int t_idx = 0;
#define TSTAMP() do { if (MK_TMASK) { const unsigned long long t_now = __builtin_amdgcn_s_memrealtime(); if ((MK_TMASK >> t_idx) & 1) t_acc += t_now - t_prev; t_prev = t_now; ++t_idx; } } while (0)
    if (MK_TMASK) t_prev = __builtin_amdgcn_s_memrealtime();
    unsigned char* ws = F.ws;
    bf16* XB = (bf16*)(ws + WS_XB); float* X = (float*)(ws + WS_X); bf16* CB = (bf16*)(ws + WS_CB); bf16* ACT = (bf16*)(ws + WS_ACT);
    unsigned long long* SS = (unsigned long long*)(ws + WS_SS);
    const int gw = F.vcu * NWAVES + F.wave, NGW = F.G * NWAVES;

    for (int rep = 0; rep < MK_REP_P0; ++rep) { p0_prologue(F); __syncthreads(); }
    GRID_BAR(); TSTAMP();
    for (int rep = 0; rep < MK_REP_G1; ++rep) {
        pg8::Gemm g{XB, (const bf16*)(ws + WS_W1), NTOK, 2560, 1024}; pg8::StaticOrder S; S.init(NTOK, 2560, F.G, (int)blockIdx.x);
        pg8::EpiInProj E{(const float*)(ws + WS_R0), (bf16*)(ws + WS_U), (bf16*)(ws + WS_VR), (bf16*)(ws + WS_QB), (bf16*)(ws + WS_KB), (bf16*)(ws + WS_VB), SS, F.out, rep == 0};
        pg8::gemm_phase<pg8::EpiInProj, pg8::StaticOrder, true, true>(F.lds + RING_OFF, g, S, E);
    }
    GRID_BAR(); TSTAMP();
    const float lam = lambda_val(F);
    if (MK_LAST_PHASE >= 2) {
        for (int rep = 0; rep < MK_REP_ATTNP; ++rep)
        for (int u = F.vcu; u < 256; u += F.G) { const int bh = u >> 4, s = u & 15; attn_prompt_unit(F, lam, bh >> 2, bh & 3, s); attn_prompt_unit(F, lam, bh >> 2, bh & 3, 31 - s); }
        for (int rep = 0; rep < MK_REP_ATTNS; ++rep)
        for (int u = F.vcu; u < 256; u += F.G) attn_sample_unit(F, u >> 3, u & 7);
        __syncthreads();
        for (int rep = 0; rep < MK_REP_SGU; ++rep) {
        for (int u = F.vcu; u < 512; u += F.G) sgu_prompt_unit(F, u >> 2, u & 3);
        for (int u = F.vcu; u < 32; u += F.G) sgu_sample_unit(F, u); }
    }
    GRID_BAR(); TSTAMP();
    if (MK_LAST_PHASE >= 2) { for (int u = F.vcu; u < 128; u += F.G) attn_sample_combine(F, lam, u >> 2, u & 3); }
    GRID_BAR(); TSTAMP();
    if (MK_LAST_PHASE >= 3) {
        pg8::Gemm g{CB, (const bf16*)(ws + WS_W2), NP, 1024, 1024}; pg8::StaticOrder S; S.init(NP, 1024, F.G, (int)blockIdx.x);
        pg8::EpiResid E{XB, nullptr, true, SS + 1 * (size_t)NTOK};
        pg8::gemm_phase<pg8::EpiResid, pg8::StaticOrder, true, true>(F.lds + RING_OFF, g, S, E);
        for (int t = F.vcu; t < 256; t += F.G) sample_gemm_tile<0, 1024>(F, CB + (size_t)NP * 1024, (const bf16*)(ws + WS_W2), t, nullptr, nullptr, XB, true, SS + 1 * (size_t)NTOK);
    }
    GRID_BAR(); TSTAMP();
    for (int rep = 0; rep < MK_REP_G3; ++rep) {
        pg8::Gemm g{XB, (const bf16*)(ws + WS_W3), NTOK, 5632, 1024}; pg8::StaticOrder S; S.init(NTOK, 5632, F.G, (int)blockIdx.x);
        pg8::EpiSwiGLU E{SS + 1 * (size_t)NTOK, ACT};
        pg8::gemm_phase<pg8::EpiSwiGLU, pg8::StaticOrder, true, true>(F.lds + RING_OFF, g, S, E);
    }
    GRID_BAR(); TSTAMP();
    if (MK_LAST_PHASE >= 5) {
        pg8::Gemm g{ACT, (const bf16*)(ws + WS_W4), NP, 1024, 2816}; pg8::StaticOrder S; S.init(NP, 1024, F.G, (int)blockIdx.x);
        pg8::EpiResid E{XB, nullptr, true, SS + 2 * (size_t)NTOK};
        pg8::gemm_phase<pg8::EpiResid, pg8::StaticOrder, true, true>(F.lds + RING_OFF, g, S, E);
        for (int t = F.vcu; t < 256; t += F.G) sample_gemm_tile<0, 2816>(F, ACT + (size_t)NP * 2816, (const bf16*)(ws + WS_W4), t, nullptr, nullptr, XB, true, SS + 2 * (size_t)NTOK);
    }
    GRID_BAR(); TSTAMP();
    if (MK_LAST_PHASE >= 6) {
        for (int rep = 0; rep < MK_REP_SSM; ++rep) {
        for (int u = F.vcu; u < 256; u += F.G) ssm_prompt_unit(F, u >> 6, u & 63);
        for (int w = gw; w < 2048; w += NGW) ssm_sample_unit(F, w >> 6, w & 63); }
    }
    GRID_BAR(); TSTAMP();
    if (MK_LAST_PHASE >= 7) {
        pg8::Gemm g{CB, (const bf16*)(ws + WS_W5), NP, 2048, 1024}; pg8::StaticOrder S; S.init(NP, 2048, F.G, (int)blockIdx.x);
        pg8::EpiGLU E{F.in[I_BGLU], XB, SS + 3 * (size_t)NTOK};
        pg8::gemm_phase<pg8::EpiGLU, pg8::StaticOrder, true, true>(F.lds + RING_OFF, g, S, E);
        for (int t = F.vcu; t < 256; t += F.G) sample_gemm_tile<1, 1024>(F, CB + (size_t)NP * 1024, (const bf16*)(ws + WS_W5), t, F.in[I_BGLU], nullptr, XB, true, SS + 3 * (size_t)NTOK);
    }
    GRID_BAR(); TSTAMP();
    if (MK_LAST_PHASE >= 8) {
        pg8::Gemm g{XB, (const bf16*)(ws + WS_W6), NTOK, 5632, 1024}; pg8::StaticOrder S; S.init(NTOK, 5632, F.G, (int)blockIdx.x);
        pg8::EpiSwiGLU E{SS + 3 * (size_t)NTOK, ACT};
        pg8::gemm_phase<pg8::EpiSwiGLU, pg8::StaticOrder, true, true>(F.lds + RING_OFF, g, S, E);
    }
    GRID_BAR(); TSTAMP();
    if (MK_LAST_PHASE >= 9) {
        pg8::Gemm g{ACT, (const bf16*)(ws + WS_W7), NP, 1024, 2816}; pg8::StaticOrder S; S.init(NP, 1024, F.G, (int)blockIdx.x);
        pg8::EpiResid E{XB, X, false, SS + 4 * (size_t)NTOK};
        pg8::gemm_phase<pg8::EpiResid, pg8::StaticOrder, true, true>(F.lds + RING_OFF, g, S, E);
        for (int t = F.vcu; t < 256; t += F.G) sample_gemm_tile<0, 2816>(F, ACT + (size_t)NP * 2816, (const bf16*)(ws + WS_W7), t, nullptr, X, XB, false, SS + 4 * (size_t)NTOK);
    }
    GRID_BAR(); TSTAMP();
#if MK_PROBE_GEMMS
    {   pg8::EpiNull E{X, (int)F.G};
        { pg8::Gemm g{CB, (const bf16*)(ws + WS_W2), NP, 1024, 1024}; pg8::StaticOrder S; S.init(NP, 1024, F.G, (int)blockIdx.x); pg8::gemm_phase<pg8::EpiNull, pg8::StaticOrder, true, true>(F.lds + RING_OFF, g, S, E); }
        { pg8::Gemm g{ACT, (const bf16*)(ws + WS_W4), NP, 1024, 2816}; pg8::StaticOrder S; S.init(NP, 1024, F.G, (int)blockIdx.x); pg8::gemm_phase<pg8::EpiNull, pg8::StaticOrder, true, true>(F.lds + RING_OFF, g, S, E); }
        { pg8::Gemm g{CB, (const bf16*)(ws + WS_W5), NP, 2048, 1024}; pg8::StaticOrder S; S.init(NP, 2048, F.G, (int)blockIdx.x); pg8::gemm_phase<pg8::EpiNull, pg8::StaticOrder, true, true>(F.lds + RING_OFF, g, S, E); }
        { pg8::Gemm g{ACT, (const bf16*)(ws + WS_W7), NP, 1024, 2816}; pg8::StaticOrder S; S.init(NP, 1024, F.G, (int)blockIdx.x); pg8::gemm_phase<pg8::EpiNull, pg8::StaticOrder, true, true>(F.lds + RING_OFF, g, S, E); }
    }
#endif
    for (int rep = 0; rep < MK_REP_FIN; ++rep) { for (int m = gw; m < NTOK; m += NGW) final_norm_row(F, m); }
    if (MK_TMASK) { TSTAMP(); if (blockIdx.x == 0 && F.tid == 0) { const unsigned long long t0_ = __builtin_amdgcn_s_memrealtime(); while (__builtin_amdgcn_s_memrealtime() - t0_ < MK_TMULT * t_acc) __builtin_amdgcn_s_sleep(8); } }
}

extern "C" void kernel_launch(void* const* d_in, const int* in_sizes, int n_in, void* d_out, int out_size, void* d_ws, size_t ws_size, hipStream_t stream) {
    static int grid = 0;
    if (grid == 0) {
        if (n_in != 32 || (size_t)out_size != OUT_TOTAL || ws_size < WS_END) { fprintf(stderr, "kernel_launch: shape mismatch (n_in %d, out %d, ws %zu); nothing launched\n", n_in, out_size, ws_size); grid = -1; return; }
        int dev = 0, cus = 0, per_cu = 0;
        if (hipGetDevice(&dev) != hipSuccess || hipDeviceGetAttribute(&cus, hipDeviceAttributeMultiprocessorCount, dev) != hipSuccess) { grid = -1; return; }
        if (hipFuncSetAttribute((const void*)hyb_fwd, hipFuncAttributeMaxDynamicSharedMemorySize, LDS_BYTES) != hipSuccess) { fprintf(stderr, "kernel_launch: hipFuncSetAttribute failed\n"); grid = -1; return; }
        if (hipOccupancyMaxActiveBlocksPerMultiprocessor(&per_cu, (const void*)hyb_fwd, NWAVES * 64, LDS_BYTES) != hipSuccess || per_cu < 1) { fprintf(stderr, "kernel_launch: occupancy query says %d blocks per CU\n", per_cu); }
        (void)hipGetLastError();
        grid = cus;
    }
    if (grid < 0) return;
    if (hipMemsetAsync((char*)d_ws + WS_CTL, 0, CTL_ZERO_BYTES, stream) != hipSuccess) { fprintf(stderr, "kernel_launch: memset failed\n"); return; }
    Args a{};
    for (int i = 0; i < 32; ++i) a.in[i] = (const float*)d_in[i];
    a.out = (float*)d_out; a.ws = (unsigned char*)d_ws;
    hipLaunchKernelGGL(hyb_fwd, dim3(grid), dim3(NWAVES * 64), LDS_BYTES, stream, a);
    const hipError_t le = hipPeekAtLastError();
    if (le != hipSuccess) fprintf(stderr, "kernel_launch: launch failed: %s\n", hipGetErrorName(le));
}
```

```cpp
#include <hip/hip_runtime.h>
#include <cstdio>
#include <cstdint>
namespace pg8 {
#define PG8_LAS __attribute__((address_space(3)))
typedef unsigned short bf16_t;
typedef short bf16x8 __attribute__((ext_vector_type(8)));
typedef float f32x4 __attribute__((ext_vector_type(4)));
typedef unsigned u32x4 __attribute__((ext_vector_type(4)));
constexpr int BM = 256, BK = 64, HALF = 128, HTB = HALF * BK * 2  , STAGE_BYTES = 8 * HTB, NXCD = 8, WGM = 8;

__host__ __device__ __forceinline__ int lds_byte(int r, int c) { const int st = (r >> 4) * 2 + (c >> 5), rr = r & 15, cc = c & 31, ob = rr * 64 + cc * 2; return st * 1024 + (ob ^ (((ob >> 9) & 1) << 5)); }
__host__ __device__ __forceinline__ void stage_rc(int b, int& R, int& C) { const int st = b / 1024, sb = b % 1024, swz = sb ^ (((sb >> 9) & 1) << 5); R = (st >> 1) * 16 + swz / 64; C = (st & 1) * 32 + (swz % 64) / 2; }
__host__ __device__ __forceinline__ int perm32(int rho) { const int n = rho >> 4, i = rho & 15; return 8 * (i >> 2) + 4 * n + (i & 3); }

struct Unit { int pm, pn; };
struct Gemm { const bf16_t* A; const bf16_t* Bt; int M, N, K; };

struct StaticOrder {
    int nM, nN, nwg, G, c;
    __host__ __device__ void init(int M, int N, int G_, int c_) { nM = M / BM; nN = N / BM; nwg = nM * nN; G = G_; c = c_; }
    __host__ __device__ bool next(int i, Unit& u) const {
        const long L = (long)i * G + c; if (L >= nwg) return false;
        int wgid = (int)L; { const int q = nwg / NXCD, r = nwg % NXCD, xcd = wgid % NXCD, off = wgid / NXCD; wgid = (xcd < r ? xcd * (q + 1) : r * (q + 1) + (xcd - r) * q) + off; }
        const int nig = WGM * nN, gid = wgid / nig, fm = gid * WGM, gsz = (nM - fm) < WGM ? (nM - fm) : WGM;
        u.pm = fm + ((wgid % nig) % gsz); u.pn = (wgid % nig) / gsz; return true;
    }
    __device__ __forceinline__ void a_ready(const Unit&) const {}
    __device__ __forceinline__ void done(const Unit&) const {}
};

__device__ __forceinline__ unsigned cvt_pk_bf16(float lo, float hi) { unsigned r; asm volatile("v_cvt_pk_bf16_f32 %0, %1, %2" : "=v"(r) : "v"(lo), "v"(hi)); return r; }
typedef float f32x2 __attribute__((ext_vector_type(2)));
constexpr int NP_ = 16384, NS_ = 256;
constexpr size_t OFF_YP = 0, OFF_YS = OFF_YP + (size_t)NP_ * 1024, OFF_KP = OFF_YS + (size_t)NS_ * 1024, OFF_VP = OFF_KP + (size_t)NP_ * 512, OFF_KS = OFF_VP + (size_t)NP_ * 512,
                 OFF_VS = OFF_KS + (size_t)NS_ * 512, OFF_CV = OFF_VS + (size_t)NS_ * 512, OFF_SRP = OFF_CV + (size_t)NS_ * 512, OFF_SIP = OFF_SRP + 4 * 64 * 64, OFF_SRS = OFF_SIP + 4 * 64 * 64,
                 OFF_SIS = OFF_SRS + 32 * 64 * 64, OUT_TOTAL = OFF_SIS + 32 * 64 * 64;
constexpr float QSCALE = 0.125f * 1.4426950408889634f;
#define PG8_RLXA __ATOMIC_RELAXED, __HIP_MEMORY_SCOPE_AGENT
__device__ __forceinline__ void ss_add(unsigned long long* p, float v) { __hip_atomic_fetch_add(p, (unsigned long long)(v * 1048576.0f + 0.5f), PG8_RLXA); }
__device__ __forceinline__ float ss_rinv(const unsigned long long* p, float inv_n) { const unsigned long long w = __hip_atomic_load(p, PG8_RLXA); return __builtin_amdgcn_rsqf((float)w * (inv_n * (1.0f / 1048576.0f)) + 1e-6f); }
__device__ __forceinline__ float gelu_t(float x) { const float t = x * (1.0f + 0.044715f * x * x); return x * __builtin_amdgcn_rcpf(1.0f + __builtin_amdgcn_exp2f(-2.302208198f * t)); }
__device__ __forceinline__ float sigm(float x) { return __builtin_amdgcn_rcpf(1.0f + __builtin_amdgcn_exp2f(-1.4426950409f * x)); }
__device__ __forceinline__ float quad_sum(float s) { s += __shfl_xor(s, 16); s += __shfl_xor(s, 32); return s; }
__device__ __forceinline__ u32x4 pack8(const f32x4 a, const f32x4 b) { u32x4 w; w.x = cvt_pk_bf16(a[0], a[1]); w.y = cvt_pk_bf16(a[2], a[3]); w.z = cvt_pk_bf16(b[0], b[1]); w.w = cvt_pk_bf16(b[2], b[3]); return w; }

struct EpiInProj {
    static constexpr bool PERM = true, AFTER_DRAIN = false;
    const float* r0; bf16_t* U; bf16_t* VR; bf16_t* QB; bf16_t* KB; bf16_t* VB; unsigned long long* vss; float* out; bool do_ss;
    __device__ __forceinline__ void operator()(const f32x4 (&acc)[2][2][4][2], const Unit& u, int wr, int wc, int fr, int fq) const {
        const int row0 = u.pm * BM + wr * 64 + fr, seg = u.pn >> 1, col0 = (u.pn & 1) * 256 + wc * 32 + 8 * fq;
        bf16_t* dstb = seg == 0 ? U : seg == 1 ? VR : seg == 2 ? QB : seg == 3 ? KB : VB;
        const bool prompt = u.pm < NP_ / BM;
        float* dstf = out + (prompt ? (seg == 3 ? OFF_KP : OFF_VP) : (seg == 3 ? OFF_KS : OFF_VS));
#pragma unroll
        for (int ai = 0; ai < 2; ++ai)
#pragma unroll
            for (int m = 0; m < 4; ++m) {
                const int row = row0 + ai * HALF + m * 16; const float r = r0[row]; float ssq = 0.f;
                const int orow = prompt ? row : row - NP_;
#pragma unroll
                for (int bj = 0; bj < 2; ++bj) {
                    f32x4 v0 = acc[ai][bj][m][0] * r, v1 = acc[ai][bj][m][1] * r; const int col = col0 + bj * HALF;
                    if (seg <= 1) {
#pragma unroll
                        for (int i = 0; i < 4; ++i) { v0[i] = gelu_t(v0[i]); v1[i] = gelu_t(v1[i]); }
                        if (seg == 1) ssq += (v0[0] * v0[0] + v0[1] * v0[1]) + (v0[2] * v0[2] + v0[3] * v0[3]) + (v1[0] * v1[0] + v1[1] * v1[1]) + (v1[2] * v1[2] + v1[3] * v1[3]);
                    } else if (seg == 2) { v0 = v0 * QSCALE; v1 = v1 * QSCALE; }
                    else { float* o = dstf + (size_t)orow * 512 + col; *(f32x4*)o = v0; *(f32x4*)(o + 4) = v1; }
                    *(u32x4*)(dstb + (size_t)row * 512 + col) = pack8(v0, v1);
                }
                if (seg == 1 && do_ss) { ssq = quad_sum(ssq); if (fq == 0) ss_add(vss + row, ssq); }
            }
    }
};
__device__ __forceinline__ void unpack8(const u32x4 w, f32x4& a, f32x4& b) { a[0] = __uint_as_float(w.x << 16); a[1] = __uint_as_float(w.x & 0xffff0000u); a[2] = __uint_as_float(w.y << 16); a[3] = __uint_as_float(w.y & 0xffff0000u);
    b[0] = __uint_as_float(w.z << 16); b[1] = __uint_as_float(w.z & 0xffff0000u); b[2] = __uint_as_float(w.w << 16); b[3] = __uint_as_float(w.w & 0xffff0000u); }
struct EpiResid {
    static constexpr bool PERM = true, AFTER_DRAIN = false;
    bf16_t* XB; float* X; bool wxb; unsigned long long* ss;
    __device__ __forceinline__ void operator()(const f32x4 (&acc)[2][2][4][2], const Unit& u, int wr, int wc, int fr, int fq) const {
        const int row0 = u.pm * BM + wr * 64 + fr, col0 = u.pn * BM + wc * 32 + 8 * fq;
#pragma unroll
        for (int ai = 0; ai < 2; ++ai)
#pragma unroll
            for (int m = 0; m < 4; ++m) {
                const int row = row0 + ai * HALF + m * 16; float ssq = 0.f;
#pragma unroll
                for (int bj = 0; bj < 2; ++bj) {
                    bf16_t* xb = XB + (size_t)row * 1024 + col0 + bj * HALF; f32x4 r0_, r1_; unpack8(*(const u32x4*)xb, r0_, r1_);
                    const f32x4 o0 = acc[ai][bj][m][0] + r0_, o1 = acc[ai][bj][m][1] + r1_;
                    if (X) { float* xo = X + (size_t)row * 1024 + col0 + bj * HALF; *(f32x4*)xo = o0; *(f32x4*)(xo + 4) = o1; }
                    if (wxb) *(u32x4*)xb = pack8(o0, o1);
                    ssq += (o0[0] * o0[0] + o0[1] * o0[1]) + (o0[2] * o0[2] + o0[3] * o0[3]) + (o1[0] * o1[0] + o1[1] * o1[1]) + (o1[2] * o1[2] + o1[3] * o1[3]);
                }
                ssq = quad_sum(ssq); if (fq == 0) ss_add(ss + row, ssq);
            }
    }
};
struct EpiSwiGLU {
    static constexpr bool PERM = true, AFTER_DRAIN = false;
    const unsigned long long* ss; bf16_t* ACT;
    __device__ __forceinline__ void operator()(const f32x4 (&acc)[2][2][4][2], const Unit& u, int wr, int wc, int fr, int fq) const {
        const int row0 = u.pm * BM + wr * 64 + fr, col0 = u.pn * HALF + wc * 32 + 8 * fq;
#pragma unroll
        for (int ai = 0; ai < 2; ++ai)
#pragma unroll
            for (int m = 0; m < 4; ++m) {
                const int row = row0 + ai * HALF + m * 16; const float r = ss_rinv(ss + row, 1.0f / 1024.0f);
                f32x4 a[2];
#pragma unroll
                for (int n = 0; n < 2; ++n) { const f32x4 g = acc[ai][0][m][n] * r, up = acc[ai][1][m][n] * r;
#pragma unroll
                    for (int i = 0; i < 4; ++i) a[n][i] = g[i] * sigm(g[i]) * up[i]; }
                *(u32x4*)(ACT + (size_t)row * 2816 + col0) = pack8(a[0], a[1]);
            }
    }
};
struct EpiGLU {
    static constexpr bool PERM = true, AFTER_DRAIN = false;
    const float* bglu; bf16_t* XB; unsigned long long* ss;
    __device__ __forceinline__ void operator()(const f32x4 (&acc)[2][2][4][2], const Unit& u, int wr, int wc, int fr, int fq) const {
        const int row0 = u.pm * BM + wr * 64 + fr, col0 = u.pn * HALF + wc * 32 + 8 * fq;
        f32x4 bv[2], bg[2];
#pragma unroll
        for (int n = 0; n < 2; ++n) { bv[n] = *(const f32x4*)(bglu + col0 + 4 * n); bg[n] = *(const f32x4*)(bglu + 1024 + col0 + 4 * n); }
#pragma unroll
        for (int ai = 0; ai < 2; ++ai)
#pragma unroll
            for (int m = 0; m < 4; ++m) {
                const int row = row0 + ai * HALF + m * 16; bf16_t* xb = XB + (size_t)row * 1024 + col0; f32x4 x[2], o[2]; float ssq = 0.f; unpack8(*(const u32x4*)xb, x[0], x[1]);
#pragma unroll
                for (int n = 0; n < 2; ++n) { const f32x4 zv = acc[ai][0][m][n] + bv[n], zg = acc[ai][1][m][n] + bg[n];
#pragma unroll
                    for (int i = 0; i < 4; ++i) { o[n][i] = x[n][i] + zv[i] * sigm(zg[i]); ssq += o[n][i] * o[n][i]; } }
                *(u32x4*)xb = pack8(o[0], o[1]);
                ssq = quad_sum(ssq); if (fq == 0) ss_add(ss + row, ssq);
            }
    }
};
struct EpiNull {
    static constexpr bool PERM = true, AFTER_DRAIN = false;
    float* X; int never;
    __device__ __forceinline__ void operator()(const f32x4 (&acc)[2][2][4][2], const Unit& u, int wr, int wc, int fr, int fq) const {
        if (never == 0x7fffffff) {
#pragma unroll
            for (int ai = 0; ai < 2; ++ai)
#pragma unroll
                for (int m = 0; m < 4; ++m)
#pragma unroll
                    for (int bj = 0; bj < 2; ++bj) { float* xo = X + (size_t)(u.pm * BM + wr * 64 + fr + ai * HALF + m * 16) * 1024 + (u.pn & 3) * BM + wc * 32 + 8 * fq + bj * HALF; *(f32x4*)xo = acc[ai][bj][m][0]; *(f32x4*)(xo + 4) = acc[ai][bj][m][1]; }
        }
    }
};
template <class Epi, class Sched, bool ALIGN_EPI = false, bool SP2 = false>
__device__ __forceinline__ void gemm_phase(PG8_LAS unsigned char* lds, const Gemm g, const Sched& S, const Epi& E) {
    int tid_ = threadIdx.x; asm volatile("" : "+v"(tid_));
    const int tid = tid_, wid = __builtin_amdgcn_readfirstlane(tid >> 6), lane = tid & 63, wr = wid >> 2, wc = wid & 3, fr = lane & 15, fq = lane >> 4;
    const int K = g.K, nt = K / BK;
    unsigned voffA[2], voffB[2];
#pragma unroll
    for (int i = 0; i < 2; ++i) { int R, C; stage_rc(tid * 16 + i * 8192, R, C); const int Rb = Epi::PERM ? ((R & ~31) + perm32(R & 31)) : R;
        voffA[i] = (unsigned)(R * K + C) * 2u; voffB[i] = (unsigned)(Rb * K + C) * 2u; }
    const size_t kstep = (size_t)(BK * 2);
    const size_t hstep = (size_t)HALF * K * 2;
    const size_t tstep = 2 * hstep;
    const unsigned ldsw = (unsigned)wid * 1024u;
    const int aoff = lds_byte(wr * 64 + fr, fq * 8), boff = lds_byte(wc * 32 + fr, fq * 8);
#define PG8_SA(b, h) (((b) * 2 + (h)) * HTB)
#define PG8_SB(b, h) ((4 + (b) * 2 + (h)) * HTB)
#define PG8_STAGE(bufoff, gbase, voff) do { _Pragma("unroll") for (int _i = 0; _i < 2; ++_i) \
        __builtin_amdgcn_global_load_lds((const unsigned*)((const char*)(gbase) + (voff)[_i]), (PG8_LAS unsigned*)(lds + (bufoff) + ldsw + _i * 8192), 16, 0, 0); } while (0)
#define PG8_LDA(dst, b, h) do { _Pragma("unroll") for (int m = 0; m < 4; ++m) _Pragma("unroll") for (int k = 0; k < 2; ++k) dst[m][k] = *(const PG8_LAS bf16x8*)(lds + PG8_SA(b, h) + aoff + m * 2048 + k * 1024); } while (0)
#define PG8_LDB(dst, b, h) do { _Pragma("unroll") for (int n = 0; n < 2; ++n) _Pragma("unroll") for (int k = 0; k < 2; ++k) dst[n][k] = *(const PG8_LAS bf16x8*)(lds + PG8_SB(b, h) + boff + n * 2048 + k * 1024); } while (0)
#define PG8_MMA(ai, bj, At, Bt) do { __builtin_amdgcn_s_setprio(1); _Pragma("unroll") for (int m = 0; m < 4; ++m) _Pragma("unroll") for (int n = 0; n < 2; ++n) _Pragma("unroll") for (int k = 0; k < 2; ++k) \
        acc[ai][bj][m][n] = __builtin_amdgcn_mfma_f32_16x16x32_bf16(Bt[n][k], At[m][k], acc[ai][bj][m][n], 0, 0, 0); __builtin_amdgcn_s_setprio(0); } while (0)
#define PG8_WAIT_V(n) asm volatile("s_waitcnt vmcnt(" #n ")" ::: "memory")
#define PG8_WAIT_L(n) asm volatile("s_waitcnt lgkmcnt(" #n ")" ::: "memory")
#define PG8_BAR __builtin_amdgcn_s_barrier()
#define PG8_SCHED __builtin_amdgcn_sched_barrier(0)
    Unit cur, nxt; int ui = 0;
    if (!S.next(0, cur)) return;
    f32x4 acc[2][2][4][2];
#pragma unroll
    for (int a = 0; a < 2; ++a)
#pragma unroll
        for (int b = 0; b < 2; ++b)
#pragma unroll
            for (int m = 0; m < 4; ++m)
#pragma unroll
                for (int n = 0; n < 2; ++n) acc[a][b][m][n] = (f32x4){0.f, 0.f, 0.f, 0.f};
    bf16x8 At[4][2], B0[2][2], B1[2][2];
    const char* cA = (const char*)g.A + (size_t)cur.pm * tstep; const char* cB = (const char*)g.Bt + (size_t)cur.pn * tstep;
    S.a_ready(cur);
    if constexpr (SP2) {
        PG8_STAGE(PG8_SB(0, 0), cB, voffB); PG8_STAGE(PG8_SB(0, 1), cB + hstep, voffB); PG8_STAGE(PG8_SA(0, 0), cA, voffA); PG8_STAGE(PG8_SA(0, 1), cA + hstep, voffA);
        if (wr == 1) PG8_BAR;
        PG8_WAIT_V(2); PG8_BAR;
        PG8_STAGE(PG8_SB(1, 0), cB + kstep, voffB); PG8_STAGE(PG8_SA(1, 0), cA + kstep, voffA); PG8_STAGE(PG8_SB(1, 1), cB + hstep + kstep, voffB);
        PG8_WAIT_V(6); PG8_BAR;
    } else {
        PG8_STAGE(PG8_SB(0, 0), cB, voffB); PG8_STAGE(PG8_SA(0, 0), cA, voffA); PG8_STAGE(PG8_SB(0, 1), cB + hstep, voffB); PG8_STAGE(PG8_SA(0, 1), cA + hstep, voffA);
        if (wr == 1) PG8_BAR;
        PG8_WAIT_V(4); PG8_BAR;
        PG8_STAGE(PG8_SB(1, 0), cB + kstep, voffB); PG8_STAGE(PG8_SA(1, 0), cA + kstep, voffA); PG8_STAGE(PG8_SB(1, 1), cB + hstep + kstep, voffB);
        PG8_WAIT_V(6); PG8_BAR;
    }
    for (;;) {
        const bool has_next = S.next(ui + 1, nxt);
        const char* nA = has_next ? (const char*)g.A + (size_t)nxt.pm * tstep : cA; const char* nB = has_next ? (const char*)g.Bt + (size_t)nxt.pn * tstep : cB;
        for (int t = 0; t < nt; t += 2) {
            const bool last = (t == nt - 2);
            const char* a1 = cA + (size_t)(t + 1) * kstep;
            const char* a2 = last ? nA : cA + (size_t)(t + 2) * kstep; const char* b2 = last ? nB : cB + (size_t)(t + 2) * kstep;
            const char* a3 = a2 + kstep; const char* b3 = b2 + kstep;
            if (last && has_next) S.a_ready(nxt);
            if constexpr (SP2) {
            PG8_LDB(B0, 0, 0); PG8_LDB(B1, 0, 1); PG8_SCHED; PG8_LDA(At, 0, 0); PG8_STAGE(PG8_SA(1, 1), a1 + hstep, voffA);
            PG8_WAIT_V(8); PG8_WAIT_L(0); PG8_BAR; PG8_MMA(0, 0, At, B0); PG8_MMA(0, 1, At, B1); PG8_BAR; PG8_SCHED;
            PG8_LDA(At, 0, 1); PG8_STAGE(PG8_SB(0, 0), b2, voffB); PG8_STAGE(PG8_SB(0, 1), b2 + hstep, voffB); PG8_STAGE(PG8_SA(0, 0), a2, voffA);
            PG8_WAIT_V(8); PG8_WAIT_L(0); PG8_BAR; PG8_MMA(1, 0, At, B0); PG8_MMA(1, 1, At, B1); PG8_BAR; PG8_SCHED;
            PG8_LDB(B0, 1, 0); PG8_LDB(B1, 1, 1); PG8_SCHED; PG8_LDA(At, 1, 0); PG8_STAGE(PG8_SA(0, 1), a2 + hstep, voffA);
            PG8_WAIT_V(8); PG8_WAIT_L(0); PG8_BAR; PG8_MMA(0, 0, At, B0); PG8_MMA(0, 1, At, B1); PG8_BAR; PG8_SCHED;
            PG8_LDA(At, 1, 1); PG8_STAGE(PG8_SB(1, 0), b3, voffB); PG8_STAGE(PG8_SB(1, 1), b3 + hstep, voffB); PG8_STAGE(PG8_SA(1, 0), a3, voffA);
            PG8_WAIT_V(8); PG8_WAIT_L(0); PG8_BAR; PG8_MMA(1, 0, At, B0); PG8_MMA(1, 1, At, B1); PG8_BAR; PG8_SCHED;
            } else {
            PG8_LDB(B0, 0, 0); PG8_SCHED; PG8_LDA(At, 0, 0); PG8_STAGE(PG8_SA(1, 1), a1 + hstep, voffA);
            PG8_WAIT_L(8); PG8_BAR; PG8_WAIT_L(0); PG8_MMA(0, 0, At, B0); PG8_BAR; PG8_SCHED;
            PG8_LDB(B1, 0, 1); PG8_STAGE(PG8_SB(0, 0), b2, voffB);
            PG8_BAR; PG8_WAIT_L(0); PG8_MMA(0, 1, At, B1); PG8_BAR;
            PG8_LDA(At, 0, 1); PG8_STAGE(PG8_SA(0, 0), a2, voffA);
            PG8_BAR; PG8_WAIT_L(0); PG8_MMA(1, 0, At, B0); PG8_BAR; PG8_SCHED;
            PG8_STAGE(PG8_SB(0, 1), b2 + hstep, voffB);
            PG8_WAIT_V(6); PG8_BAR; PG8_MMA(1, 1, At, B1); PG8_BAR;
            PG8_LDB(B0, 1, 0); PG8_SCHED; PG8_LDA(At, 1, 0); PG8_STAGE(PG8_SA(0, 1), a2 + hstep, voffA);
            PG8_WAIT_L(8); PG8_BAR; PG8_WAIT_L(0); PG8_MMA(0, 0, At, B0); PG8_BAR; PG8_SCHED;
            PG8_LDB(B1, 1, 1); PG8_STAGE(PG8_SB(1, 0), b3, voffB);
            PG8_BAR; PG8_WAIT_L(0); PG8_MMA(0, 1, At, B1); PG8_BAR;
            PG8_LDA(At, 1, 1); PG8_STAGE(PG8_SA(1, 0), a3, voffA);
            PG8_BAR; PG8_WAIT_L(0); PG8_MMA(1, 0, At, B0); PG8_BAR; PG8_SCHED;
            PG8_STAGE(PG8_SB(1, 1), b3 + hstep, voffB);
            PG8_WAIT_V(6); PG8_BAR; PG8_MMA(1, 1, At, B1); PG8_BAR;
            }
        }
        if constexpr (ALIGN_EPI) { if (wr == 0) PG8_BAR; }
        if constexpr (!Epi::AFTER_DRAIN) { E(acc, cur, wr, wc, fr, fq); S.done(cur); }
        if (!has_next) break;
#pragma unroll
        for (int a = 0; a < 2; ++a)
#pragma unroll
            for (int b = 0; b < 2; ++b)
#pragma unroll
                for (int m = 0; m < 4; ++m)
#pragma unroll
                    for (int n = 0; n < 2; ++n) acc[a][b][m][n] = (f32x4){0.f, 0.f, 0.f, 0.f};
        cur = nxt; cA = nA; cB = nB; ++ui;
        if constexpr (ALIGN_EPI) { if (wr == 1) PG8_BAR; }
    }
    PG8_WAIT_V(0);
    if constexpr (!ALIGN_EPI) { if (wr == 0) PG8_BAR; }
    PG8_BAR;
    if constexpr (Epi::AFTER_DRAIN) { E.fused(acc, cur, wr, wc, fr, fq, lds, wid, lane); S.done(cur); }
#undef PG8_SA
#undef PG8_SB
#undef PG8_STAGE
#undef PG8_LDA
#undef PG8_LDB
#undef PG8_MMA
#undef PG8_WAIT_V
#undef PG8_WAIT_L
#undef PG8_BAR
#undef PG8_SCHED
}
}
#define GAS __attribute__((address_space(1)))
#define LAS __attribute__((address_space(3)))
typedef unsigned short bf16;
typedef unsigned v4u __attribute__((ext_vector_type(4)));
typedef float f32x4 __attribute__((ext_vector_type(4)));
typedef short bf16x8 __attribute__((ext_vector_type(8)));
typedef GAS unsigned gu32;
typedef GAS unsigned long long gu64;
#define RLX_AGENT __ATOMIC_RELAXED, __HIP_MEMORY_SCOPE_AGENT
#define LDS_WAIT() asm volatile("s_waitcnt lgkmcnt(0)" ::: "memory")
#define VM_WAIT() asm volatile("s_waitcnt vmcnt(0)" ::: "memory")
__device__ __forceinline__ unsigned long long rt() { return __builtin_amdgcn_s_memrealtime(); }
__device__ __forceinline__ unsigned f2bf(float f) { unsigned u = __builtin_bit_cast(unsigned, f); return (u + 0x7fffu + ((u >> 16) & 1u)) >> 16; }
__device__ __forceinline__ unsigned pk2(float lo, float hi) { return f2bf(lo) | (f2bf(hi) << 16); }

#define XB_TMO      128
#define XB_XCNT(j)  (256  + 64 * (j))
#define XB_XSUB(j)  (1280 + 64 * (j))
#define XB_XGEN(j)  (2304 + 64 * (j))
#define XB_TOP      3328
#define XB_TOPGEN   3392
#define XCD_BAR_WORDS 3456
#define XB_SPIN_CAP (1u << 18)

__device__ __forceinline__ unsigned xb_ld(unsigned* p)              { return __hip_atomic_load(p, __ATOMIC_RELAXED, __HIP_MEMORY_SCOPE_AGENT); }
__device__ __forceinline__ unsigned xb_add(unsigned* p, unsigned v) { return __hip_atomic_fetch_add(p, v, __ATOMIC_RELAXED, __HIP_MEMORY_SCOPE_AGENT); }
__device__ __forceinline__ unsigned xb_xcc_id() { return (unsigned)__builtin_amdgcn_s_getreg((3 << 11) | 20) & 0xFu; }
#define XB_SPIN(cond, bar) do { unsigned _sp = 0; while (cond) { __builtin_amdgcn_s_sleep(1); \
    if ((++_sp & 255u) == 0u) { if (xb_ld(&(bar)[XB_TMO])) break; if (_sp > XB_SPIN_CAP) { atomicAdd(&(bar)[XB_TMO], 1u); break; } } } } while (0)

struct XcdBarrier {
    unsigned* bar; unsigned x;
    volatile LAS unsigned* st;
};

__device__ __forceinline__ XcdBarrier xcd_barrier_post(unsigned* bar, volatile LAS unsigned* st) {
    XcdBarrier b; b.bar = bar; b.x = xb_xcc_id(); b.st = st;
    if (threadIdx.x == 0) (void)xb_add(&bar[XB_XCNT(b.x)], 1u);
    return b;
}
__device__ __forceinline__ void xcd_barrier_complete(unsigned* bar, unsigned x, unsigned& nloc, unsigned& nx) {
    const unsigned G = gridDim.x * gridDim.y * gridDim.z;
    unsigned sum, cnt, mine, sp = 0u;
    for (;;) {
        sum = 0u; cnt = 0u; mine = 0u;
#pragma unroll
        for (unsigned j = 0; j < 16; ++j) { const unsigned c = xb_ld(&bar[XB_XCNT(j)]); sum += c; cnt += (c > 0u) ? 1u : 0u; mine = (j == x) ? c : mine; }
        if (sum == G) break;
        __builtin_amdgcn_s_sleep(1);
        if ((++sp & 255u) == 0u) { if (xb_ld(&bar[XB_TMO])) break; if (sp > XB_SPIN_CAP) { atomicAdd(&bar[XB_TMO], 1u); break; } }
    }
    nloc = mine > 0u ? mine : 1u; nx = cnt > 0u ? cnt : 1u;
}

__device__ __forceinline__ void xcd_barrier(const XcdBarrier& b) {
    asm volatile("s_waitcnt vmcnt(0)" ::: "memory");
    __syncthreads();
    if (threadIdx.x == 0) {
        unsigned* bar = b.bar;
        __builtin_amdgcn_s_waitcnt(0);
        unsigned nloc = b.st[0], nx = b.st[1];
        if (nloc == 0u) { xcd_barrier_complete(bar, b.x, nloc, nx); b.st[0] = nloc; b.st[1] = nx; }
        const unsigned old = xb_add(&bar[XB_XSUB(b.x)], 1u);
        const unsigned gen = old / nloc;
        if (old + 1u == (gen + 1u) * nloc) {
            __builtin_amdgcn_fence(__ATOMIC_RELEASE, "agent");
            asm volatile("s_waitcnt vmcnt(0)" ::: "memory");
            const unsigned og = xb_add(&bar[XB_TOP], 1u);
            const unsigned tg = og / nx;
            if (og + 1u == (tg + 1u) * nx) xb_add(&bar[XB_TOPGEN], 1u);
            else XB_SPIN(xb_ld(&bar[XB_TOPGEN]) == tg, bar);
            __builtin_amdgcn_fence(__ATOMIC_ACQUIRE, "agent");
            xb_add(&bar[XB_XGEN(b.x)], 1u);
            asm volatile("s_waitcnt vmcnt(0)" ::: "memory");
        } else {
            XB_SPIN(xb_ld(&bar[XB_XGEN(b.x)]) == gen, bar);
            __builtin_amdgcn_fence(__ATOMIC_ACQUIRE, "agent");
            asm volatile("s_waitcnt vmcnt(0)" ::: "memory");
        }
    }
    __syncthreads();
}
constexpr int NWAVES = 8;
constexpr int NP = 16384, NS = 256, NTOK = NP + NS, DM = 1024, DFF = 2816, SEQ = 4096;
constexpr float EPS = 1e-6f, LAM_INIT = 0.2f;
using pg8::OFF_YP; using pg8::OFF_CV; using pg8::OFF_SRP; using pg8::OFF_SIP; using pg8::OFF_SRS; using pg8::OFF_SIS; using pg8::OUT_TOTAL;
constexpr size_t MiB = 1u << 20;
constexpr size_t WS_CTL = 0, CTL_ZERO_BYTES = 2 * MiB;
constexpr int CW_BAR = 4096;
constexpr size_t WS_SS = 64 * 1024;
constexpr size_t WS_R0 = 2 * MiB;
constexpr size_t WS_PW1 = 2 * MiB + 128 * 1024, WS_PW16 = WS_PW1 + 32 * 1024;
constexpr size_t WS_BBAR = 2 * MiB + 256 * 1024;
constexpr size_t WS_WTRIL = 3 * MiB;
constexpr size_t WS_T = 4 * MiB, WS_E = 12 * MiB, WS_F = 16 * MiB;
constexpr size_t WS_W1 = 24 * MiB, WS_W2 = 29 * MiB, WS_W3 = 31 * MiB, WS_W4 = 42 * MiB, WS_W5 = 48 * MiB, WS_W6 = 52 * MiB, WS_W7 = 63 * MiB;
constexpr size_t WS_XB = 70 * MiB, WS_X = 104 * MiB, WS_U = 170 * MiB, WS_VR = 187 * MiB, WS_QB = 204 * MiB, WS_KB = 221 * MiB, WS_VB = 238 * MiB;
constexpr size_t WS_CB = 256 * MiB, WS_ACT = 290 * MiB, WS_PART = 380 * MiB, WS_END = 400 * MiB;
constexpr int PART_STRIDE = 32 + 16 * 128;
static_assert(WS_W7 + (size_t)1024 * 2816 * 2 <= WS_XB && WS_XB + (size_t)NTOK * 1024 * 2 <= WS_X && WS_X + (size_t)NTOK * 1024 * 4 <= WS_U && WS_VB + (size_t)NTOK * 512 * 2 <= WS_CB &&
              WS_CB + (size_t)NTOK * 1024 * 2 <= WS_ACT && WS_ACT + (size_t)NTOK * 2816 * 2 <= WS_PART && WS_PART + (size_t)32 * 4 * 16 * PART_STRIDE * 4 <= WS_END && WS_SS + 5 * (size_t)NTOK * 8 <= CTL_ZERO_BYTES, "d_ws map");
constexpr int RING_OFF = 0, SCRATCH_BYTES = 147456;
constexpr int LDSCTL_OFF = SCRATCH_BYTES, MISC_OFF = LDSCTL_OFF + 320;
constexpr int LDS_BYTES = SCRATCH_BYTES + 1024;

typedef short s16x4 __attribute__((ext_vector_type(4)));
typedef float f32x16 __attribute__((ext_vector_type(16)));
typedef float f32x2_t __attribute__((ext_vector_type(2))); typedef __bf16 bf16x2_t __attribute__((ext_vector_type(2)));
__device__ __forceinline__ unsigned cvtpk(float lo, float hi) { f32x2_t v = {lo, hi}; bf16x2_t b = __builtin_convertvector(v, bf16x2_t); return __builtin_bit_cast(unsigned, b); }
__device__ __forceinline__ float bf2f(unsigned short h) { return __uint_as_float((unsigned)h << 16); }
__device__ __forceinline__ float bflo(unsigned w) { return __uint_as_float(w << 16); }
__device__ __forceinline__ float bfhi(unsigned w) { return __uint_as_float(w & 0xffff0000u); }
__device__ __forceinline__ float ex2(float x) { return __builtin_amdgcn_exp2f(x); }
__device__ __forceinline__ float wave_sum(float v) {
#pragma unroll
    for (int o = 1; o < 64; o <<= 1) v += __shfl_xor(v, o);
    return v;
}
__device__ __forceinline__ f32x4 mfma16(bf16x8 a, bf16x8 b, f32x4 c) { return __builtin_amdgcn_mfma_f32_16x16x32_bf16(a, b, c, 0, 0, 0); }
__device__ __forceinline__ f32x16 mfma32(bf16x8 a, bf16x8 b, f32x16 c) { return __builtin_amdgcn_mfma_f32_32x32x16_bf16(a, b, c, 0, 0, 0); }
typedef short v4i16_t __attribute__((ext_vector_type(4)));
__device__ __forceinline__ bf16x8 tr_pair(const LAS unsigned char* p0, const LAS unsigned char* p1) {
    const s16x4 lo = __builtin_bit_cast(s16x4, __builtin_amdgcn_ds_read_tr16_b64_v4i16((LAS v4i16_t*)p0));
    const s16x4 hi = __builtin_bit_cast(s16x4, __builtin_amdgcn_ds_read_tr16_b64_v4i16((LAS v4i16_t*)p1));
    return (bf16x8){lo[0], lo[1], lo[2], lo[3], hi[0], hi[1], hi[2], hi[3]};
}
__device__ __forceinline__ bf16x8 pack_bf8(const f32x4 a, const f32x4 b) { v4u w; w.x = cvtpk(a[0], a[1]); w.y = cvtpk(a[2], a[3]); w.z = cvtpk(b[0], b[1]); w.w = cvtpk(b[2], b[3]); return __builtin_bit_cast(bf16x8, w); }
__device__ __forceinline__ float xmax4(float v) {
    auto a = __builtin_amdgcn_permlane16_swap(__float_as_uint(v), __float_as_uint(v), false, false); v = fmaxf(__uint_as_float(a[0]), __uint_as_float(a[1]));
    auto b = __builtin_amdgcn_permlane32_swap(__float_as_uint(v), __float_as_uint(v), false, false); return fmaxf(__uint_as_float(b[0]), __uint_as_float(b[1])); }
__device__ __forceinline__ float xsum4(float v) {
    auto a = __builtin_amdgcn_permlane16_swap(__float_as_uint(v), __float_as_uint(v), false, false); v = __uint_as_float(a[0]) + __uint_as_float(a[1]);
    auto b = __builtin_amdgcn_permlane32_swap(__float_as_uint(v), __float_as_uint(v), false, false); return __uint_as_float(b[0]) + __uint_as_float(b[1]); }
using pg8::ss_rinv; using pg8::gelu_t;

struct Frame {
    LAS unsigned char* lds;
    volatile LAS unsigned* MISC;
    gu32* ctl;
    int tid, lane, wave, vcu, G;
    const float* const* in; float* out; unsigned char* ws;
};
enum { I_XP = 0, I_XS, I_CK, I_CV, I_PT, I_SRE, I_SIM, I_NMIX, I_NFFN, I_NFIN, I_WIN, I_WOUT, I_SGN, I_SGW, I_SGB, I_LQ1, I_LK1, I_LQ2, I_LK2, I_SUBLN,
       I_ARE, I_AIM, I_LDT, I_BRE, I_BIM, I_CRE, I_CIM, I_SD, I_WGLU, I_BGLU, I_WFI, I_WFO };

__device__ __forceinline__ int map_row(int n0, int NH) { if (NH == 0) return n0; const int hi = n0 >= NH ? 1 : 0, n2 = n0 - hi * NH; return 256 * (n2 >> 7) + 128 * hi + (n2 & 127); }
__device__ __forceinline__ void p0_transpose_item(const float* W, int K, int N, bf16* WT, int NH, const float* gain, LAS float* scr, int item, int lane) {
    const int nblk = N / 64, kb = item / nblk, nb = item % nblk, k0 = 64 * kb, n0 = 64 * nb, kq = lane >> 4, nq = 4 * (lane & 15);
    f32x4 v[16];
#pragma unroll
    for (int i = 0; i < 16; ++i) v[i] = *(const f32x4*)(W + (size_t)(k0 + 4 * i + kq) * N + n0 + nq);
#pragma unroll
    for (int i = 0; i < 16; ++i) { const int kk = 4 * i + kq; const float gs = gain ? gain[k0 + kk] : 1.0f; LAS float* d = scr + kk * 65 + nq; d[0] = v[i][0] * gs; d[1] = v[i][1] * gs; d[2] = v[i][2] * gs; d[3] = v[i][3] * gs; }
    LDS_WAIT(); asm volatile("" ::: "memory");
    const int c = lane & 7, r0 = map_row(n0, NH);
#pragma unroll
    for (int j = 0; j < 8; ++j) { const int n = (lane >> 3) + 8 * j; const LAS float* s = scr + (8 * c) * 65 + n;
        v4u o; o.x = pk2(s[0 * 65], s[1 * 65]); o.y = pk2(s[2 * 65], s[3 * 65]); o.z = pk2(s[4 * 65], s[5 * 65]); o.w = pk2(s[6 * 65], s[7 * 65]);
        *(GAS v4u*)(WT + (size_t)(r0 + n) * K + k0 + 8 * c) = o; }
    LDS_WAIT(); asm volatile("" ::: "memory");
}
__device__ __forceinline__ void p0_row2(Frame& F, const float* xrow0, const float* xrow1, bf16* orow0, float* r) {
    const GAS f32x4* xa = (const GAS f32x4*)xrow0 + F.lane; const GAS f32x4* xb = (const GAS f32x4*)xrow1 + F.lane;
    f32x4 v[4], w[4]; float s = 0.f, t = 0.f;
#pragma unroll
    for (int j = 0; j < 4; ++j) { v[j] = xa[64 * j]; w[j] = xb[64 * j]; }
#pragma unroll
    for (int j = 0; j < 4; ++j) { s += (v[j].x * v[j].x + v[j].y * v[j].y) + (v[j].z * v[j].z + v[j].w * v[j].w); t += (w[j].x * w[j].x + w[j].y * w[j].y) + (w[j].z * w[j].z + w[j].w * w[j].w); }
    GAS unsigned long long* o8 = (GAS unsigned long long*)orow0 + F.lane;
#pragma unroll
    for (int j = 0; j < 4; ++j) { o8[64 * j] = (unsigned long long)pk2(v[j].x, v[j].y) | ((unsigned long long)pk2(v[j].z, v[j].w) << 32); o8[256 + 64 * j] = (unsigned long long)pk2(w[j].x, w[j].y) | ((unsigned long long)pk2(w[j].z, w[j].w) << 32); }
    s = wave_sum(s); t = wave_sum(t);
    if (F.lane == 0) { r[0] = 1.0f / sqrtf(s * (1.0f / 1024.0f) + EPS); r[1] = 1.0f / sqrtf(t * (1.0f / 1024.0f) + EPS); }
}
__device__ __forceinline__ void p0_ssm_tables(Frame& F, int g, int q) {
    LAS f32x2_t* pw = (LAS f32x2_t*)(F.lds);
    LAS f32x2_t* cb = pw + 17 * 64;
    LAS f32x2_t* cc = cb + 64 * 16;
    LAS float* KJ = (LAS float*)(cc + 16 * 64);
    LAS f32x2_t* cf = (LAS f32x2_t*)(KJ + 4096);
    const int tid = F.tid;
    const float* a_re = F.in[I_ARE] + g * 64; const float* a_im = F.in[I_AIM] + g * 64;
    const float dt = expf(F.in[I_LDT][g]);
    {   const int p = tid & 63, jj = tid >> 6; const float ar = a_re[p], ai = a_im[p], xr = ar * dt, xi = ai * dt;
        for (int j = jj; j <= 16; j += 8) { const float mag = expf((float)j * xr), ang = (float)j * xi; pw[j * 64 + p] = (f32x2_t){mag * cosf(ang), mag * sinf(ang)}; }
        if (jj == 1) {
            const float sh = sinf(0.5f * xi), nr = expm1f(xr) * cosf(xi) - 2.0f * sh * sh, ni = expf(xr) * sinf(xi), den = 1.0f / (ar * ar + ai * ai);
            cf[p] = (f32x2_t){(nr * ar + ni * ai) * den, (ni * ar - nr * ai) * den}; }
    }
    __syncthreads();
    const float* b_re = F.in[I_BRE] + (size_t)g * 1024; const float* b_im = F.in[I_BIM] + (size_t)g * 1024;
    const float* c_re = F.in[I_CRE] + (size_t)g * 1024; const float* c_im = F.in[I_CIM] + (size_t)g * 1024;
    for (int i = tid; i < 1024; i += 512) {
        const int p = i >> 4; const f32x2_t c = cf[p]; const float br = b_re[i], bi = b_im[i];
        cb[i] = (f32x2_t){c.x * br - c.y * bi, c.x * bi + c.y * br};
        cc[i] = (f32x2_t){c_re[i], c_im[i]};
    }
    __syncthreads();
    const float* dsk = F.in[I_SD] + g * 16;
    {
        const int j = tid >> 5, c2 = (tid >> 1) & 15, ph = tid & 1; float sacc[16];
#pragma unroll
        for (int c = 0; c < 16; ++c) sacc[c] = 0.f;
#pragma unroll 2
        for (int pp = 0; pp < 32; ++pp) { const int p = 32 * ph + pp; const f32x2_t a = pw[j * 64 + p], b = cb[p * 16 + c2]; const float wr_ = a.x * b.x - a.y * b.y, wi_ = a.x * b.y + a.y * b.x;
#pragma unroll
            for (int c = 0; c < 16; ++c) { const f32x2_t cv = cc[c * 64 + p]; sacc[c] += cv.x * wr_ - cv.y * wi_; } }
#pragma unroll
        for (int c = 0; c < 16; ++c) sacc[c] += __shfl_xor(sacc[c], 1);
        if (ph == 0) {
#pragma unroll
            for (int c = 0; c < 16; ++c) KJ[(j * 16 + c) * 16 + c2] = sacc[c] + ((j == 0 && c == c2) ? dsk[c] : 0.f); }
    }
    __syncthreads();
    const float* g1 = F.in[I_NMIX] + 1024 + g * 16;
    bf16* Tg = (bf16*)(F.ws + WS_T) + (size_t)g * 65536; bf16* Eg = (bf16*)(F.ws + WS_E) + (size_t)g * 32768; bf16* Fg = (bf16*)(F.ws + WS_F) + (size_t)g * 32768;
#pragma unroll 1
    for (int i = 0; i < 4; ++i) { const int idx = tid + 512 * i, row = 64 * q + (idx >> 5), kc = idx & 31, t = row >> 4, c = row & 15, tau = kc >> 1, c0 = 8 * (kc & 1);
        float v[8];
#pragma unroll
        for (int e = 0; e < 8; ++e) v[e] = (t >= tau) ? KJ[((t - tau) * 16 + c) * 16 + c0 + e] * g1[c0 + e] : 0.f;
        v4u o; o.x = pk2(v[0], v[1]); o.y = pk2(v[2], v[3]); o.z = pk2(v[4], v[5]); o.w = pk2(v[6], v[7]);
        *(GAS v4u*)(Tg + (size_t)row * 256 + kc * 8) = o; }
#pragma unroll 1
    for (int i = 0; i < 2; ++i) { const int idx = tid + 512 * i, row = 32 * q + (idx >> 5), kc = idx & 31, ri = row >> 6, p = row & 63, tau = kc >> 1, c0 = 8 * (kc & 1);
        const f32x2_t a = pw[(15 - tau) * 64 + p]; float v[8];
#pragma unroll
        for (int e = 0; e < 8; ++e) { const f32x2_t b = cb[p * 16 + c0 + e]; const float zr = a.x * b.x - a.y * b.y, zi = a.x * b.y + a.y * b.x; v[e] = (ri ? zi : zr) * g1[c0 + e]; }
        v4u o; o.x = pk2(v[0], v[1]); o.y = pk2(v[2], v[3]); o.z = pk2(v[4], v[5]); o.w = pk2(v[6], v[7]);
        *(GAS v4u*)(Eg + (size_t)row * 256 + kc * 8) = o; }
#pragma unroll 1
    for (int i = 0; i < 2; ++i) { const int idx = tid + 512 * i, row = 64 * q + (idx >> 4), kc = idx & 15, t = row >> 4, c = row & 15, ri = kc >> 3, p0 = 8 * (kc & 7);
        float v[8];
#pragma unroll
        for (int e = 0; e < 8; ++e) { const f32x2_t a = pw[(t + 1) * 64 + p0 + e], cv = cc[c * 64 + p0 + e]; const float zr = cv.x * a.x - cv.y * a.y, zi = cv.x * a.y + cv.y * a.x; v[e] = ri ? -zi : zr; }
        v4u o; o.x = pk2(v[0], v[1]); o.y = pk2(v[2], v[3]); o.z = pk2(v[4], v[5]); o.w = pk2(v[6], v[7]);
        *(GAS v4u*)(Fg + (size_t)row * 128 + kc * 8) = o; }
    if (q == 0) {
        f32x2_t* PW1 = (f32x2_t*)(F.ws + WS_PW1) + g * 64; f32x2_t* PW16 = (f32x2_t*)(F.ws + WS_PW16) + g * 64; f32x2_t* BB = (f32x2_t*)(F.ws + WS_BBAR) + (size_t)g * 1024;
        if (tid < 64) { PW1[tid] = pw[64 + tid]; PW16[tid] = pw[16 * 64 + tid]; }
        for (int i = tid; i < 1024; i += 512) BB[i] = cb[i];
    }
    __syncthreads();
}
__device__ __forceinline__ void p0_prologue(Frame& F) {
    const int gw = F.vcu * NWAVES + F.wave, NGW = F.G * NWAVES;
    for (int u = F.vcu; u < 256; u += F.G) p0_ssm_tables(F, u >> 2, u & 3);
    LAS float* scr = (LAS float*)(F.lds + RING_OFF + F.wave * 18432);
    constexpr int I1 = 16 * (2560 / 64), I2 = 16 * (1024 / 64), I5 = 16 * (2048 / 64), I3 = 16 * (5632 / 64), I4 = 44 * (1024 / 64);
    constexpr int NITEMS = I1 + I2 + I5 + 2 * I3 + 2 * I4;
    for (int it = gw; it < NITEMS; it += NGW) {
        int r = it;
        if (r < I1) { p0_transpose_item(F.in[I_WIN], 1024, 2560, (bf16*)(F.ws + WS_W1), 0, F.in[I_NMIX], scr, r, F.lane); continue; } r -= I1;
        if (r < I2) { p0_transpose_item(F.in[I_WOUT], 1024, 1024, (bf16*)(F.ws + WS_W2), 0, nullptr, scr, r, F.lane); continue; } r -= I2;
        if (r < I5) { p0_transpose_item(F.in[I_WGLU], 1024, 2048, (bf16*)(F.ws + WS_W5), 1024, nullptr, scr, r, F.lane); continue; } r -= I5;
        if (r < I3) { p0_transpose_item(F.in[I_WFI], 1024, 5632, (bf16*)(F.ws + WS_W3), 2816, F.in[I_NFFN], scr, r, F.lane); continue; } r -= I3;
        if (r < I3) { p0_transpose_item(F.in[I_WFI] + (size_t)1024 * 5632, 1024, 5632, (bf16*)(F.ws + WS_W6), 2816, F.in[I_NFFN] + 1024, scr, r, F.lane); continue; } r -= I3;
        if (r < I4) { p0_transpose_item(F.in[I_WFO], 2816, 1024, (bf16*)(F.ws + WS_W4), 0, nullptr, scr, r, F.lane); continue; } r -= I4;
        p0_transpose_item(F.in[I_WFO] + (size_t)2816 * 1024, 2816, 1024, (bf16*)(F.ws + WS_W7), 0, nullptr, scr, r, F.lane);
    }
    bf16* XB = (bf16*)(F.ws + WS_XB); float* R0 = (float*)(F.ws + WS_R0);
    for (int m = 2 * gw; m < NTOK; m += 2 * NGW) { const float* x0 = m < NP ? F.in[I_XP] + (size_t)m * 1024 : F.in[I_XS] + (size_t)(m - NP) * 1024; p0_row2(F, x0, x0 + 1024, XB + (size_t)m * 1024, R0 + m); }
    bf16* WT = (bf16*)(F.ws + WS_WTRIL); const float* sw = F.in[I_SGW];
    for (int i = gw * 64 + F.lane; i < 8192; i += NGW * 64) { const int e0 = i * 8, t = (e0 >> 7) & 127, s0 = e0 & 127; float v[8];
#pragma unroll
        for (int e = 0; e < 8; ++e) v[e] = (s0 + e <= t) ? sw[e0 + e] : 0.f;
        v4u o; o.x = pk2(v[0], v[1]); o.y = pk2(v[2], v[3]); o.z = pk2(v[4], v[5]); o.w = pk2(v[6], v[7]); *(GAS v4u*)(WT + e0) = o; }
}
__device__ __forceinline__ float lambda_val(Frame& F) {
    const int l = F.lane; const float a = wave_sum(F.in[I_LQ1][l] * F.in[I_LK1][l]), b = wave_sum(F.in[I_LQ2][l] * F.in[I_LK2][l]);
    return expf(a) - expf(b) + LAM_INIT;
}
#define LAUNDER_TID() int tid = F.tid; asm volatile("" : "+v"(tid)); const int lane = tid & 63, wave = __builtin_amdgcn_readfirstlane(tid >> 6); (void)lane; (void)wave
__device__ __forceinline__ void sgu_prompt_unit(Frame& F, int chunk, int g) {
    LAUNDER_TID();
    const bf16* U = (const bf16*)(F.ws + WS_U); const bf16* VR = (const bf16*)(F.ws + WS_VR); bf16* CB = (bf16*)(F.ws + WS_CB);
    const unsigned long long* vss = (const unsigned long long*)(F.ws + WS_SS);
    const bf16* WT = (const bf16*)(F.ws + WS_WTRIL) + (size_t)g * 16384;
    const float* gn = F.in[I_SGN] + g * 128; const float* bias = F.in[I_SGB] + g * 128;
    LAS unsigned short* vT = (LAS unsigned short*)F.lds;
    const size_t tok0 = (size_t)chunk * 128;
    {
        const int s = tid >> 2, c0 = 32 * (tid & 3); const float rv = ss_rinv(vss + tok0 + s, 1.0f / 512.0f);
        const v4u* src = (const v4u*)(VR + (tok0 + s) * 512 + g * 128 + c0);
#pragma unroll
        for (int i = 0; i < 4; ++i) { const v4u w = src[i]; const unsigned ww[4] = {w.x, w.y, w.z, w.w};
#pragma unroll
            for (int e = 0; e < 4; ++e) { const int c = c0 + 8 * i + 2 * e; const float a = bflo(ww[e]) * rv * gn[c], b = bfhi(ww[e]) * rv * gn[c + 1];
                vT[c * 136 + s] = (unsigned short)f2bf(a); vT[(c + 1) * 136 + s] = (unsigned short)f2bf(b); } }
    }
    __syncthreads();
    const int mb = wave & 3, nh = wave >> 2, r32 = lane & 31, hi = lane >> 5;
    f32x16 acc[2]; acc[0] = (f32x16){}; acc[1] = (f32x16){};
    for (int ks = 0; ks < 2 * mb + 2; ++ks) {
        const bf16x8 a = *(const bf16x8*)(WT + (32 * mb + r32) * 128 + 16 * ks + 8 * hi);
#pragma unroll
        for (int j = 0; j < 2; ++j) { const bf16x8 b = *(const LAS bf16x8*)((const LAS unsigned char*)vT + ((64 * nh + 32 * j + r32) * 136 + 16 * ks + 8 * hi) * 2); acc[j] = mfma32(a, b, acc[j]); }
    }
#pragma unroll
    for (int j = 0; j < 2; ++j) { const int d = g * 128 + 64 * nh + 32 * j + r32;
#pragma unroll
        for (int r = 0; r < 16; ++r) { const int t = 32 * mb + (r & 3) + 8 * (r >> 2) + 4 * hi; const size_t o = (tok0 + t) * 512 + d;
            const float val = bf2f(U[o]) * (acc[j][r] + bias[t]); CB[(tok0 + t) * 1024 + d] = (bf16)f2bf(val); } }
    __syncthreads();
}
__device__ __forceinline__ void sgu_sample_unit(Frame& F, int b) {
    LAUNDER_TID(); const int c = tid, g = c >> 7; const bf16* U = (const bf16*)(F.ws + WS_U); const bf16* VR = (const bf16*)(F.ws + WS_VR); bf16* CB = (bf16*)(F.ws + WS_CB);
    const unsigned long long* vss = (const unsigned long long*)(F.ws + WS_SS);
    const float gn = F.in[I_SGN][c]; const float* W = F.in[I_SGW] + (size_t)g * 16384; const float* bias = F.in[I_SGB] + g * 128;
    float v[8];
#pragma unroll
    for (int t = 0; t < 8; ++t) { const size_t tok = NP + 8 * b + t; v[t] = bf2f(VR[tok * 512 + c]) * ss_rinv(vss + tok, 1.0f / 512.0f) * gn; F.out[OFF_CV + (size_t)(8 * b + t) * 512 + c] = v[t]; }
#pragma unroll
    for (int t = 0; t < 8; ++t) { float s = bias[t];
#pragma unroll
        for (int k = 0; k <= t; ++k) s += W[t * 128 + k] * v[k];
        const size_t tok = NP + 8 * b + t; CB[tok * 1024 + c] = (bf16)f2bf(bf2f(U[tok * 512 + c]) * s); }
}

struct Soft16 { float m, l; };
__device__ __forceinline__ void smax_update(f32x4 (&s)[4], Soft16& st, f32x4 (&O)[8], bf16x8& pf0, bf16x8& pf1) {
    float mx = fmaxf(fmaxf(s[0][0], s[0][1]), fmaxf(s[0][2], s[0][3]));
#pragma unroll
    for (int i = 1; i < 4; ++i) mx = fmaxf(mx, fmaxf(fmaxf(s[i][0], s[i][1]), fmaxf(s[i][2], s[i][3])));
    mx = xmax4(mx);
    const float mn = fmaxf(st.m, mx), al = ex2(st.m - mn); st.m = mn; float sum = 0.f;
#pragma unroll
    for (int i = 0; i < 4; ++i)
#pragma unroll
        for (int r = 0; r < 4; ++r) { s[i][r] = ex2(s[i][r] - mn); sum += s[i][r]; }
    st.l = st.l * al + sum;
    if (__any(al != 1.0f)) {
#pragma unroll
        for (int nb = 0; nb < 8; ++nb) O[nb] = O[nb] * al; }
    pf0 = pack_bf8(s[0], s[1]); pf1 = pack_bf8(s[2], s[3]);
}
__device__ __forceinline__ void attn_prompt_unit(Frame& F, float lam, int b, int h, int qb) {
    LAUNDER_TID(); const int g = lane >> 4, li = lane & 15;
    const bf16* QB = (const bf16*)(F.ws + WS_QB); const bf16* KB = (const bf16*)(F.ws + WS_KB); const bf16* VB = (const bf16*)(F.ws + WS_VB); bf16* CB = (bf16*)(F.ws + WS_CB);
    const size_t rowbase = (size_t)b * SEQ; const int qrel = 16 * wave + li; const size_t qtok = rowbase + 128 * qb + qrel;
    bf16x8 qf[4];
#pragma unroll
    for (int s = 0; s < 4; ++s) qf[s] = *(const bf16x8*)(QB + qtok * 512 + h * 128 + 32 * s + 8 * g);
    const int nt = 2 * qb + 2;
    const int skey = tid >> 4, sch = tid & 15;
    const bf16* kg = KB + (rowbase + skey) * 512 + h * 128 + 8 * sch; const bf16* vg = VB + (rowbase + skey) * 512 + h * 128 + 8 * sch;
    const int kw0 = skey * 256 + ((sch ^ (skey & 15)) << 4), vw0 = skey * 256 + (((sch >> 1) ^ (skey & 7)) << 5) + (sch & 1) * 16;
    LAS unsigned char* L = F.lds;
    int kad[4];
#pragma unroll
    for (int s = 0; s < 4; ++s) kad[s] = li * 256 + (((4 * s + g) ^ li) << 4);
    const int vq = li >> 2, vp = li & 3, vk7 = (4 * g + vq) & 7; int vad[8];
#pragma unroll
    for (int nb = 0; nb < 8; ++nb) vad[nb] = (4 * g + vq) * 256 + ((nb ^ vk7) << 5) + 8 * vp;
    f32x4 O1[8], O2[8]; Soft16 st1{-1e30f, 0.f}, st2{-1e30f, 0.f};
#pragma unroll
    for (int nb = 0; nb < 8; ++nb) { O1[nb] = (f32x4){0.f, 0.f, 0.f, 0.f}; O2[nb] = (f32x4){0.f, 0.f, 0.f, 0.f}; }
    v4u kr0, kr1, vr0, vr1;
    kr0 = *(const v4u*)kg; kr1 = *(const v4u*)(kg + 32 * 512); vr0 = *(const v4u*)vg; vr1 = *(const v4u*)(vg + 32 * 512);
    *(LAS v4u*)(L + kw0) = kr0; *(LAS v4u*)(L + kw0 + 32 * 256) = kr1; *(LAS v4u*)(L + 16384 + vw0) = vr0; *(LAS v4u*)(L + 16384 + vw0 + 32 * 256) = vr1;
    __syncthreads();
    for (int t = 0; t < nt; ++t) {
        const int bo = (t & 1) * 32768;
        if (t + 1 < nt) { const size_t go = (size_t)(t + 1) * 64 * 512; kr0 = *(const v4u*)(kg + go); kr1 = *(const v4u*)(kg + go + 32 * 512); vr0 = *(const v4u*)(vg + go); vr1 = *(const v4u*)(vg + go + 32 * 512); }
        if (!(t == nt - 1 && wave < 4)) {
            const LAS unsigned char* Kt = L + bo; const LAS unsigned char* Vt = L + bo + 16384;
            f32x4 s1[4], s2[4];
            {   bf16x8 kf[4][4];
#pragma unroll
                for (int sub = 0; sub < 4; ++sub)
#pragma unroll
                    for (int ks = 0; ks < 4; ++ks) kf[sub][ks] = *(const LAS bf16x8*)(Kt + sub * 4096 + kad[ks]);
#pragma unroll
                for (int sub = 0; sub < 4; ++sub) { s1[sub] = mfma16(kf[sub][0], qf[0], (f32x4){0.f, 0.f, 0.f, 0.f}); s2[sub] = mfma16(kf[sub][2], qf[2], (f32x4){0.f, 0.f, 0.f, 0.f}); }
#pragma unroll
                for (int sub = 0; sub < 4; ++sub) { s1[sub] = mfma16(kf[sub][1], qf[1], s1[sub]); s2[sub] = mfma16(kf[sub][3], qf[3], s2[sub]); }
            }
            bf16x8 va[8], vb[8];
#pragma unroll
            for (int nb = 0; nb < 8; ++nb) { va[nb] = tr_pair(Vt + vad[nb], Vt + vad[nb] + 16 * 256); vb[nb] = tr_pair(Vt + vad[nb] + 32 * 256, Vt + vad[nb] + 48 * 256); }
            if (t >= nt - 2) {
                const int kb0 = 64 * (t - 2 * qb) + 4 * g;
#pragma unroll
                for (int sub = 0; sub < 4; ++sub)
#pragma unroll
                    for (int r = 0; r < 4; ++r) if (kb0 + 16 * sub + r > qrel) { s1[sub][r] = -__builtin_inff(); s2[sub][r] = -__builtin_inff(); }
            }
            bf16x8 p1a, p1b, p2a, p2b;
            smax_update(s1, st1, O1, p1a, p1b); smax_update(s2, st2, O2, p2a, p2b);
#pragma unroll
            for (int nb = 0; nb < 8; ++nb) { O1[nb] = mfma16(va[nb], p1a, O1[nb]); O2[nb] = mfma16(va[nb], p2a, O2[nb]); }
#pragma unroll
            for (int nb = 0; nb < 8; ++nb) { O1[nb] = mfma16(vb[nb], p1b, O1[nb]); O2[nb] = mfma16(vb[nb], p2b, O2[nb]); }
        }
        if (t + 1 < nt) { const int wo = ((t + 1) & 1) * 32768; *(LAS v4u*)(L + wo + kw0) = kr0; *(LAS v4u*)(L + wo + kw0 + 32 * 256) = kr1; *(LAS v4u*)(L + wo + 16384 + vw0) = vr0; *(LAS v4u*)(L + wo + 16384 + vw0 + 32 * 256) = vr1; }
        __syncthreads();
    }
    const float l1 = xsum4(st1.l), l2 = xsum4(st2.l);
    const float i1 = 1.0f / l1, i2 = lam / l2; float ssq = 0.f;
#pragma unroll
    for (int nb = 0; nb < 8; ++nb)
#pragma unroll
        for (int r = 0; r < 4; ++r) { const float o = O1[nb][r] * i1 - O2[nb][r] * i2; O1[nb][r] = o; ssq += o * o; }
    ssq = xsum4(ssq);
    const float rn = (1.0f - LAM_INIT) / sqrtf(ssq * (1.0f / 128.0f) + EPS);
    const float* sub = F.in[I_SUBLN];
#pragma unroll
    for (int nb = 0; nb < 8; ++nb) { const int dv = 16 * nb + 4 * g; const f32x4 sg = *(const f32x4*)(sub + dv);
        const unsigned w0 = cvtpk(O1[nb][0] * rn * sg[0], O1[nb][1] * rn * sg[1]), w1 = cvtpk(O1[nb][2] * rn * sg[2], O1[nb][3] * rn * sg[3]);
        *(unsigned long long*)(CB + qtok * 1024 + 512 + h * 128 + dv) = (unsigned long long)w0 | ((unsigned long long)w1 << 32); }
}

__device__ __forceinline__ void attn_sample_unit(Frame& F, int b, int rg) {
    LAUNDER_TID(); const int g = lane >> 4, li = lane & 15, head = wave & 3, hf = wave >> 2;
    const bf16* QB = (const bf16*)(F.ws + WS_QB); const float* CK = F.in[I_CK]; const float* CV = F.in[I_CV]; const int* PT = (const int*)F.in[I_PT] + b * 64 + 8 * rg + 4 * hf;
    bf16x8 qf[4];
    { const int qi = li & 7, half = li >> 3; const bf16* qrow = QB + (size_t)(NP + 8 * b + qi) * 512 + head * 128;
#pragma unroll
      for (int s = 0; s < 4; ++s) { bf16x8 z = (bf16x8){0, 0, 0, 0, 0, 0, 0, 0}; if ((s >> 1) == half) z = *(const bf16x8*)(qrow + 32 * s + 8 * g); qf[s] = z; } }
    LAS unsigned char* Kt = F.lds + wave * 16384; LAS unsigned char* Vt = Kt + 8192;
    const int l31 = lane & 31, lh = lane >> 5;
    const int kwr = ((l31 >> 1) << 4) + (l31 & 1) * 8;
    const int vwu = l31 >> 2, vwo = (l31 & 3) * 8;
    int kad[4];
#pragma unroll
    for (int s = 0; s < 4; ++s) kad[s] = li * 256 + (((4 * s + g) ^ li) << 4);
    const int vq = li >> 2, vp = li & 3, vk7 = (4 * g + vq) & 7; int vad[8];
#pragma unroll
    for (int nb = 0; nb < 8; ++nb) vad[nb] = (4 * g + vq) * 256 + ((nb ^ vk7) << 5) + 8 * vp;
    f32x4 O[8]; Soft16 st{-1e30f, 0.f};
#pragma unroll
    for (int nb = 0; nb < 8; ++nb) O[nb] = (f32x4){0.f, 0.f, 0.f, 0.f};
    f32x4 kr[16], vr[16];
#define SLOAD(t) do { const int phys_ = __builtin_amdgcn_readfirstlane(PT[(t) >> 2]); const size_t e0_ = (((size_t)phys_ * 128 + 32 * ((t) & 3) + lh) * 4 + head) * 128 + 4 * l31; \
        _Pragma("unroll") for (int i_ = 0; i_ < 16; ++i_) { kr[i_] = __builtin_nontemporal_load((const f32x4*)(CK + e0_ + (size_t)i_ * 1024)); vr[i_] = __builtin_nontemporal_load((const f32x4*)(CV + e0_ + (size_t)i_ * 1024)); } } while (0)
    SLOAD(0);
#pragma unroll 1
    for (int t = 0; t < 16; ++t) {
#pragma unroll
        for (int i = 0; i < 16; ++i) { const int key = 2 * i + lh;
            *(LAS unsigned long long*)(Kt + key * 256 + (kwr ^ ((key & 15) << 4))) = (unsigned long long)cvtpk(kr[i][0], kr[i][1]) | ((unsigned long long)cvtpk(kr[i][2], kr[i][3]) << 32);
            *(LAS unsigned long long*)(Vt + key * 256 + ((vwu ^ (key & 7)) << 5) + vwo) = (unsigned long long)cvtpk(vr[i][0], vr[i][1]) | ((unsigned long long)cvtpk(vr[i][2], vr[i][3]) << 32); }
        if (t + 1 < 16) SLOAD(t + 1);
        f32x4 s[2];
#pragma unroll
        for (int sub = 0; sub < 2; ++sub) {
            s[sub] = (f32x4){0.f, 0.f, 0.f, 0.f};
#pragma unroll
            for (int ks = 0; ks < 4; ++ks) s[sub] = mfma16(*(const LAS bf16x8*)(Kt + sub * 4096 + kad[ks]), qf[ks], s[sub]);
        }
        float mx = fmaxf(fmaxf(fmaxf(s[0][0], s[0][1]), fmaxf(s[0][2], s[0][3])), fmaxf(fmaxf(s[1][0], s[1][1]), fmaxf(s[1][2], s[1][3])));
        mx = xmax4(mx);
        const float mn = fmaxf(st.m, mx), al = ex2(st.m - mn); st.m = mn; float sum = 0.f;
#pragma unroll
        for (int i = 0; i < 2; ++i)
#pragma unroll
            for (int r = 0; r < 4; ++r) { s[i][r] = ex2(s[i][r] - mn); sum += s[i][r]; }
        st.l = st.l * al + sum;
        const bf16x8 pf = pack_bf8(s[0], s[1]);
#pragma unroll
        for (int nb = 0; nb < 8; ++nb) { const bf16x8 va = tr_pair(Vt + vad[nb], Vt + vad[nb] + 16 * 256); O[nb] = mfma16(va, pf, O[nb] * al); }
    }
#undef SLOAD
    const float l = xsum4(st.l);
    float* P = (float*)(F.ws + WS_PART) + ((size_t)(b * 4 + head) * 16 + 2 * rg + hf) * PART_STRIDE;
    if (g == 0) { P[li] = st.m; P[16 + li] = l; }
#pragma unroll
    for (int nb = 0; nb < 8; ++nb) *(f32x4*)(P + 32 + li * 128 + 16 * nb + 4 * g) = O[nb];
}
__device__ __forceinline__ void attn_sample_combine(Frame& F, float lam, int b, int head) {
    LAUNDER_TID(); const int qp = tid >> 5, dvc = tid & 31, qi = qp & 7, half = qp >> 3, dv = 4 * dvc;
    const bf16* QB = (const bf16*)(F.ws + WS_QB); const bf16* KB = (const bf16*)(F.ws + WS_KB); const bf16* VB = (const bf16*)(F.ws + WS_VB); bf16* CB = (bf16*)(F.ws + WS_CB);
    const float* P = (const float*)(F.ws + WS_PART) + (size_t)(b * 4 + head) * 16 * PART_STRIDE;
    float M = -1e30f;
    for (int sl = 0; sl < 16; ++sl) M = fmaxf(M, P[sl * PART_STRIDE + qp]);
    const size_t tq = NP + 8 * b + qi; const bf16* qrow = QB + tq * 512 + head * 128 + 64 * half;
    float sc[8];
#pragma unroll
    for (int j = 0; j < 8; ++j) { const bf16* krow = KB + (size_t)(NP + 8 * b + j) * 512 + head * 128 + 64 * half; float d = 0.f;
#pragma unroll 2
        for (int e = 0; e < 8; ++e) { const v4u a = *(const v4u*)(qrow + 8 * e), k = *(const v4u*)(krow + 8 * e);
            d += (bflo(a.x) * bflo(k.x) + bfhi(a.x) * bfhi(k.x)) + (bflo(a.y) * bflo(k.y) + bfhi(a.y) * bfhi(k.y)) + (bflo(a.z) * bflo(k.z) + bfhi(a.z) * bfhi(k.z)) + (bflo(a.w) * bflo(k.w) + bfhi(a.w) * bfhi(k.w)); }
        sc[j] = (j <= qi) ? d : -__builtin_inff(); M = fmaxf(M, sc[j]); }
    float Lacc = 0.f; f32x4 Oa = (f32x4){0.f, 0.f, 0.f, 0.f};
    for (int sl = 0; sl < 16; ++sl) { const float w = ex2(P[sl * PART_STRIDE + qp] - M); Lacc += w * P[sl * PART_STRIDE + 16 + qp]; Oa = Oa + *(const f32x4*)(P + sl * PART_STRIDE + 32 + qp * 128 + dv) * w; }
#pragma unroll
    for (int j = 0; j < 8; ++j) { const float p = ex2(sc[j] - M); Lacc += p; const float pb = bf2f((unsigned short)f2bf(p));
        const bf16* vrow = VB + (size_t)(NP + 8 * b + j) * 512 + head * 128 + dv;
        Oa[0] += pb * bf2f(vrow[0]); Oa[1] += pb * bf2f(vrow[1]); Oa[2] += pb * bf2f(vrow[2]); Oa[3] += pb * bf2f(vrow[3]); }
    LAS float* buf = (LAS float*)F.lds;
    const float inv = 1.0f / Lacc;
    *(LAS f32x4*)(buf + (half * 8 + qi) * 128 + dv) = Oa * inv;
    __syncthreads();
    if (half == 0) {
        const f32x4 a = *(const LAS f32x4*)(buf + qi * 128 + dv), c = *(const LAS f32x4*)(buf + (8 + qi) * 128 + dv); const f32x4 o = a - c * lam;
        float ssq = (o[0] * o[0] + o[1] * o[1]) + (o[2] * o[2] + o[3] * o[3]);
#pragma unroll
        for (int x = 1; x < 32; x <<= 1) ssq += __shfl_xor(ssq, x);
        const float rn = (1.0f - LAM_INIT) / sqrtf(ssq * (1.0f / 128.0f) + EPS); const f32x4 sg = *(const f32x4*)(F.in[I_SUBLN] + dv);
        const unsigned w0 = cvtpk(o[0] * rn * sg[0], o[1] * rn * sg[1]), w1 = cvtpk(o[2] * rn * sg[2], o[3] * rn * sg[3]);
        *(unsigned long long*)(CB + tq * 1024 + 512 + head * 128 + dv) = (unsigned long long)w0 | ((unsigned long long)w1 << 32);
    }
    __syncthreads();
}

__device__ __forceinline__ void ssm_prompt_unit(Frame& F, int b, int g) {
    LAUNDER_TID(); const int n = lane & 31, hi = lane >> 5, chunk = 32 * wave + n;
    const bf16* XB = (const bf16*)(F.ws + WS_XB); bf16* G = (bf16*)(F.ws + WS_CB);
    const unsigned long long* ss2 = (const unsigned long long*)(F.ws + WS_SS) + 2 * (size_t)NTOK;
    const bf16* Tg = (const bf16*)(F.ws + WS_T) + (size_t)g * 65536; const bf16* Eg = (const bf16*)(F.ws + WS_E) + (size_t)g * 32768; const bf16* Fg = (const bf16*)(F.ws + WS_F) + (size_t)g * 32768;
    LAS float* S = (LAS float*)F.lds;
    const size_t tok0 = (size_t)b * SEQ + 16 * chunk;
    bf16x8 uf[16];
#pragma unroll
    for (int ks = 0; ks < 16; ++ks) { const size_t tok = tok0 + ks; const v4u w = *(const v4u*)(XB + tok * 1024 + 16 * g + 8 * hi); const float r = ss_rinv(ss2 + tok, 1.0f / 1024.0f);
        v4u o; o.x = cvtpk(bflo(w.x) * r, bfhi(w.x) * r); o.y = cvtpk(bflo(w.y) * r, bfhi(w.y) * r); o.z = cvtpk(bflo(w.z) * r, bfhi(w.z) * r); o.w = cvtpk(bflo(w.w) * r, bfhi(w.w) * r);
        uf[ks] = __builtin_bit_cast(bf16x8, o); }
#pragma unroll 1
    for (int mb = 0; mb < 4; ++mb) {
        f32x16 acc = (f32x16){};
#pragma unroll
        for (int ks = 0; ks < 16; ++ks) acc = mfma32(*(const bf16x8*)(Eg + (32 * mb + n) * 256 + 16 * ks + 8 * hi), uf[ks], acc);
#pragma unroll
        for (int i = 0; i < 4; ++i) *(LAS f32x4*)(S + chunk * 132 + 32 * mb + 8 * i + 4 * hi) = (f32x4){acc[4 * i], acc[4 * i + 1], acc[4 * i + 2], acc[4 * i + 3]};
    }
    __syncthreads();
    {
        LAS float* car = S + 256 * 132;
        const f32x2_t aL = ((const f32x2_t*)(F.ws + WS_PW16))[g * 64 + lane]; float sr = 0.f, si = 0.f;
#pragma unroll 8
        for (int c = 32 * wave; c < 32 * wave + 32; ++c) { const float lr = S[c * 132 + lane], li_ = S[c * 132 + 64 + lane]; S[c * 132 + lane] = sr; S[c * 132 + 64 + lane] = si;
            const float nr = aL.x * sr - aL.y * si + lr, ni = aL.x * si + aL.y * sr + li_; sr = nr; si = ni; }
        car[wave * 128 + lane] = sr; car[wave * 128 + 64 + lane] = si;
        __syncthreads();
        float ar = aL.x, ai = aL.y;
#pragma unroll
        for (int q = 0; q < 5; ++q) { const float nr = ar * ar - ai * ai, ni = 2.f * ar * ai; ar = nr; ai = ni; }
        float cr = 0.f, ci = 0.f;
        for (int w2 = 0; w2 < wave; ++w2) { const float lr = car[w2 * 128 + lane], li_ = car[w2 * 128 + 64 + lane]; const float nr = ar * cr - ai * ci + lr, ni = ar * ci + ai * cr + li_; cr = nr; ci = ni; }
        float pr = 1.f, pi = 0.f;
#pragma unroll 8
        for (int c = 32 * wave; c < 32 * wave + 32; ++c) { S[c * 132 + lane] += pr * cr - pi * ci; S[c * 132 + 64 + lane] += pr * ci + pi * cr;
            const float nr = pr * aL.x - pi * aL.y, ni = pr * aL.y + pi * aL.x; pr = nr; pi = ni; }
        if (wave == 7) { const float fr_ = ar * cr - ai * ci + sr, fi_ = ar * ci + ai * cr + si;
            F.out[OFF_SRP + (size_t)(b * 64 + g) * 64 + lane] = fr_; F.out[OFF_SIP + (size_t)(b * 64 + g) * 64 + lane] = fi_; }
    }
    __syncthreads();
    bf16x8 sf[8];
#pragma unroll
    for (int ks = 0; ks < 8; ++ks) { const f32x4 a = *(const LAS f32x4*)(S + chunk * 132 + 16 * ks + 8 * hi), c = *(const LAS f32x4*)(S + chunk * 132 + 16 * ks + 8 * hi + 4); sf[ks] = pack_bf8(a, c); }
#pragma unroll
    for (int mb = 0; mb < 8; ++mb) {
        f32x16 acc = (f32x16){};
#pragma unroll
        for (int ks = 0; ks < 16; ++ks) if (ks <= 2 * mb + 1) acc = mfma32(*(const bf16x8*)(Tg + (32 * mb + n) * 256 + 16 * ks + 8 * hi), uf[ks], acc);
#pragma unroll
        for (int ks = 0; ks < 8; ++ks) acc = mfma32(*(const bf16x8*)(Fg + (32 * mb + n) * 128 + 16 * ks + 8 * hi), sf[ks], acc);
#pragma unroll
        for (int i = 0; i < 4; ++i) { const int t = 2 * mb + (i >> 1), c = 8 * (i & 1) + 4 * hi;
            const unsigned w0 = cvtpk(gelu_t(acc[4 * i]), gelu_t(acc[4 * i + 1])), w1 = cvtpk(gelu_t(acc[4 * i + 2]), gelu_t(acc[4 * i + 3]));
            *(unsigned long long*)(G + (tok0 + t) * 1024 + 16 * g + c) = (unsigned long long)w0 | ((unsigned long long)w1 << 32); }
    }
    __syncthreads();
}
__device__ __forceinline__ void ssm_sample_unit(Frame& F, int b, int g) {
    LAUNDER_TID(); const int p = lane; const bf16* XB = (const bf16*)(F.ws + WS_XB); bf16* G = (bf16*)(F.ws + WS_CB);
    const unsigned long long* ss2 = (const unsigned long long*)(F.ws + WS_SS) + 2 * (size_t)NTOK;
    const f32x2_t a = ((const f32x2_t*)(F.ws + WS_PW1))[g * 64 + p]; const f32x2_t* BB = (const f32x2_t*)(F.ws + WS_BBAR) + (size_t)g * 1024 + p * 16;
    const float* c_re = F.in[I_CRE] + (size_t)g * 1024; const float* c_im = F.in[I_CIM] + (size_t)g * 1024; const float* g1 = F.in[I_NMIX] + 1024 + 16 * g; const float* dsk = F.in[I_SD] + 16 * g;
    LAS float* sh = (LAS float*)(F.lds + wave * 4096);
    float sr = F.in[I_SRE][(size_t)(b * 64 + g) * 64 + p], si = F.in[I_SIM][(size_t)(b * 64 + g) * 64 + p];
    f32x2_t bb[16];
#pragma unroll
    for (int c = 0; c < 16; ++c) bb[c] = BB[c];
#pragma unroll
    for (int t = 0; t < 8; ++t) {
        const size_t tok = NP + 8 * b + t; const float r = ss_rinv(ss2 + tok, 1.0f / 1024.0f); float br = 0.f, bi = 0.f;
        const v4u w0 = *(const v4u*)(XB + tok * 1024 + 16 * g), w1 = *(const v4u*)(XB + tok * 1024 + 16 * g + 8); const unsigned ww[8] = {w0.x, w0.y, w0.z, w0.w, w1.x, w1.y, w1.z, w1.w};
#pragma unroll
        for (int c = 0; c < 16; ++c) { const float u = ((c & 1) ? bfhi(ww[c >> 1]) : bflo(ww[c >> 1])) * r * g1[c]; br += bb[c].x * u; bi += bb[c].y * u; }
        const float nr = a.x * sr - a.y * si + br, ni = a.x * si + a.y * sr + bi; sr = nr; si = ni;
        sh[t * 128 + p] = sr; sh[t * 128 + 64 + p] = si;
    }
    F.out[OFF_SRS + (size_t)(b * 64 + g) * 64 + p] = sr; F.out[OFF_SIS + (size_t)(b * 64 + g) * 64 + p] = si;
    LDS_WAIT(); asm volatile("" ::: "memory");
    {   const int t = lane >> 3, c0 = 2 * (lane & 7); const size_t tok = NP + 8 * b + t; float y0 = 0.f, y1 = 0.f;
        const float* cr0 = c_re + c0 * 64; const float* ci0 = c_im + c0 * 64;
#pragma unroll 4
        for (int q = 0; q < 16; ++q) { const f32x4 xr = *(const LAS f32x4*)(sh + t * 128 + 4 * q), xi = *(const LAS f32x4*)(sh + t * 128 + 64 + 4 * q);
            const f32x4 a0 = *(const f32x4*)(cr0 + 4 * q), b0 = *(const f32x4*)(ci0 + 4 * q), a1 = *(const f32x4*)(cr0 + 64 + 4 * q), b1 = *(const f32x4*)(ci0 + 64 + 4 * q);
#pragma unroll
            for (int e = 0; e < 4; ++e) { y0 += a0[e] * xr[e] - b0[e] * xi[e]; y1 += a1[e] * xr[e] - b1[e] * xi[e]; } }
        const float r = ss_rinv(ss2 + tok, 1.0f / 1024.0f); const unsigned xw = *(const unsigned*)(XB + tok * 1024 + 16 * g + c0);
        y0 += dsk[c0] * (bflo(xw) * r * g1[c0]); y1 += dsk[c0 + 1] * (bfhi(xw) * r * g1[c0 + 1]);
        *(unsigned*)(G + tok * 1024 + 16 * g + c0) = cvtpk(gelu_t(y0), gelu_t(y1));
    }
    LDS_WAIT(); asm volatile("" ::: "memory");
}

template <int MODE, int K>
__device__ __forceinline__ void sample_gemm_tile(Frame& F, const bf16* A, const bf16* Bt, int tile, const float* bglu, float* X, bf16* XB, bool wxb, unsigned long long* ss) {
    LAUNDER_TID();
    constexpr int kper = K / 8, nks = kper / 16;
    const int rb = tile >> 5, cb = tile & 31, r32 = lane & 31, hi = lane >> 5, k0 = wave * kper;
    const bf16* ap = A + (size_t)(32 * rb + r32) * K + k0 + 8 * hi;
    const int brow = MODE == 0 ? 32 * cb + r32 : 256 * (cb >> 2) + 32 * (cb & 3) + r32;
    const bf16* bp = Bt + (size_t)brow * K + k0 + 8 * hi;
    f32x16 acc = (f32x16){}, acc2 = (f32x16){};
#pragma unroll
    for (int ks = 0; ks < nks; ++ks) { const bf16x8 a = *(const bf16x8*)(ap + 16 * ks); const bf16x8 b = *(const bf16x8*)(bp + 16 * ks); acc = mfma32(a, b, acc);
        if (MODE == 1) { const bf16x8 b2 = *(const bf16x8*)(bp + (size_t)128 * K + 16 * ks); acc2 = mfma32(a, b2, acc2); } }
    LAS float* red = (LAS float*)F.lds;
#pragma unroll
    for (int r = 0; r < 16; ++r) { red[(wave * 16 + r) * 64 + lane] = acc[r]; if (MODE == 1) red[8192 + (wave * 16 + r) * 64 + lane] = acc2[r]; }
    __syncthreads();
#pragma unroll
    for (int h2 = 0; h2 < 2; ++h2) {
        const int r = (tid >> 6) + 8 * h2, l2 = tid & 63; float sum = 0.f, sum2 = 0.f;
#pragma unroll
        for (int w = 0; w < 8; ++w) { sum += red[(w * 16 + r) * 64 + l2]; if (MODE == 1) sum2 += red[8192 + (w * 16 + r) * 64 + l2]; }
        const int row = 32 * rb + (r & 3) + 8 * (r >> 2) + 4 * (l2 >> 5), col = 32 * cb + (l2 & 31); const size_t go = (size_t)(NP + row) * 1024 + col;
        float o = bf2f(XB[go]);
        if (MODE == 0) o += sum; else o += (sum + bglu[col]) * pg8::sigm(sum2 + bglu[1024 + col]);
        if (X) X[go] = o;
        if (wxb) XB[go] = (bf16)f2bf(o);
        float ssq = o * o;
#pragma unroll
        for (int x = 1; x < 32; x <<= 1) ssq += __shfl_xor(ssq, x);
        if ((l2 & 31) == 0) pg8::ss_add(ss + NP + row, ssq);
    }
    __syncthreads();
}
__device__ __forceinline__ void final_norm_row(Frame& F, int m) {
    LAUNDER_TID(); const float* X = (const float*)(F.ws + WS_X) + (size_t)m * 1024; const unsigned long long* ss4 = (const unsigned long long*)(F.ws + WS_SS) + 4 * (size_t)NTOK;
    const float r = ss_rinv(ss4 + m, 1.0f / 1024.0f); const float* gf = F.in[I_NFIN]; float* o = F.out + OFF_YP + (size_t)m * 1024;
#pragma unroll
    for (int j = 0; j < 4; ++j) { const int c = 4 * lane + 256 * j; const f32x4 v = *(const f32x4*)(X + c), gg = *(const f32x4*)(gf + c); *(f32x4*)(o + c) = v * gg * r; }
}
#ifndef MK_LAST_PHASE
#define MK_LAST_PHASE 99
#endif
#ifndef MK_REP_ATTNP
#define MK_REP_ATTNP 1
#endif
#ifndef MK_REP_ATTNS
#define MK_REP_ATTNS 1
#endif
#ifndef MK_REP_SGU
#define MK_REP_SGU 1
#endif
#ifndef MK_REP_SSM
#define MK_REP_SSM 1
#endif
#ifndef MK_REP_G3
#define MK_REP_G3 1
#endif
#ifndef MK_REP_P0
#define MK_REP_P0 1
#endif
#ifndef MK_REP_G1
#define MK_REP_G1 1
#endif
#ifndef MK_REP_FIN
#define MK_REP_FIN 1
#endif
#ifndef MK_PROBE_GEMMS
#define MK_PROBE_GEMMS 0
#endif
#ifndef MK_TMASK
#define MK_TMASK 0
#endif
#define MK_TMULT 4
struct Args { const float* in[32]; float* out; unsigned char* ws; };
__global__ void __launch_bounds__(NWAVES * 64, 2) hyb_fwd(Args args) {
    extern __shared__ __attribute__((aligned(16))) unsigned char lds[];
    Frame F;
    F.lds = (LAS unsigned char*)lds;
    F.MISC = (volatile LAS unsigned*)(F.lds + MISC_OFF);
    F.tid = threadIdx.x; F.lane = F.tid & 63; F.wave = __builtin_amdgcn_readfirstlane(F.tid >> 6);
    F.G = gridDim.x; { const int bx = blockIdx.x; F.vcu = (F.G % 8 == 0) ? (bx % 8) * (F.G / 8) + bx / 8 : bx; }
    F.in = args.in;
    F.out = args.out; F.ws = args.ws; F.ctl = (gu32*)(args.ws + WS_CTL);
    for (int u = F.tid; u < (LDS_BYTES - LDSCTL_OFF) / 4; u += NWAVES * 64) ((LAS unsigned*)(F.lds + LDSCTL_OFF))[u] = 0u;
    __syncthreads();
    XcdBarrier bar = xcd_barrier_post((unsigned*)(F.ctl + CW_BAR), F.MISC + 8);
#define GRID_BAR() xcd_barrier(bar)
    unsigned long long t_prev = 0, t_acc = 0; int t_idx = 0;
#define TSTAMP() do { if (MK_TMASK) { const unsigned long long t_now = __builtin_amdgcn_s_memrealtime(); if ((MK_TMASK >> t_idx) & 1) t_acc += t_now - t_prev; t_prev = t_now; ++t_idx; } } while (0)
    if (MK_TMASK) t_prev = __builtin_amdgcn_s_memrealtime();
    unsigned char* ws = F.ws;
    bf16* XB = (bf16*)(ws + WS_XB); float* X = (float*)(ws + WS_X); bf16* CB = (bf16*)(ws + WS_CB); bf16* ACT = (bf16*)(ws + WS_ACT);
    unsigned long long* SS = (unsigned long long*)(ws + WS_SS);
    const int gw = F.vcu * NWAVES + F.wave, NGW = F.G * NWAVES;

    for (int rep = 0; rep < MK_REP_P0; ++rep) { p0_prologue(F); __syncthreads(); }
    GRID_BAR(); TSTAMP();
    for (int rep = 0; rep < MK_REP_G1; ++rep) {
        pg8::Gemm g{XB, (const bf16*)(ws + WS_W1), NTOK, 2560, 1024}; pg8::StaticOrder S; S.init(NTOK, 2560, F.G, (int)blockIdx.x);
        pg8::EpiInProj E{(const float*)(ws + WS_R0), (bf16*)(ws + WS_U), (bf16*)(ws + WS_VR), (bf16*)(ws + WS_QB), (bf16*)(ws + WS_KB), (bf16*)(ws + WS_VB), SS, F.out, rep == 0};
        pg8::gemm_phase<pg8::EpiInProj, pg8::StaticOrder, true, true>(F.lds + RING_OFF, g, S, E);
    }
    GRID_BAR(); TSTAMP();
    const float lam = lambda_val(F);
    if (MK_LAST_PHASE >= 2) {
        const bool stream_first = ((F.vcu >> 4) & 1) != 0;
        if (stream_first) { for (int u = F.vcu; u < 256; u += F.G) attn_sample_unit(F, u >> 3, u & 7); __syncthreads(); }
        for (int rep = 0; rep < MK_REP_ATTNP; ++rep)
        for (int u = F.vcu; u < 256; u += F.G) { const int bh = u >> 4, s = u & 15; attn_prompt_unit(F, lam, bh >> 2, bh & 3, s); attn_prompt_unit(F, lam, bh >> 2, bh & 3, 31 - s); }
        if (!stream_first) { for (int u = F.vcu; u < 256; u += F.G) attn_sample_unit(F, u >> 3, u & 7); }
        __syncthreads();
        for (int rep = 0; rep < MK_REP_SGU; ++rep) {
        for (int u = F.vcu; u < 512; u += F.G) sgu_prompt_unit(F, u >> 2, u & 3);
        for (int u = F.vcu; u < 32; u += F.G) sgu_sample_unit(F, u); }
    }
    GRID_BAR(); TSTAMP();
    if (MK_LAST_PHASE >= 2) { for (int u = F.vcu; u < 128; u += F.G) attn_sample_combine(F, lam, u >> 2, u & 3); }
    GRID_BAR(); TSTAMP();
    if (MK_LAST_PHASE >= 3) {
        pg8::Gemm g{CB, (const bf16*)(ws + WS_W2), NP, 1024, 1024}; pg8::StaticOrder S; S.init(NP, 1024, F.G, (int)blockIdx.x);
        pg8::EpiResid E{XB, nullptr, true, SS + 1 * (size_t)NTOK};
        pg8::gemm_phase<pg8::EpiResid, pg8::StaticOrder, true, true>(F.lds + RING_OFF, g, S, E);
        for (int t = F.vcu; t < 256; t += F.G) sample_gemm_tile<0, 1024>(F, CB + (size_t)NP * 1024, (const bf16*)(ws + WS_W2), t, nullptr, nullptr, XB, true, SS + 1 * (size_t)NTOK);
    }
    GRID_BAR(); TSTAMP();
    for (int rep = 0; rep < MK_REP_G3; ++rep) {
        pg8::Gemm g{XB, (const bf16*)(ws + WS_W3), NTOK, 5632, 1024}; pg8::StaticOrder S; S.init(NTOK, 5632, F.G, (int)blockIdx.x);
        pg8::EpiSwiGLU E{SS + 1 * (size_t)NTOK, ACT};
        pg8::gemm_phase<pg8::EpiSwiGLU, pg8::StaticOrder, true, true>(F.lds + RING_OFF, g, S, E);
    }
    GRID_BAR(); TSTAMP();
    if (MK_LAST_PHASE >= 5) {
        pg8::Gemm g{ACT, (const bf16*)(ws + WS_W4), NP, 1024, 2816}; pg8::StaticOrder S; S.init(NP, 1024, F.G, (int)blockIdx.x);
        pg8::EpiResid E{XB, nullptr, true, SS + 2 * (size_t)NTOK};
        pg8::gemm_phase<pg8::EpiResid, pg8::StaticOrder, true, true>(F.lds + RING_OFF, g, S, E);
        for (int t = F.vcu; t < 256; t += F.G) sample_gemm_tile<0, 2816>(F, ACT + (size_t)NP * 2816, (const bf16*)(ws + WS_W4), t, nullptr, nullptr, XB, true, SS + 2 * (size_t)NTOK);
    }
    GRID_BAR(); TSTAMP();
    if (MK_LAST_PHASE >= 6) {
        for (int rep = 0; rep < MK_REP_SSM; ++rep) {
        for (int u = F.vcu; u < 256; u += F.G) ssm_prompt_unit(F, u >> 6, u & 63);
        for (int w = gw; w < 2048; w += NGW) ssm_sample_unit(F, w >> 6, w & 63); }
    }
    GRID_BAR(); TSTAMP();
    if (MK_LAST_PHASE >= 7) {
        pg8::Gemm g{CB, (const bf16*)(ws + WS_W5), NP, 2048, 1024}; pg8::StaticOrder S; S.init(NP, 2048, F.G, (int)blockIdx.x);
        pg8::EpiGLU E{F.in[I_BGLU], XB, SS + 3 * (size_t)NTOK};
        pg8::gemm_phase<pg8::EpiGLU, pg8::StaticOrder, true, true>(F.lds + RING_OFF, g, S, E);
        for (int t = F.vcu; t < 256; t += F.G) sample_gemm_tile<1, 1024>(F, CB + (size_t)NP * 1024, (const bf16*)(ws + WS_W5), t, F.in[I_BGLU], nullptr, XB, true, SS + 3 * (size_t)NTOK);
    }
    GRID_BAR(); TSTAMP();
    if (MK_LAST_PHASE >= 8) {
        pg8::Gemm g{XB, (const bf16*)(ws + WS_W6), NTOK, 5632, 1024}; pg8::StaticOrder S; S.init(NTOK, 5632, F.G, (int)blockIdx.x);
        pg8::EpiSwiGLU E{SS + 3 * (size_t)NTOK, ACT};
        pg8::gemm_phase<pg8::EpiSwiGLU, pg8::StaticOrder, true, true>(F.lds + RING_OFF, g, S, E);
    }
    GRID_BAR(); TSTAMP();
    if (MK_LAST_PHASE >= 9) {
        pg8::Gemm g{ACT, (const bf16*)(ws + WS_W7), NP, 1024, 2816}; pg8::StaticOrder S; S.init(NP, 1024, F.G, (int)blockIdx.x);
        pg8::EpiResid E{XB, X, false, SS + 4 * (size_t)NTOK};
        pg8::gemm_phase<pg8::EpiResid, pg8::StaticOrder, true, true>(F.lds + RING_OFF, g, S, E);
        for (int t = F.vcu; t < 256; t += F.G) sample_gemm_tile<0, 2816>(F, ACT + (size_t)NP * 2816, (const bf16*)(ws + WS_W7), t, nullptr, X, XB, false, SS + 4 * (size_t)NTOK);
    }
    GRID_BAR(); TSTAMP();
#if MK_PROBE_GEMMS
    {   pg8::EpiNull E{X, (int)F.G};
        { pg8::Gemm g{CB, (const bf16*)(ws + WS_W2), NP, 1024, 1024}; pg8::StaticOrder S; S.init(NP, 1024, F.G, (int)blockIdx.x); pg8::gemm_phase<pg8::EpiNull, pg8::StaticOrder, true, true>(F.lds + RING_OFF, g, S, E); }
        { pg8::Gemm g{ACT, (const bf16*)(ws + WS_W4), NP, 1024, 2816}; pg8::StaticOrder S; S.init(NP, 1024, F.G, (int)blockIdx.x); pg8::gemm_phase<pg8::EpiNull, pg8::StaticOrder, true, true>(F.lds + RING_OFF, g, S, E); }
        { pg8::Gemm g{CB, (const bf16*)(ws + WS_W5), NP, 2048, 1024}; pg8::StaticOrder S; S.init(NP, 2048, F.G, (int)blockIdx.x); pg8::gemm_phase<pg8::EpiNull, pg8::StaticOrder, true, true>(F.lds + RING_OFF, g, S, E); }
        { pg8::Gemm g{ACT, (const bf16*)(ws + WS_W7), NP, 1024, 2816}; pg8::StaticOrder S; S.init(NP, 1024, F.G, (int)blockIdx.x); pg8::gemm_phase<pg8::EpiNull, pg8::StaticOrder, true, true>(F.lds + RING_OFF, g, S, E); }
    }
#endif
    for (int rep = 0; rep < MK_REP_FIN; ++rep) { for (int m = gw; m < NTOK; m += NGW) final_norm_row(F, m); }
    if (MK_TMASK) { TSTAMP(); if (blockIdx.x == 0 && F.tid == 0) { const unsigned long long t0_ = __builtin_amdgcn_s_memrealtime(); while (__builtin_amdgcn_s_memrealtime() - t0_ < MK_TMULT * t_acc) __builtin_amdgcn_s_sleep(8); } }
}

extern "C" void kernel_launch(void* const* d_in, const int* in_sizes, int n_in, void* d_out, int out_size, void* d_ws, size_t ws_size, hipStream_t stream) {
    static int grid = 0;
    if (grid == 0) {
        if (n_in != 32 || (size_t)out_size != OUT_TOTAL || ws_size < WS_END) { fprintf(stderr, "kernel_launch: shape mismatch (n_in %d, out %d, ws %zu); nothing launched\n", n_in, out_size, ws_size); grid = -1; return; }
        int dev = 0, cus = 0, per_cu = 0;
        if (hipGetDevice(&dev) != hipSuccess || hipDeviceGetAttribute(&cus, hipDeviceAttributeMultiprocessorCount, dev) != hipSuccess) { grid = -1; return; }
        if (hipFuncSetAttribute((const void*)hyb_fwd, hipFuncAttributeMaxDynamicSharedMemorySize, LDS_BYTES) != hipSuccess) { fprintf(stderr, "kernel_launch: hipFuncSetAttribute failed\n"); grid = -1; return; }
        if (hipOccupancyMaxActiveBlocksPerMultiprocessor(&per_cu, (const void*)hyb_fwd, NWAVES * 64, LDS_BYTES) != hipSuccess || per_cu < 1) { fprintf(stderr, "kernel_launch: occupancy query says %d blocks per CU\n", per_cu); }
        (void)hipGetLastError();
        grid = cus;
    }
    if (grid < 0) return;
    if (hipMemsetAsync((char*)d_ws + WS_CTL, 0, CTL_ZERO_BYTES, stream) != hipSuccess) { fprintf(stderr, "kernel_launch: memset failed\n"); return; }
    Args a{};
    for (int i = 0; i < 32; ++i) a.in[i] = (const float*)d_in[i];
    a.out = (float*)d_out; a.ws = (unsigned char*)d_ws;
    hipLaunchKernelGGL(hyb_fwd, dim3(grid), dim3(NWAVES * 64), LDS_BYTES, stream, a);
    const hipError_t le = hipPeekAtLastError();
    if (le != hipSuccess) fprintf(stderr, "kernel_launch: launch failed: %s\n", hipGetErrorName(le));
}
```

```cpp
#include <hip/hip_runtime.h>
#include <cstdio>
#include <cstdint>
namespace pg8 {
#define PG8_LAS __attribute__((address_space(3)))
typedef unsigned short bf16_t;
typedef short bf16x8 __attribute__((ext_vector_type(8)));
typedef float f32x4 __attribute__((ext_vector_type(4)));
typedef unsigned u32x4 __attribute__((ext_vector_type(4)));
constexpr int BM = 256, BK = 64, HALF = 128, HTB = HALF * BK * 2  , STAGE_BYTES = 8 * HTB, NXCD = 8, WGM = 8;

__host__ __device__ __forceinline__ int lds_byte(int r, int c) { const int st = (r >> 4) * 2 + (c >> 5), rr = r & 15, cc = c & 31, ob = rr * 64 + cc * 2; return st * 1024 + (ob ^ (((ob >> 9) & 1) << 5)); }
__host__ __device__ __forceinline__ void stage_rc(int b, int& R, int& C) { const int st = b / 1024, sb = b % 1024, swz = sb ^ (((sb >> 9) & 1) << 5); R = (st >> 1) * 16 + swz / 64; C = (st & 1) * 32 + (swz % 64) / 2; }
__host__ __device__ __forceinline__ int perm32(int rho) { const int n = rho >> 4, i = rho & 15; return 8 * (i >> 2) + 4 * n + (i & 3); }

struct Unit { int pm, pn; };
struct Gemm { const bf16_t* A; const bf16_t* Bt; int M, N, K; };

struct StaticOrder {
    int nM, nN, nwg, G, c;
    __host__ __device__ void init(int M, int N, int G_, int c_) { nM = M / BM; nN = N / BM; nwg = nM * nN; G = G_; c = c_; }
    __host__ __device__ bool next(int i, Unit& u) const {
        const long L = (long)i * G + c; if (L >= nwg) return false;
        int wgid = (int)L; { const int q = nwg / NXCD, r = nwg % NXCD, xcd = wgid % NXCD, off = wgid / NXCD; wgid = (xcd < r ? xcd * (q + 1) : r * (q + 1) + (xcd - r) * q) + off; }
        const int nig = WGM * nN, gid = wgid / nig, fm = gid * WGM, gsz = (nM - fm) < WGM ? (nM - fm) : WGM;
        u.pm = fm + ((wgid % nig) % gsz); u.pn = (wgid % nig) / gsz; return true;
    }
    __device__ __forceinline__ void a_ready(const Unit&) const {}
    __device__ __forceinline__ void done(const Unit&) const {}
};

__device__ __forceinline__ unsigned cvt_pk_bf16(float lo, float hi) { unsigned r; asm volatile("v_cvt_pk_bf16_f32 %0, %1, %2" : "=v"(r) : "v"(lo), "v"(hi)); return r; }
typedef float f32x2 __attribute__((ext_vector_type(2)));
constexpr int NP_ = 16384, NS_ = 256;
constexpr size_t OFF_YP = 0, OFF_YS = OFF_YP + (size_t)NP_ * 1024, OFF_KP = OFF_YS + (size_t)NS_ * 1024, OFF_VP = OFF_KP + (size_t)NP_ * 512, OFF_KS = OFF_VP + (size_t)NP_ * 512,
                 OFF_VS = OFF_KS + (size_t)NS_ * 512, OFF_CV = OFF_VS + (size_t)NS_ * 512, OFF_SRP = OFF_CV + (size_t)NS_ * 512, OFF_SIP = OFF_SRP + 4 * 64 * 64, OFF_SRS = OFF_SIP + 4 * 64 * 64,
                 OFF_SIS = OFF_SRS + 32 * 64 * 64, OUT_TOTAL = OFF_SIS + 32 * 64 * 64;
constexpr float QSCALE = 0.125f * 1.4426950408889634f;
#define PG8_RLXA __ATOMIC_RELAXED, __HIP_MEMORY_SCOPE_AGENT
__device__ __forceinline__ void ss_add(unsigned long long* p, float v) { __hip_atomic_fetch_add(p, (unsigned long long)(v * 1048576.0f + 0.5f), PG8_RLXA); }
__device__ __forceinline__ float ss_rinv(const unsigned long long* p, float inv_n) { const unsigned long long w = __hip_atomic_load(p, PG8_RLXA); return __builtin_amdgcn_rsqf((float)w * (inv_n * (1.0f / 1048576.0f)) + 1e-6f); }
__device__ __forceinline__ float gelu_t(float x) { const float t = x * (1.0f + 0.044715f * x * x); return x * __builtin_amdgcn_rcpf(1.0f + __builtin_amdgcn_exp2f(-2.302208198f * t)); }
__device__ __forceinline__ float sigm(float x) { return __builtin_amdgcn_rcpf(1.0f + __builtin_amdgcn_exp2f(-1.4426950409f * x)); }
__device__ __forceinline__ float quad_sum(float s) { s += __shfl_xor(s, 16); s += __shfl_xor(s, 32); return s; }
__device__ __forceinline__ u32x4 pack8(const f32x4 a, const f32x4 b) { u32x4 w; w.x = cvt_pk_bf16(a[0], a[1]); w.y = cvt_pk_bf16(a[2], a[3]); w.z = cvt_pk_bf16(b[0], b[1]); w.w = cvt_pk_bf16(b[2], b[3]); return w; }

struct EpiInProj {
    static constexpr bool PERM = true, AFTER_DRAIN = false;
    const float* r0; bf16_t* U; bf16_t* VR; bf16_t* QB; bf16_t* KB; bf16_t* VB; unsigned long long* vss; float* out; bool do_ss;
    __device__ __forceinline__ void operator()(const f32x4 (&acc)[2][2][4][2], const Unit& u, int wr, int wc, int fr, int fq) const {
        const int row0 = u.pm * BM + wr * 64 + fr, seg = u.pn >> 1, col0 = (u.pn & 1) * 256 + wc * 32 + 8 * fq;
        bf16_t* dstb = seg == 0 ? U : seg == 1 ? VR : seg == 2 ? QB : seg == 3 ? KB : VB;
        const bool prompt = u.pm < NP_ / BM;
        float* dstf = out + (prompt ? (seg == 3 ? OFF_KP : OFF_VP) : (seg == 3 ? OFF_KS : OFF_VS));
#pragma unroll
        for (int ai = 0; ai < 2; ++ai)
#pragma unroll
            for (int m = 0; m < 4; ++m) {
                const int row = row0 + ai * HALF + m * 16; const float r = r0[row]; float ssq = 0.f;
                const int orow = prompt ? row : row - NP_;
#pragma unroll
                for (int bj = 0; bj < 2; ++bj) {
                    f32x4 v0 = acc[ai][bj][m][0] * r, v1 = acc[ai][bj][m][1] * r; const int col = col0 + bj * HALF;
                    if (seg <= 1) {
#pragma unroll
                        for (int i = 0; i < 4; ++i) { v0[i] = gelu_t(v0[i]); v1[i] = gelu_t(v1[i]); }
                        if (seg == 1) ssq += (v0[0] * v0[0] + v0[1] * v0[1]) + (v0[2] * v0[2] + v0[3] * v0[3]) + (v1[0] * v1[0] + v1[1] * v1[1]) + (v1[2] * v1[2] + v1[3] * v1[3]);
                    } else if (seg == 2) { v0 = v0 * QSCALE; v1 = v1 * QSCALE; }
                    else { float* o = dstf + (size_t)orow * 512 + col; *(f32x4*)o = v0; *(f32x4*)(o + 4) = v1; }
                    *(u32x4*)(dstb + (size_t)row * 512 + col) = pack8(v0, v1);
                }
                if (seg == 1 && do_ss) { ssq = quad_sum(ssq); if (fq == 0) ss_add(vss + row, ssq); }
            }
    }
};
__device__ __forceinline__ void unpack8(const u32x4 w, f32x4& a, f32x4& b) { a[0] = __uint_as_float(w.x << 16); a[1] = __uint_as_float(w.x & 0xffff0000u); a[2] = __uint_as_float(w.y << 16); a[3] = __uint_as_float(w.y & 0xffff0000u);
    b[0] = __uint_as_float(w.z << 16); b[1] = __uint_as_float(w.z & 0xffff0000u); b[2] = __uint_as_float(w.w << 16); b[3] = __uint_as_float(w.w & 0xffff0000u); }
struct EpiResid {
    static constexpr bool PERM = true, AFTER_DRAIN = false;
    bf16_t* XB; float* X; bool wxb; unsigned long long* ss;
    __device__ __forceinline__ void operator()(const f32x4 (&acc)[2][2][4][2], const Unit& u, int wr, int wc, int fr, int fq) const {
        const int row0 = u.pm * BM + wr * 64 + fr, col0 = u.pn * BM + wc * 32 + 8 * fq;
#pragma unroll
        for (int ai = 0; ai < 2; ++ai)
#pragma unroll
            for (int m = 0; m < 4; ++m) {
                const int row = row0 + ai * HALF + m * 16; float ssq = 0.f;
#pragma unroll
                for (int bj = 0; bj < 2; ++bj) {
                    bf16_t* xb = XB + (size_t)row * 1024 + col0 + bj * HALF; f32x4 r0_, r1_; unpack8(*(const u32x4*)xb, r0_, r1_);
                    const f32x4 o0 = acc[ai][bj][m][0] + r0_, o1 = acc[ai][bj][m][1] + r1_;
                    if (X) { float* xo = X + (size_t)row * 1024 + col0 + bj * HALF; *(f32x4*)xo = o0; *(f32x4*)(xo + 4) = o1; }
                    if (wxb) *(u32x4*)xb = pack8(o0, o1);
                    ssq += (o0[0] * o0[0] + o0[1] * o0[1]) + (o0[2] * o0[2] + o0[3] * o0[3]) + (o1[0] * o1[0] + o1[1] * o1[1]) + (o1[2] * o1[2] + o1[3] * o1[3]);
                }
                ssq = quad_sum(ssq); if (fq == 0) ss_add(ss + row, ssq);
            }
    }
};
struct EpiSwiGLU {
    static constexpr bool PERM = true, AFTER_DRAIN = false;
    const unsigned long long* ss; bf16_t* ACT;
    __device__ __forceinline__ void operator()(const f32x4 (&acc)[2][2][4][2], const Unit& u, int wr, int wc, int fr, int fq) const {
        const int row0 = u.pm * BM + wr * 64 + fr, col0 = u.pn * HALF + wc * 32 + 8 * fq;
#pragma unroll
        for (int ai = 0; ai < 2; ++ai)
#pragma unroll
            for (int m = 0; m < 4; ++m) {
                const int row = row0 + ai * HALF + m * 16; const float r = ss_rinv(ss + row, 1.0f / 1024.0f);
                f32x4 a[2];
#pragma unroll
                for (int n = 0; n < 2; ++n) { const f32x4 g = acc[ai][0][m][n] * r, up = acc[ai][1][m][n] * r;
#pragma unroll
                    for (int i = 0; i < 4; ++i) a[n][i] = g[i] * sigm(g[i]) * up[i]; }
                *(u32x4*)(ACT + (size_t)row * 2816 + col0) = pack8(a[0], a[1]);
            }
    }
};
struct EpiGLU {
    static constexpr bool PERM = true, AFTER_DRAIN = false;
    const float* bglu; bf16_t* XB; unsigned long long* ss;
    __device__ __forceinline__ void operator()(const f32x4 (&acc)[2][2][4][2], const Unit& u, int wr, int wc, int fr, int fq) const {
        const int row0 = u.pm * BM + wr * 64 + fr, col0 = u.pn * HALF + wc * 32 + 8 * fq;
        f32x4 bv[2], bg[2];
#pragma unroll
        for (int n = 0; n < 2; ++n) { bv[n] = *(const f32x4*)(bglu + col0 + 4 * n); bg[n] = *(const f32x4*)(bglu + 1024 + col0 + 4 * n); }
#pragma unroll
        for (int ai = 0; ai < 2; ++ai)
#pragma unroll
            for (int m = 0; m < 4; ++m) {
                const int row = row0 + ai * HALF + m * 16; bf16_t* xb = XB + (size_t)row * 1024 + col0; f32x4 x[2], o[2]; float ssq = 0.f; unpack8(*(const u32x4*)xb, x[0], x[1]);
#pragma unroll
                for (int n = 0; n < 2; ++n) { const f32x4 zv = acc[ai][0][m][n] + bv[n], zg = acc[ai][1][m][n] + bg[n];
#pragma unroll
                    for (int i = 0; i < 4; ++i) { o[n][i] = x[n][i] + zv[i] * sigm(zg[i]); ssq += o[n][i] * o[n][i]; } }
                *(u32x4*)xb = pack8(o[0], o[1]);
                ssq = quad_sum(ssq); if (fq == 0) ss_add(ss + row, ssq);
            }
    }
};
struct EpiNull {
    static constexpr bool PERM = true, AFTER_DRAIN = false;
    float* X; int never;
    __device__ __forceinline__ void operator()(const f32x4 (&acc)[2][2][4][2], const Unit& u, int wr, int wc, int fr, int fq) const {
        if (never == 0x7fffffff) {
#pragma unroll
            for (int ai = 0; ai < 2; ++ai)
#pragma unroll
                for (int m = 0; m < 4; ++m)
#pragma unroll
                    for (int bj = 0; bj < 2; ++bj) { float* xo = X + (size_t)(u.pm * BM + wr * 64 + fr + ai * HALF + m * 16) * 1024 + (u.pn & 3) * BM + wc * 32 + 8 * fq + bj * HALF; *(f32x4*)xo = acc[ai][bj][m][0]; *(f32x4*)(xo + 4) = acc[ai][bj][m][1]; }
        }
    }
};
template <class Epi, class Sched, bool ALIGN_EPI = false, bool SP2 = false>
__device__ __forceinline__ void gemm_phase(PG8_LAS unsigned char* lds, const Gemm g, const Sched& S, const Epi& E) {
    int tid_ = threadIdx.x; asm volatile("" : "+v"(tid_));
    const int tid = tid_, wid = __builtin_amdgcn_readfirstlane(tid >> 6), lane = tid & 63, wr = wid >> 2, wc = wid & 3, fr = lane & 15, fq = lane >> 4;
    const int K = g.K, nt = K / BK;
    unsigned voffA[2], voffB[2];
#pragma unroll
    for (int i = 0; i < 2; ++i) { int R, C; stage_rc(tid * 16 + i * 8192, R, C); const int Rb = Epi::PERM ? ((R & ~31) + perm32(R & 31)) : R;
        voffA[i] = (unsigned)(R * K + C) * 2u; voffB[i] = (unsigned)(Rb * K + C) * 2u; }
    const size_t kstep = (size_t)(BK * 2);
    const size_t hstep = (size_t)HALF * K * 2;
    const size_t tstep = 2 * hstep;
    const unsigned ldsw = (unsigned)wid * 1024u;
    const int aoff = lds_byte(wr * 64 + fr, fq * 8), boff = lds_byte(wc * 32 + fr, fq * 8);
#define PG8_SA(b, h) (((b) * 2 + (h)) * HTB)
#define PG8_SB(b, h) ((4 + (b) * 2 + (h)) * HTB)
#define PG8_STAGE(bufoff, gbase, voff) do { _Pragma("unroll") for (int _i = 0; _i < 2; ++_i) \
        __builtin_amdgcn_global_load_lds((const unsigned*)((const char*)(gbase) + (voff)[_i]), (PG8_LAS unsigned*)(lds + (bufoff) + ldsw + _i * 8192), 16, 0, 0); } while (0)
#define PG8_LDA(dst, b, h) do { _Pragma("unroll") for (int m = 0; m < 4; ++m) _Pragma("unroll") for (int k = 0; k < 2; ++k) dst[m][k] = *(const PG8_LAS bf16x8*)(lds + PG8_SA(b, h) + aoff + m * 2048 + k * 1024); } while (0)
#define PG8_LDB(dst, b, h) do { _Pragma("unroll") for (int n = 0; n < 2; ++n) _Pragma("unroll") for (int k = 0; k < 2; ++k) dst[n][k] = *(const PG8_LAS bf16x8*)(lds + PG8_SB(b, h) + boff + n * 2048 + k * 1024); } while (0)
#define PG8_MMA(ai, bj, At, Bt) do { __builtin_amdgcn_s_setprio(1); _Pragma("unroll") for (int m = 0; m < 4; ++m) _Pragma("unroll") for (int n = 0; n < 2; ++n) _Pragma("unroll") for (int k = 0; k < 2; ++k) \
        acc[ai][bj][m][n] = __builtin_amdgcn_mfma_f32_16x16x32_bf16(Bt[n][k], At[m][k], acc[ai][bj][m][n], 0, 0, 0); __builtin_amdgcn_s_setprio(0); } while (0)
#define PG8_WAIT_V(n) asm volatile("s_waitcnt vmcnt(" #n ")" ::: "memory")
#define PG8_WAIT_L(n) asm volatile("s_waitcnt lgkmcnt(" #n ")" ::: "memory")
#define PG8_BAR __builtin_amdgcn_s_barrier()
#define PG8_SCHED __builtin_amdgcn_sched_barrier(0)
    Unit cur, nxt; int ui = 0;
    if (!S.next(0, cur)) return;
    f32x4 acc[2][2][4][2];
#pragma unroll
    for (int a = 0; a < 2; ++a)
#pragma unroll
        for (int b = 0; b < 2; ++b)
#pragma unroll
            for (int m = 0; m < 4; ++m)
#pragma unroll
                for (int n = 0; n < 2; ++n) acc[a][b][m][n] = (f32x4){0.f, 0.f, 0.f, 0.f};
    bf16x8 At[4][2], B0[2][2], B1[2][2];
    const char* cA = (const char*)g.A + (size_t)cur.pm * tstep; const char* cB = (const char*)g.Bt + (size_t)cur.pn * tstep;
    S.a_ready(cur);
    if constexpr (SP2) {
        PG8_STAGE(PG8_SB(0, 0), cB, voffB); PG8_STAGE(PG8_SB(0, 1), cB + hstep, voffB); PG8_STAGE(PG8_SA(0, 0), cA, voffA); PG8_STAGE(PG8_SA(0, 1), cA + hstep, voffA);
        if (wr == 1) PG8_BAR;
        PG8_WAIT_V(2); PG8_BAR;
        PG8_STAGE(PG8_SB(1, 0), cB + kstep, voffB); PG8_STAGE(PG8_SA(1, 0), cA + kstep, voffA); PG8_STAGE(PG8_SB(1, 1), cB + hstep + kstep, voffB);
        PG8_WAIT_V(6); PG8_BAR;
    } else {
        PG8_STAGE(PG8_SB(0, 0), cB, voffB); PG8_STAGE(PG8_SA(0, 0), cA, voffA); PG8_STAGE(PG8_SB(0, 1), cB + hstep, voffB); PG8_STAGE(PG8_SA(0, 1), cA + hstep, voffA);
        if (wr == 1) PG8_BAR;
        PG8_WAIT_V(4); PG8_BAR;
        PG8_STAGE(PG8_SB(1, 0), cB + kstep, voffB); PG8_STAGE(PG8_SA(1, 0), cA + kstep, voffA); PG8_STAGE(PG8_SB(1, 1), cB + hstep + kstep, voffB);
        PG8_WAIT_V(6); PG8_BAR;
    }
    for (;;) {
        const bool has_next = S.next(ui + 1, nxt);
        const char* nA = has_next ? (const char*)g.A + (size_t)nxt.pm * tstep : cA; const char* nB = has_next ? (const char*)g.Bt + (size_t)nxt.pn * tstep : cB;
        for (int t = 0; t < nt; t += 2) {
            const bool last = (t == nt - 2);
            const char* a1 = cA + (size_t)(t + 1) * kstep;
            const char* a2 = last ? nA : cA + (size_t)(t + 2) * kstep; const char* b2 = last ? nB : cB + (size_t)(t + 2) * kstep;
            const char* a3 = a2 + kstep; const char* b3 = b2 + kstep;
            if (last && has_next) S.a_ready(nxt);
            if constexpr (SP2) {
            PG8_LDB(B0, 0, 0); PG8_LDB(B1, 0, 1); PG8_SCHED; PG8_LDA(At, 0, 0); PG8_STAGE(PG8_SA(1, 1), a1 + hstep, voffA);
            PG8_WAIT_V(8); PG8_WAIT_L(0); PG8_BAR; PG8_MMA(0, 0, At, B0); PG8_MMA(0, 1, At, B1); PG8_BAR; PG8_SCHED;
            PG8_LDA(At, 0, 1); PG8_STAGE(PG8_SB(0, 0), b2, voffB); PG8_STAGE(PG8_SB(0, 1), b2 + hstep, voffB); PG8_STAGE(PG8_SA(0, 0), a2, voffA);
            PG8_WAIT_V(8); PG8_WAIT_L(0); PG8_BAR; PG8_MMA(1, 0, At, B0); PG8_MMA(1, 1, At, B1); PG8_BAR; PG8_SCHED;
            PG8_LDB(B0, 1, 0); PG8_LDB(B1, 1, 1); PG8_SCHED; PG8_LDA(At, 1, 0); PG8_STAGE(PG8_SA(0, 1), a2 + hstep, voffA);
            PG8_WAIT_V(8); PG8_WAIT_L(0); PG8_BAR; PG8_MMA(0, 0, At, B0); PG8_MMA(0, 1, At, B1); PG8_BAR; PG8_SCHED;
            PG8_LDA(At, 1, 1); PG8_STAGE(PG8_SB(1, 0), b3, voffB); PG8_STAGE(PG8_SB(1, 1), b3 + hstep, voffB); PG8_STAGE(PG8_SA(1, 0), a3, voffA);
            PG8_WAIT_V(8); PG8_WAIT_L(0); PG8_BAR; PG8_MMA(1, 0, At, B0); PG8_MMA(1, 1, At, B1); PG8_BAR; PG8_SCHED;
            } else {
            PG8_LDB(B0, 0, 0); PG8_SCHED; PG8_LDA(At, 0, 0); PG8_STAGE(PG8_SA(1, 1), a1 + hstep, voffA);
            PG8_WAIT_L(8); PG8_BAR; PG8_WAIT_L(0); PG8_MMA(0, 0, At, B0); PG8_BAR; PG8_SCHED;
            PG8_LDB(B1, 0, 1); PG8_STAGE(PG8_SB(0, 0), b2, voffB);
            PG8_BAR; PG8_WAIT_L(0); PG8_MMA(0, 1, At, B1); PG8_BAR;
            PG8_LDA(At, 0, 1); PG8_STAGE(PG8_SA(0, 0), a2, voffA);
            PG8_BAR; PG8_WAIT_L(0); PG8_MMA(1, 0, At, B0); PG8_BAR; PG8_SCHED;
            PG8_STAGE(PG8_SB(0, 1), b2 + hstep, voffB);
            PG8_WAIT_V(6); PG8_BAR; PG8_MMA(1, 1, At, B1); PG8_BAR;
            PG8_LDB(B0, 1, 0); PG8_SCHED; PG8_LDA(At, 1, 0); PG8_STAGE(PG8_SA(0, 1), a2 + hstep, voffA);
            PG8_WAIT_L(8); PG8_BAR; PG8_WAIT_L(0); PG8_MMA(0, 0, At, B0); PG8_BAR; PG8_SCHED;
            PG8_LDB(B1, 1, 1); PG8_STAGE(PG8_SB(1, 0), b3, voffB);
            PG8_BAR; PG8_WAIT_L(0); PG8_MMA(0, 1, At, B1); PG8_BAR;
            PG8_LDA(At, 1, 1); PG8_STAGE(PG8_SA(1, 0), a3, voffA);
            PG8_BAR; PG8_WAIT_L(0); PG8_MMA(1, 0, At, B0); PG8_BAR; PG8_SCHED;
            PG8_STAGE(PG8_SB(1, 1), b3 + hstep, voffB);
            PG8_WAIT_V(6); PG8_BAR; PG8_MMA(1, 1, At, B1); PG8_BAR;
            }
        }
        if constexpr (ALIGN_EPI) { if (wr == 0) PG8_BAR; }
        if constexpr (!Epi::AFTER_DRAIN) { E(acc, cur, wr, wc, fr, fq); S.done(cur); }
        if (!has_next) break;
#pragma unroll
        for (int a = 0; a < 2; ++a)
#pragma unroll
            for (int b = 0; b < 2; ++b)
#pragma unroll
                for (int m = 0; m < 4; ++m)
#pragma unroll
                    for (int n = 0; n < 2; ++n) acc[a][b][m][n] = (f32x4){0.f, 0.f, 0.f, 0.f};
        cur = nxt; cA = nA; cB = nB; ++ui;
        if constexpr (ALIGN_EPI) { if (wr == 1) PG8_BAR; }
    }
    PG8_WAIT_V(0);
    if constexpr (!ALIGN_EPI) { if (wr == 0) PG8_BAR; }
    PG8_BAR;
    if constexpr (Epi::AFTER_DRAIN) { E.fused(acc, cur, wr, wc, fr, fq, lds, wid, lane); S.done(cur); }
#undef PG8_SA
#undef PG8_SB
#undef PG8_STAGE
#undef PG8_LDA
#undef PG8_LDB
#undef PG8_MMA
#undef PG8_WAIT_V
#undef PG8_WAIT_L
#undef PG8_BAR
#undef PG8_SCHED
}
}
#define GAS __attribute__((address_space(1)))
#define LAS __attribute__((address_space(3)))
typedef unsigned short bf16;
typedef unsigned v4u __attribute__((ext_vector_type(4)));
typedef float f32x4 __attribute__((ext_vector_type(4)));
typedef short bf16x8 __attribute__((ext_vector_type(8)));
typedef GAS unsigned gu32;
typedef GAS unsigned long long gu64;
#define RLX_AGENT __ATOMIC_RELAXED, __HIP_MEMORY_SCOPE_AGENT
#define LDS_WAIT() asm volatile("s_waitcnt lgkmcnt(0)" ::: "memory")
#define VM_WAIT() asm volatile("s_waitcnt vmcnt(0)" ::: "memory")
__device__ __forceinline__ unsigned long long rt() { return __builtin_amdgcn_s_memrealtime(); }
__device__ __forceinline__ unsigned f2bf(float f) { unsigned u = __builtin_bit_cast(unsigned, f); return (u + 0x7fffu + ((u >> 16) & 1u)) >> 16; }
__device__ __forceinline__ unsigned pk2(float lo, float hi) { return f2bf(lo) | (f2bf(hi) << 16); }

#define XB_TMO      128
#define XB_XCNT(j)  (256  + 64 * (j))
#define XB_XSUB(j)  (1280 + 64 * (j))
#define XB_XGEN(j)  (2304 + 64 * (j))
#define XB_TOP      3328
#define XB_TOPGEN   3392
#define XCD_BAR_WORDS 3456
#define XB_SPIN_CAP (1u << 18)

__device__ __forceinline__ unsigned xb_ld(unsigned* p)              { return __hip_atomic_load(p, __ATOMIC_RELAXED, __HIP_MEMORY_SCOPE_AGENT); }
__device__ __forceinline__ unsigned xb_add(unsigned* p, unsigned v) { return __hip_atomic_fetch_add(p, v, __ATOMIC_RELAXED, __HIP_MEMORY_SCOPE_AGENT); }
__device__ __forceinline__ unsigned xb_xcc_id() { return (unsigned)__builtin_amdgcn_s_getreg((3 << 11) | 20) & 0xFu; }
#define XB_SPIN(cond, bar) do { unsigned _sp = 0; while (cond) { __builtin_amdgcn_s_sleep(1); \
    if ((++_sp & 255u) == 0u) { if (xb_ld(&(bar)[XB_TMO])) break; if (_sp > XB_SPIN_CAP) { atomicAdd(&(bar)[XB_TMO], 1u); break; } } } } while (0)

struct XcdBarrier {
    unsigned* bar; unsigned x;
    volatile LAS unsigned* st;
};

__device__ __forceinline__ XcdBarrier xcd_barrier_post(unsigned* bar, volatile LAS unsigned* st) {
    XcdBarrier b; b.bar = bar; b.x = xb_xcc_id(); b.st = st;
    if (threadIdx.x == 0) (void)xb_add(&bar[XB_XCNT(b.x)], 1u);
    return b;
}
__device__ __forceinline__ void xcd_barrier_complete(unsigned* bar, unsigned x, unsigned& nloc, unsigned& nx) {
    const unsigned G = gridDim.x * gridDim.y * gridDim.z;
    unsigned sum, cnt, mine, sp = 0u;
    for (;;) {
        sum = 0u; cnt = 0u; mine = 0u;
#pragma unroll
        for (unsigned j = 0; j < 16; ++j) { const unsigned c = xb_ld(&bar[XB_XCNT(j)]); sum += c; cnt += (c > 0u) ? 1u : 0u; mine = (j == x) ? c : mine; }
        if (sum == G) break;
        __builtin_amdgcn_s_sleep(1);
        if ((++sp & 255u) == 0u) { if (xb_ld(&bar[XB_TMO])) break; if (sp > XB_SPIN_CAP) { atomicAdd(&bar[XB_TMO], 1u); break; } }
    }
    nloc = mine > 0u ? mine : 1u; nx = cnt > 0u ? cnt : 1u;
}

__device__ __forceinline__ void xcd_barrier(const XcdBarrier& b) {
    asm volatile("s_waitcnt vmcnt(0)" ::: "memory");
    __syncthreads();
    if (threadIdx.x == 0) {
        unsigned* bar = b.bar;
        __builtin_amdgcn_s_waitcnt(0);
        unsigned nloc = b.st[0], nx = b.st[1];
        if (nloc == 0u) { xcd_barrier_complete(bar, b.x, nloc, nx); b.st[0] = nloc; b.st[1] = nx; }
        const unsigned old = xb_add(&bar[XB_XSUB(b.x)], 1u);
        const unsigned gen = old / nloc;
        if (old + 1u == (gen + 1u) * nloc) {
            __builtin_amdgcn_fence(__ATOMIC_RELEASE, "agent");
            asm volatile("s_waitcnt vmcnt(0)" ::: "memory");
            const unsigned og = xb_add(&bar[XB_TOP], 1u);
            const unsigned tg = og / nx;
            if (og + 1u == (tg + 1u) * nx) xb_add(&bar[XB_TOPGEN], 1u);
            else XB_SPIN(xb_ld(&bar[XB_TOPGEN]) == tg, bar);
            __builtin_amdgcn_fence(__ATOMIC_ACQUIRE, "agent");
            xb_add(&bar[XB_XGEN(b.x)], 1u);
            asm volatile("s_waitcnt vmcnt(0)" ::: "memory");
        } else {
            XB_SPIN(xb_ld(&bar[XB_XGEN(b.x)]) == gen, bar);
            __builtin_amdgcn_fence(__ATOMIC_ACQUIRE, "agent");
            asm volatile("s_waitcnt vmcnt(0)" ::: "memory");
        }
    }
    __syncthreads();
}
constexpr int NWAVES = 8;
constexpr int NP = 16384, NS = 256, NTOK = NP + NS, DM = 1024, DFF = 2816, SEQ = 4096;
constexpr float EPS = 1e-6f, LAM_INIT = 0.2f;
using pg8::OFF_YP; using pg8::OFF_CV; using pg8::OFF_SRP; using pg8::OFF_SIP; using pg8::OFF_SRS; using pg8::OFF_SIS; using pg8::OUT_TOTAL;
constexpr size_t MiB = 1u << 20;
constexpr size_t WS_CTL = 0, CTL_ZERO_BYTES = 2 * MiB;
constexpr int CW_BAR = 4096;
constexpr size_t WS_SS = 64 * 1024;
constexpr size_t WS_R0 = 2 * MiB;
constexpr size_t WS_PW1 = 2 * MiB + 128 * 1024, WS_PW16 = WS_PW1 + 32 * 1024;
constexpr size_t WS_BBAR = 2 * MiB + 256 * 1024;
constexpr size_t WS_WTRIL = 3 * MiB;
constexpr size_t WS_T = 4 * MiB, WS_E = 12 * MiB, WS_F = 16 * MiB;
constexpr size_t WS_W1 = 24 * MiB, WS_W2 = 29 * MiB, WS_W3 = 31 * MiB, WS_W4 = 42 * MiB, WS_W5 = 48 * MiB, WS_W6 = 52 * MiB, WS_W7 = 63 * MiB;
constexpr size_t WS_XB = 70 * MiB, WS_X = 104 * MiB, WS_U = 170 * MiB, WS_VR = 187 * MiB, WS_QB = 204 * MiB, WS_KB = 221 * MiB, WS_VB = 238 * MiB;
constexpr size_t WS_CB = 256 * MiB, WS_ACT = 290 * MiB, WS_PART = 380 * MiB, WS_END = 400 * MiB;
constexpr int PART_STRIDE = 32 + 16 * 128;
static_assert(WS_W7 + (size_t)1024 * 2816 * 2 <= WS_XB && WS_XB + (size_t)NTOK * 1024 * 2 <= WS_X && WS_X + (size_t)NTOK * 1024 * 4 <= WS_U && WS_VB + (size_t)NTOK * 512 * 2 <= WS_CB &&
              WS_CB + (size_t)NTOK * 1024 * 2 <= WS_ACT && WS_ACT + (size_t)NTOK * 2816 * 2 <= WS_PART && WS_PART + (size_t)32 * 4 * 16 * PART_STRIDE * 4 <= WS_END && WS_SS + 5 * (size_t)NTOK * 8 <= CTL_ZERO_BYTES, "d_ws map");
constexpr int RING_OFF = 0, SCRATCH_BYTES = 147456;
constexpr int LDSCTL_OFF = SCRATCH_BYTES, MISC_OFF = LDSCTL_OFF + 320;
constexpr int LDS_BYTES = SCRATCH_BYTES + 1024;

typedef short s16x4 __attribute__((ext_vector_type(4)));
typedef float f32x16 __attribute__((ext_vector_type(16)));
typedef float f32x2_t __attribute__((ext_vector_type(2))); typedef __bf16 bf16x2_t __attribute__((ext_vector_type(2)));
__device__ __forceinline__ unsigned cvtpk(float lo, float hi) { f32x2_t v = {lo, hi}; bf16x2_t b = __builtin_convertvector(v, bf16x2_t); return __builtin_bit_cast(unsigned, b); }
__device__ __forceinline__ float bf2f(unsigned short h) { return __uint_as_float((unsigned)h << 16); }
__device__ __forceinline__ float bflo(unsigned w) { return __uint_as_float(w << 16); }
__device__ __forceinline__ float bfhi(unsigned w) { return __uint_as_float(w & 0xffff0000u); }
__device__ __forceinline__ float ex2(float x) { return __builtin_amdgcn_exp2f(x); }
__device__ __forceinline__ float wave_sum(float v) {
#pragma unroll
    for (int o = 1; o < 64; o <<= 1) v += __shfl_xor(v, o);
    return v;
}
__device__ __forceinline__ f32x4 mfma16(bf16x8 a, bf16x8 b, f32x4 c) { return __builtin_amdgcn_mfma_f32_16x16x32_bf16(a, b, c, 0, 0, 0); }
__device__ __forceinline__ f32x16 mfma32(bf16x8 a, bf16x8 b, f32x16 c) { return __builtin_amdgcn_mfma_f32_32x32x16_bf16(a, b, c, 0, 0, 0); }
typedef short v4i16_t __attribute__((ext_vector_type(4)));
__device__ __forceinline__ bf16x8 tr_pair(const LAS unsigned char* p0, const LAS unsigned char* p1) {
    const s16x4 lo = __builtin_bit_cast(s16x4, __builtin_amdgcn_ds_read_tr16_b64_v4i16((LAS v4i16_t*)p0));
    const s16x4 hi = __builtin_bit_cast(s16x4, __builtin_amdgcn_ds_read_tr16_b64_v4i16((LAS v4i16_t*)p1));
    return (bf16x8){lo[0], lo[1], lo[2], lo[3], hi[0], hi[1], hi[2], hi[3]};
}
__device__ __forceinline__ bf16x8 pack_bf8(const f32x4 a, const f32x4 b) { v4u w; w.x = cvtpk(a[0], a[1]); w.y = cvtpk(a[2], a[3]); w.z = cvtpk(b[0], b[1]); w.w = cvtpk(b[2], b[3]); return __builtin_bit_cast(bf16x8, w); }
__device__ __forceinline__ float xmax4(float v) {
    auto a = __builtin_amdgcn_permlane16_swap(__float_as_uint(v), __float_as_uint(v), false, false); v = fmaxf(__uint_as_float(a[0]), __uint_as_float(a[1]));
    auto b = __builtin_amdgcn_permlane32_swap(__float_as_uint(v), __float_as_uint(v), false, false); return fmaxf(__uint_as_float(b[0]), __uint_as_float(b[1])); }
__device__ __forceinline__ float xsum4(float v) {
    auto a = __builtin_amdgcn_permlane16_swap(__float_as_uint(v), __float_as_uint(v), false, false); v = __uint_as_float(a[0]) + __uint_as_float(a[1]);
    auto b = __builtin_amdgcn_permlane32_swap(__float_as_uint(v), __float_as_uint(v), false, false); return __uint_as_float(b[0]) + __uint_as_float(b[1]); }
using pg8::ss_rinv; using pg8::gelu_t;

struct Frame {
    LAS unsigned char* lds;
    volatile LAS unsigned* MISC;
    gu32* ctl;
    int tid, lane, wave, vcu, G;
    const float* const* in; float* out; unsigned char* ws;
};
enum { I_XP = 0, I_XS, I_CK, I_CV, I_PT, I_SRE, I_SIM, I_NMIX, I_NFFN, I_NFIN, I_WIN, I_WOUT, I_SGN, I_SGW, I_SGB, I_LQ1, I_LK1, I_LQ2, I_LK2, I_SUBLN,
       I_ARE, I_AIM, I_LDT, I_BRE, I_BIM, I_CRE, I_CIM, I_SD, I_WGLU, I_BGLU, I_WFI, I_WFO };

#define LAUNDER_TID() int tid = F.tid; asm volatile("" : "+v"(tid)); const int lane = tid & 63, wave = __builtin_amdgcn_readfirstlane(tid >> 6); (void)lane; (void)wave
__device__ __forceinline__ int map_row(int n0, int NH) { if (NH == 0) return n0; const int hi = n0 >= NH ? 1 : 0, n2 = n0 - hi * NH; return 256 * (n2 >> 7) + 128 * hi + (n2 & 127); }
__device__ __forceinline__ void p0_transpose_item(const float* W, int K, int N, bf16* WT, int NH, const float* gain, LAS float* scr, int item, int lane) {
    const int nblk = N / 64, kb = item / nblk, nb = item % nblk, k0 = 64 * kb, n0 = 64 * nb, kq = lane >> 4, nq = 4 * (lane & 15);
    f32x4 v[16];
#pragma unroll
    for (int i = 0; i < 16; ++i) v[i] = *(const f32x4*)(W + (size_t)(k0 + 4 * i + kq) * N + n0 + nq);
#pragma unroll
    for (int i = 0; i < 16; ++i) { const int kk = 4 * i + kq; const float gs = gain ? gain[k0 + kk] : 1.0f; LAS float* d = scr + kk * 65 + nq; d[0] = v[i][0] * gs; d[1] = v[i][1] * gs; d[2] = v[i][2] * gs; d[3] = v[i][3] * gs; }
    LDS_WAIT(); asm volatile("" ::: "memory");
    const int c = lane & 7, r0 = map_row(n0, NH);
#pragma unroll
    for (int j = 0; j < 8; ++j) { const int n = (lane >> 3) + 8 * j; const LAS float* s = scr + (8 * c) * 65 + n;
        v4u o; o.x = pk2(s[0 * 65], s[1 * 65]); o.y = pk2(s[2 * 65], s[3 * 65]); o.z = pk2(s[4 * 65], s[5 * 65]); o.w = pk2(s[6 * 65], s[7 * 65]);
        *(GAS v4u*)(WT + (size_t)(r0 + n) * K + k0 + 8 * c) = o; }
    LDS_WAIT(); asm volatile("" ::: "memory");
}
__device__ __forceinline__ void p0_row2(int lane, const float* xrow0, const float* xrow1, bf16* orow0, float* r) {
    const GAS f32x4* xa = (const GAS f32x4*)xrow0 + lane; const GAS f32x4* xb = (const GAS f32x4*)xrow1 + lane;
    f32x4 v[4], w[4]; float s = 0.f, t = 0.f;
#pragma unroll
    for (int j = 0; j < 4; ++j) { v[j] = xa[64 * j]; w[j] = xb[64 * j]; }
#pragma unroll
    for (int j = 0; j < 4; ++j) { s += (v[j].x * v[j].x + v[j].y * v[j].y) + (v[j].z * v[j].z + v[j].w * v[j].w); t += (w[j].x * w[j].x + w[j].y * w[j].y) + (w[j].z * w[j].z + w[j].w * w[j].w); }
    GAS unsigned long long* o8 = (GAS unsigned long long*)orow0 + lane;
#pragma unroll
    for (int j = 0; j < 4; ++j) { o8[64 * j] = (unsigned long long)pk2(v[j].x, v[j].y) | ((unsigned long long)pk2(v[j].z, v[j].w) << 32); o8[256 + 64 * j] = (unsigned long long)pk2(w[j].x, w[j].y) | ((unsigned long long)pk2(w[j].z, w[j].w) << 32); }
    s = wave_sum(s); t = wave_sum(t);
    if (lane == 0) { r[0] = 1.0f / sqrtf(s * (1.0f / 1024.0f) + EPS); r[1] = 1.0f / sqrtf(t * (1.0f / 1024.0f) + EPS); }
}
__device__ __forceinline__ void p0_ssm_tables(Frame& F, int g) {
    LAS f32x2_t* pw = (LAS f32x2_t*)(F.lds);
    LAS f32x2_t* cb = pw + 17 * 64;
    LAS f32x2_t* cc = cb + 64 * 16;
    LAS float* KJ = (LAS float*)(cc + 16 * 64);
    LAS f32x2_t* cf = (LAS f32x2_t*)(KJ + 4096);
    LAUNDER_TID();
    const float* a_re = F.in[I_ARE] + g * 64; const float* a_im = F.in[I_AIM] + g * 64;
    const float dt = expf(F.in[I_LDT][g]);
    {   const int p = tid & 63, jj = tid >> 6; const float ar = a_re[p], ai = a_im[p], xr = ar * dt, xi = ai * dt;
        for (int j = jj; j <= 16; j += 8) { const float mag = expf((float)j * xr), ang = (float)j * xi; pw[j * 64 + p] = (f32x2_t){mag * cosf(ang), mag * sinf(ang)}; }
        if (jj == 1) {
            const float sh = sinf(0.5f * xi), nr = expm1f(xr) * cosf(xi) - 2.0f * sh * sh, ni = expf(xr) * sinf(xi), den = 1.0f / (ar * ar + ai * ai);
            cf[p] = (f32x2_t){(nr * ar + ni * ai) * den, (ni * ar - nr * ai) * den}; }
    }
    __syncthreads();
    const float* b_re = F.in[I_BRE] + (size_t)g * 1024; const float* b_im = F.in[I_BIM] + (size_t)g * 1024;
    const float* c_re = F.in[I_CRE] + (size_t)g * 1024; const float* c_im = F.in[I_CIM] + (size_t)g * 1024;
    for (int i = tid; i < 1024; i += 512) {
        const int p = i >> 4; const f32x2_t c = cf[p]; const float br = b_re[i], bi = b_im[i];
        cb[i] = (f32x2_t){c.x * br - c.y * bi, c.x * bi + c.y * br};
        cc[i] = (f32x2_t){c_re[i], c_im[i]};
    }
    __syncthreads();
    const float* dsk = F.in[I_SD] + g * 16;
    {
        const int j = tid >> 5, c2 = (tid >> 1) & 15, ph = tid & 1; float sacc[16];
#pragma unroll
        for (int c = 0; c < 16; ++c) sacc[c] = 0.f;
#pragma unroll 2
        for (int pp = 0; pp < 32; ++pp) { const int p = 32 * ph + pp; const f32x2_t a = pw[j * 64 + p], b = cb[p * 16 + c2]; const float wr_ = a.x * b.x - a.y * b.y, wi_ = a.x * b.y + a.y * b.x;
#pragma unroll
            for (int c = 0; c < 16; ++c) { const f32x2_t cv = cc[c * 64 + p]; sacc[c] += cv.x * wr_ - cv.y * wi_; } }
#pragma unroll
        for (int c = 0; c < 16; ++c) sacc[c] += __shfl_xor(sacc[c], 1);
        if (ph == 0) {
#pragma unroll
            for (int c = 0; c < 16; ++c) KJ[(j * 16 + c) * 16 + c2] = sacc[c] + ((j == 0 && c == c2) ? dsk[c] : 0.f); }
    }
    __syncthreads();
    const float* g1 = F.in[I_NMIX] + 1024 + g * 16;
    bf16* Tg = (bf16*)(F.ws + WS_T) + (size_t)g * 65536; bf16* Eg = (bf16*)(F.ws + WS_E) + (size_t)g * 32768; bf16* Fg = (bf16*)(F.ws + WS_F) + (size_t)g * 32768;
#pragma unroll 1
    for (int q = 0; q < 4; ++q) {
#pragma unroll 1
    for (int i = 0; i < 4; ++i) { const int idx = tid + 512 * i, row = 64 * q + (idx >> 5), kc = idx & 31, t = row >> 4, c = row & 15, tau = kc >> 1, c0 = 8 * (kc & 1);
        float v[8];
#pragma unroll
        for (int e = 0; e < 8; ++e) v[e] = (t >= tau) ? KJ[((t - tau) * 16 + c) * 16 + c0 + e] * g1[c0 + e] : 0.f;
        v4u o; o.x = pk2(v[0], v[1]); o.y = pk2(v[2], v[3]); o.z = pk2(v[4], v[5]); o.w = pk2(v[6], v[7]);
        *(GAS v4u*)(Tg + (size_t)row * 256 + kc * 8) = o; }
#pragma unroll 1
    for (int i = 0; i < 2; ++i) { const int idx = tid + 512 * i, row = 32 * q + (idx >> 5), kc = idx & 31, ri = row >> 6, p = row & 63, tau = kc >> 1, c0 = 8 * (kc & 1);
        const f32x2_t a = pw[(15 - tau) * 64 + p]; float v[8];
#pragma unroll
        for (int e = 0; e < 8; ++e) { const f32x2_t b = cb[p * 16 + c0 + e]; const float zr = a.x * b.x - a.y * b.y, zi = a.x * b.y + a.y * b.x; v[e] = (ri ? zi : zr) * g1[c0 + e]; }
        v4u o; o.x = pk2(v[0], v[1]); o.y = pk2(v[2], v[3]); o.z = pk2(v[4], v[5]); o.w = pk2(v[6], v[7]);
        *(GAS v4u*)(Eg + (size_t)row * 256 + kc * 8) = o; }
#pragma unroll 1
    for (int i = 0; i < 2; ++i) { const int idx = tid + 512 * i, row = 64 * q + (idx >> 4), kc = idx & 15, t = row >> 4, c = row & 15, ri = kc >> 3, p0 = 8 * (kc & 7);
        float v[8];
#pragma unroll
        for (int e = 0; e < 8; ++e) { const f32x2_t a = pw[(t + 1) * 64 + p0 + e], cv = cc[c * 64 + p0 + e]; const float zr = cv.x * a.x - cv.y * a.y, zi = cv.x * a.y + cv.y * a.x; v[e] = ri ? -zi : zr; }
        v4u o; o.x = pk2(v[0], v[1]); o.y = pk2(v[2], v[3]); o.z = pk2(v[4], v[5]); o.w = pk2(v[6], v[7]);
        *(GAS v4u*)(Fg + (size_t)row * 128 + kc * 8) = o; }
    }
    {
        f32x2_t* PW1 = (f32x2_t*)(F.ws + WS_PW1) + g * 64; f32x2_t* PW16 = (f32x2_t*)(F.ws + WS_PW16) + g * 64; f32x2_t* BB = (f32x2_t*)(F.ws + WS_BBAR) + (size_t)g * 1024;
        if (tid < 64) { PW1[tid] = pw[64 + tid]; PW16[tid] = pw[16 * 64 + tid]; }
        for (int i = tid; i < 1024; i += 512) BB[i] = cb[i];
    }
    __syncthreads();
}
constexpr int PI1 = 16 * (2560 / 64), PI2 = 16 * (1024 / 64), PI5 = 16 * (2048 / 64), PI3 = 16 * (5632 / 64), PI4 = 44 * (1024 / 64);
__device__ __forceinline__ void p0_prologue(Frame& F) {
    LAUNDER_TID();
    const int gw = F.vcu * NWAVES + wave, NGW = F.G * NWAVES;
    LAS float* scr = (LAS float*)(F.lds + RING_OFF + wave * 18432);
    for (int it = gw; it < PI1; it += NGW) p0_transpose_item(F.in[I_WIN], 1024, 2560, (bf16*)(F.ws + WS_W1), 0, F.in[I_NMIX], scr, it, lane);
    bf16* XB = (bf16*)(F.ws + WS_XB); float* R0 = (float*)(F.ws + WS_R0);
    for (int m = 2 * gw; m < NTOK; m += 2 * NGW) { const float* x0 = m < NP ? F.in[I_XP] + (size_t)m * 1024 : F.in[I_XS] + (size_t)(m - NP) * 1024; p0_row2(lane, x0, x0 + 1024, XB + (size_t)m * 1024, R0 + m); }
    bf16* WT = (bf16*)(F.ws + WS_WTRIL); const float* sw = F.in[I_SGW];
    for (int i = gw * 64 + lane; i < 8192; i += NGW * 64) { const int e0 = i * 8, t = (e0 >> 7) & 127, s0 = e0 & 127; float v[8];
#pragma unroll
        for (int e = 0; e < 8; ++e) v[e] = (s0 + e <= t) ? sw[e0 + e] : 0.f;
        v4u o; o.x = pk2(v[0], v[1]); o.y = pk2(v[2], v[3]); o.z = pk2(v[4], v[5]); o.w = pk2(v[6], v[7]); *(GAS v4u*)(WT + e0) = o; }
}
__device__ __forceinline__ void p0_late_weights(Frame& F, int part, int j, int nj) {
    LAUNDER_TID();
    const int gw = j * NWAVES + wave, NGW = nj * NWAVES;
    LAS float* scr = (LAS float*)(F.lds + RING_OFF + wave * 18432);
    if (part == 0) {
        for (int it = gw; it < PI2 + PI3 + PI4; it += NGW) {
            int r = it;
            if (r < PI2) { p0_transpose_item(F.in[I_WOUT], 1024, 1024, (bf16*)(F.ws + WS_W2), 0, nullptr, scr, r, lane); continue; } r -= PI2;
            if (r < PI3) { p0_transpose_item(F.in[I_WFI], 1024, 5632, (bf16*)(F.ws + WS_W3), 2816, F.in[I_NFFN], scr, r, lane); continue; } r -= PI3;
            p0_transpose_item(F.in[I_WFO], 2816, 1024, (bf16*)(F.ws + WS_W4), 0, nullptr, scr, r, lane);
        }
    } else {
        for (int it = gw; it < PI5 + PI3 + PI4; it += NGW) {
            int r = it;
            if (r < PI5) { p0_transpose_item(F.in[I_WGLU], 1024, 2048, (bf16*)(F.ws + WS_W5), 1024, nullptr, scr, r, lane); continue; } r -= PI5;
            if (r < PI3) { p0_transpose_item(F.in[I_WFI] + (size_t)1024 * 5632, 1024, 5632, (bf16*)(F.ws + WS_W6), 2816, F.in[I_NFFN] + 1024, scr, r, lane); continue; } r -= PI3;
            p0_transpose_item(F.in[I_WFO] + (size_t)2816 * 1024, 2816, 1024, (bf16*)(F.ws + WS_W7), 0, nullptr, scr, r, lane);
        }
    }
}
__device__ __forceinline__ float lambda_val(Frame& F) {
    LAUNDER_TID(); const int l = lane; const float a = wave_sum(F.in[I_LQ1][l] * F.in[I_LK1][l]), b = wave_sum(F.in[I_LQ2][l] * F.in[I_LK2][l]);
    return expf(a) - expf(b) + LAM_INIT;
}
__device__ __forceinline__ void sgu_prompt_unit(Frame& F, int chunk, int g) {
    LAUNDER_TID();
    const bf16* U = (const bf16*)(F.ws + WS_U); const bf16* VR = (const bf16*)(F.ws + WS_VR); bf16* CB = (bf16*)(F.ws + WS_CB);
    const unsigned long long* vss = (const unsigned long long*)(F.ws + WS_SS);
    const bf16* WT = (const bf16*)(F.ws + WS_WTRIL) + (size_t)g * 16384;
    const float* gn = F.in[I_SGN] + g * 128; const float* bias = F.in[I_SGB] + g * 128;
    LAS unsigned short* vT = (LAS unsigned short*)F.lds;
    const size_t tok0 = (size_t)chunk * 128;
    {
        const int s = tid >> 2, c0 = 32 * (tid & 3); const float rv = ss_rinv(vss + tok0 + s, 1.0f / 512.0f);
        const v4u* src = (const v4u*)(VR + (tok0 + s) * 512 + g * 128 + c0);
#pragma unroll
        for (int i = 0; i < 4; ++i) { const v4u w = src[i]; const unsigned ww[4] = {w.x, w.y, w.z, w.w};
#pragma unroll
            for (int e = 0; e < 4; ++e) { const int c = c0 + 8 * i + 2 * e; const float a = bflo(ww[e]) * rv * gn[c], b = bfhi(ww[e]) * rv * gn[c + 1];
                vT[c * 136 + s] = (unsigned short)f2bf(a); vT[(c + 1) * 136 + s] = (unsigned short)f2bf(b); } }
    }
    __syncthreads();
    const int mb = wave & 3, nh = wave >> 2, r32 = lane & 31, hi = lane >> 5;
    f32x16 acc[2]; acc[0] = (f32x16){}; acc[1] = (f32x16){};
    for (int ks = 0; ks < 2 * mb + 2; ++ks) {
        const bf16x8 a = *(const bf16x8*)(WT + (32 * mb + r32) * 128 + 16 * ks + 8 * hi);
#pragma unroll
        for (int j = 0; j < 2; ++j) { const bf16x8 b = *(const LAS bf16x8*)((const LAS unsigned char*)vT + ((64 * nh + 32 * j + r32) * 136 + 16 * ks + 8 * hi) * 2); acc[j] = mfma32(a, b, acc[j]); }
    }
#pragma unroll
    for (int j = 0; j < 2; ++j) { const int d = g * 128 + 64 * nh + 32 * j + r32;
#pragma unroll
        for (int r = 0; r < 16; ++r) { const int t = 32 * mb + (r & 3) + 8 * (r >> 2) + 4 * hi; const size_t o = (tok0 + t) * 512 + d;
            const float val = bf2f(U[o]) * (acc[j][r] + bias[t]); CB[(tok0 + t) * 1024 + d] = (bf16)f2bf(val); } }
    __syncthreads();
}
__device__ __forceinline__ void sgu_sample_unit(Frame& F, int b) {
    LAUNDER_TID(); const int c = tid, g = c >> 7; const bf16* U = (const bf16*)(F.ws + WS_U); const bf16* VR = (const bf16*)(F.ws + WS_VR); bf16* CB = (bf16*)(F.ws + WS_CB);
    const unsigned long long* vss = (const unsigned long long*)(F.ws + WS_SS);
    const float gn = F.in[I_SGN][c]; const float* W = F.in[I_SGW] + (size_t)g * 16384; const float* bias = F.in[I_SGB] + g * 128;
    float v[8];
#pragma unroll
    for (int t = 0; t < 8; ++t) { const size_t tok = NP + 8 * b + t; v[t] = bf2f(VR[tok * 512 + c]) * ss_rinv(vss + tok, 1.0f / 512.0f) * gn; F.out[OFF_CV + (size_t)(8 * b + t) * 512 + c] = v[t]; }
#pragma unroll
    for (int t = 0; t < 8; ++t) { float s = bias[t];
#pragma unroll
        for (int k = 0; k <= t; ++k) s += W[t * 128 + k] * v[k];
        const size_t tok = NP + 8 * b + t; CB[tok * 1024 + c] = (bf16)f2bf(bf2f(U[tok * 512 + c]) * s); }
}

struct Soft16 { float m, l; };
__device__ __forceinline__ void smax_update(f32x4 (&s)[4], Soft16& st, f32x4 (&O)[8], bf16x8& pf0, bf16x8& pf1) {
    float mx = fmaxf(fmaxf(s[0][0], s[0][1]), fmaxf(s[0][2], s[0][3]));
#pragma unroll
    for (int i = 1; i < 4; ++i) mx = fmaxf(mx, fmaxf(fmaxf(s[i][0], s[i][1]), fmaxf(s[i][2], s[i][3])));
    mx = xmax4(mx);
    const float mn = fmaxf(st.m, mx), al = ex2(st.m - mn); st.m = mn; float sum = 0.f;
#pragma unroll
    for (int i = 0; i < 4; ++i)
#pragma unroll
        for (int r = 0; r < 4; ++r) { s[i][r] = ex2(s[i][r] - mn); sum += s[i][r]; }
    st.l = st.l * al + sum;
    if (__any(al != 1.0f)) {
#pragma unroll
        for (int nb = 0; nb < 8; ++nb) O[nb] = O[nb] * al; }
    pf0 = pack_bf8(s[0], s[1]); pf1 = pack_bf8(s[2], s[3]);
}
__device__ __forceinline__ void attn_prompt_unit(Frame& F, float lam, int b, int h, int qb) {
    LAUNDER_TID(); const int g = lane >> 4, li = lane & 15;
    const bf16* QB = (const bf16*)(F.ws + WS_QB); const bf16* KB = (const bf16*)(F.ws + WS_KB); const bf16* VB = (const bf16*)(F.ws + WS_VB); bf16* CB = (bf16*)(F.ws + WS_CB);
    const size_t rowbase = (size_t)b * SEQ; const int qrel = 16 * wave + li; const size_t qtok = rowbase + 128 * qb + qrel;
    bf16x8 qf[4];
#pragma unroll
    for (int s = 0; s < 4; ++s) qf[s] = *(const bf16x8*)(QB + qtok * 512 + h * 128 + 32 * s + 8 * g);
    const int nt = 2 * qb + 2;
    const int skey = tid >> 4, sch = tid & 15;
    const bf16* kg = KB + (rowbase + skey) * 512 + h * 128 + 8 * sch; const bf16* vg = VB + (rowbase + skey) * 512 + h * 128 + 8 * sch;
    const int kw0 = skey * 256 + ((sch ^ (skey & 15)) << 4), vw0 = skey * 256 + (((sch >> 1) ^ (skey & 7)) << 5) + (sch & 1) * 16;
    LAS unsigned char* L = F.lds;
    int kad[4];
#pragma unroll
    for (int s = 0; s < 4; ++s) kad[s] = li * 256 + (((4 * s + g) ^ li) << 4);
    const int vq = li >> 2, vp = li & 3, vk7 = (4 * g + vq) & 7; int vad[8];
#pragma unroll
    for (int nb = 0; nb < 8; ++nb) vad[nb] = (4 * g + vq) * 256 + ((nb ^ vk7) << 5) + 8 * vp;
    f32x4 O1[8], O2[8]; Soft16 st1{-1e30f, 0.f}, st2{-1e30f, 0.f};
#pragma unroll
    for (int nb = 0; nb < 8; ++nb) { O1[nb] = (f32x4){0.f, 0.f, 0.f, 0.f}; O2[nb] = (f32x4){0.f, 0.f, 0.f, 0.f}; }
    v4u kr0, kr1, vr0, vr1;
    kr0 = *(const v4u*)kg; kr1 = *(const v4u*)(kg + 32 * 512); vr0 = *(const v4u*)vg; vr1 = *(const v4u*)(vg + 32 * 512);
    *(LAS v4u*)(L + kw0) = kr0; *(LAS v4u*)(L + kw0 + 32 * 256) = kr1; *(LAS v4u*)(L + 16384 + vw0) = vr0; *(LAS v4u*)(L + 16384 + vw0 + 32 * 256) = vr1;
    __syncthreads();
    for (int t = 0; t < nt; ++t) {
        const int bo = (t & 1) * 32768;
        if (t + 1 < nt) { const size_t go = (size_t)(t + 1) * 64 * 512; kr0 = *(const v4u*)(kg + go); kr1 = *(const v4u*)(kg + go + 32 * 512); vr0 = *(const v4u*)(vg + go); vr1 = *(const v4u*)(vg + go + 32 * 512); }
        if (!(t == nt - 1 && wave < 4)) {
            const LAS unsigned char* Kt = L + bo; const LAS unsigned char* Vt = L + bo + 16384;
            f32x4 s1[4], s2[4];
            {   bf16x8 kf[4][4];
#pragma unroll
                for (int sub = 0; sub < 4; ++sub)
#pragma unroll
                    for (int ks = 0; ks < 4; ++ks) kf[sub][ks] = *(const LAS bf16x8*)(Kt + sub * 4096 + kad[ks]);
#pragma unroll
                for (int sub = 0; sub < 4; ++sub) { s1[sub] = mfma16(kf[sub][0], qf[0], (f32x4){0.f, 0.f, 0.f, 0.f}); s2[sub] = mfma16(kf[sub][2], qf[2], (f32x4){0.f, 0.f, 0.f, 0.f}); }
#pragma unroll
                for (int sub = 0; sub < 4; ++sub) { s1[sub] = mfma16(kf[sub][1], qf[1], s1[sub]); s2[sub] = mfma16(kf[sub][3], qf[3], s2[sub]); }
            }
            bf16x8 va[8], vb[8];
#pragma unroll
            for (int nb = 0; nb < 8; ++nb) { va[nb] = tr_pair(Vt + vad[nb], Vt + vad[nb] + 16 * 256); vb[nb] = tr_pair(Vt + vad[nb] + 32 * 256, Vt + vad[nb] + 48 * 256); }
            if (t >= nt - 2) {
                const int kb0 = 64 * (t - 2 * qb) + 4 * g;
#pragma unroll
                for (int sub = 0; sub < 4; ++sub)
#pragma unroll
                    for (int r = 0; r < 4; ++r) if (kb0 + 16 * sub + r > qrel) { s1[sub][r] = -__builtin_inff(); s2[sub][r] = -__builtin_inff(); }
            }
            bf16x8 p1a, p1b, p2a, p2b;
            smax_update(s1, st1, O1, p1a, p1b); smax_update(s2, st2, O2, p2a, p2b);
#pragma unroll
            for (int nb = 0; nb < 8; ++nb) { O1[nb] = mfma16(va[nb], p1a, O1[nb]); O2[nb] = mfma16(va[nb], p2a, O2[nb]); }
#pragma unroll
            for (int nb = 0; nb < 8; ++nb) { O1[nb] = mfma16(vb[nb], p1b, O1[nb]); O2[nb] = mfma16(vb[nb], p2b, O2[nb]); }
        }
        if (t + 1 < nt) { const int wo = ((t + 1) & 1) * 32768; *(LAS v4u*)(L + wo + kw0) = kr0; *(LAS v4u*)(L + wo + kw0 + 32 * 256) = kr1; *(LAS v4u*)(L + wo + 16384 + vw0) = vr0; *(LAS v4u*)(L + wo + 16384 + vw0 + 32 * 256) = vr1; }
        __syncthreads();
    }
    const float l1 = xsum4(st1.l), l2 = xsum4(st2.l);
    const float i1 = 1.0f / l1, i2 = lam / l2; float ssq = 0.f;
#pragma unroll
    for (int nb = 0; nb < 8; ++nb)
#pragma unroll
        for (int r = 0; r < 4; ++r) { const float o = O1[nb][r] * i1 - O2[nb][r] * i2; O1[nb][r] = o; ssq += o * o; }
    ssq = xsum4(ssq);
    const float rn = (1.0f - LAM_INIT) / sqrtf(ssq * (1.0f / 128.0f) + EPS);
    const float* sub = F.in[I_SUBLN];
#pragma unroll
    for (int nb = 0; nb < 8; ++nb) { const int dv = 16 * nb + 4 * g; const f32x4 sg = *(const f32x4*)(sub + dv);
        const unsigned w0 = cvtpk(O1[nb][0] * rn * sg[0], O1[nb][1] * rn * sg[1]), w1 = cvtpk(O1[nb][2] * rn * sg[2], O1[nb][3] * rn * sg[3]);
        *(unsigned long long*)(CB + qtok * 1024 + 512 + h * 128 + dv) = (unsigned long long)w0 | ((unsigned long long)w1 << 32); }
}

__device__ __forceinline__ void attn_sample_unit(Frame& F, int b, int rg) {
    LAUNDER_TID(); const int g = lane >> 4, li = lane & 15, head = wave & 3, hf = wave >> 2;
    const bf16* QB = (const bf16*)(F.ws + WS_QB); const float* CK = F.in[I_CK]; const float* CV = F.in[I_CV]; const int* PT = (const int*)F.in[I_PT] + b * 64 + 8 * rg + 4 * hf;
    bf16x8 qf[4];
    { const int qi = li & 7, half = li >> 3; const bf16* qrow = QB + (size_t)(NP + 8 * b + qi) * 512 + head * 128;
#pragma unroll
      for (int s = 0; s < 4; ++s) { bf16x8 z = (bf16x8){0, 0, 0, 0, 0, 0, 0, 0}; if ((s >> 1) == half) z = *(const bf16x8*)(qrow + 32 * s + 8 * g); qf[s] = z; } }
    LAS unsigned char* Kt = F.lds + wave * 16384; LAS unsigned char* Vt = Kt + 8192;
    const int l31 = lane & 31, lh = lane >> 5;
    const int kwr = ((l31 >> 1) << 4) + (l31 & 1) * 8;
    const int vwu = l31 >> 2, vwo = (l31 & 3) * 8;
    int kad[4];
#pragma unroll
    for (int s = 0; s < 4; ++s) kad[s] = li * 256 + (((4 * s + g) ^ li) << 4);
    const int vq = li >> 2, vp = li & 3, vk7 = (4 * g + vq) & 7; int vad[8];
#pragma unroll
    for (int nb = 0; nb < 8; ++nb) vad[nb] = (4 * g + vq) * 256 + ((nb ^ vk7) << 5) + 8 * vp;
    f32x4 O[8]; Soft16 st{-1e30f, 0.f};
#pragma unroll
    for (int nb = 0; nb < 8; ++nb) O[nb] = (f32x4){0.f, 0.f, 0.f, 0.f};
    f32x4 kr[16], vr[16];
#define SLOAD(t) do { const int phys_ = __builtin_amdgcn_readfirstlane(PT[(t) >> 2]); const size_t e0_ = (((size_t)phys_ * 128 + 32 * ((t) & 3) + lh) * 4 + head) * 128 + 4 * l31; \
        _Pragma("unroll") for (int i_ = 0; i_ < 16; ++i_) { kr[i_] = __builtin_nontemporal_load((const f32x4*)(CK + e0_ + (size_t)i_ * 1024)); vr[i_] = __builtin_nontemporal_load((const f32x4*)(CV + e0_ + (size_t)i_ * 1024)); } } while (0)
    SLOAD(0);
#pragma unroll 1
    for (int t = 0; t < 16; ++t) {
#pragma unroll
        for (int i = 0; i < 16; ++i) { const int key = 2 * i + lh;
            *(LAS unsigned long long*)(Kt + key * 256 + (kwr ^ ((key & 15) << 4))) = (unsigned long long)cvtpk(kr[i][0], kr[i][1]) | ((unsigned long long)cvtpk(kr[i][2], kr[i][3]) << 32);
            *(LAS unsigned long long*)(Vt + key * 256 + ((vwu ^ (key & 7)) << 5) + vwo) = (unsigned long long)cvtpk(vr[i][0], vr[i][1]) | ((unsigned long long)cvtpk(vr[i][2], vr[i][3]) << 32); }
        if (t + 1 < 16) SLOAD(t + 1);
        f32x4 s[2];
#pragma unroll
        for (int sub = 0; sub < 2; ++sub) {
            s[sub] = (f32x4){0.f, 0.f, 0.f, 0.f};
#pragma unroll
            for (int ks = 0; ks < 4; ++ks) s[sub] = mfma16(*(const LAS bf16x8*)(Kt + sub * 4096 + kad[ks]), qf[ks], s[sub]);
        }
        float mx = fmaxf(fmaxf(fmaxf(s[0][0], s[0][1]), fmaxf(s[0][2], s[0][3])), fmaxf(fmaxf(s[1][0], s[1][1]), fmaxf(s[1][2], s[1][3])));
        mx = xmax4(mx);
        const float mn = fmaxf(st.m, mx), al = ex2(st.m - mn); st.m = mn; float sum = 0.f;
#pragma unroll
        for (int i = 0; i < 2; ++i)
#pragma unroll
            for (int r = 0; r < 4; ++r) { s[i][r] = ex2(s[i][r] - mn); sum += s[i][r]; }
        st.l = st.l * al + sum;
        const bf16x8 pf = pack_bf8(s[0], s[1]);
#pragma unroll
        for (int nb = 0; nb < 8; ++nb) { const bf16x8 va = tr_pair(Vt + vad[nb], Vt + vad[nb] + 16 * 256); O[nb] = mfma16(va, pf, O[nb] * al); }
    }
#undef SLOAD
    const float l = xsum4(st.l);
    float* P = (float*)(F.ws + WS_PART) + ((size_t)(b * 4 + head) * 16 + 2 * rg + hf) * PART_STRIDE;
    if (g == 0) { P[li] = st.m; P[16 + li] = l; }
#pragma unroll
    for (int nb = 0; nb < 8; ++nb) *(f32x4*)(P + 32 + li * 128 + 16 * nb + 4 * g) = O[nb];
}
__device__ __forceinline__ void attn_sample_combine(Frame& F, float lam, int b, int head) {
    LAUNDER_TID(); const int qp = tid >> 5, dvc = tid & 31, qi = qp & 7, half = qp >> 3, dv = 4 * dvc;
    const bf16* QB = (const bf16*)(F.ws + WS_QB); const bf16* KB = (const bf16*)(F.ws + WS_KB); const bf16* VB = (const bf16*)(F.ws + WS_VB); bf16* CB = (bf16*)(F.ws + WS_CB);
    const float* P = (const float*)(F.ws + WS_PART) + (size_t)(b * 4 + head) * 16 * PART_STRIDE;
    float M = -1e30f;
    for (int sl = 0; sl < 16; ++sl) M = fmaxf(M, P[sl * PART_STRIDE + qp]);
    const size_t tq = NP + 8 * b + qi; const bf16* qrow = QB + tq * 512 + head * 128 + 64 * half;
    float sc[8];
#pragma unroll
    for (int j = 0; j < 8; ++j) { const bf16* krow = KB + (size_t)(NP + 8 * b + j) * 512 + head * 128 + 64 * half; float d = 0.f;
#pragma unroll 2
        for (int e = 0; e < 8; ++e) { const v4u a = *(const v4u*)(qrow + 8 * e), k = *(const v4u*)(krow + 8 * e);
            d += (bflo(a.x) * bflo(k.x) + bfhi(a.x) * bfhi(k.x)) + (bflo(a.y) * bflo(k.y) + bfhi(a.y) * bfhi(k.y)) + (bflo(a.z) * bflo(k.z) + bfhi(a.z) * bfhi(k.z)) + (bflo(a.w) * bflo(k.w) + bfhi(a.w) * bfhi(k.w)); }
        sc[j] = (j <= qi) ? d : -__builtin_inff(); M = fmaxf(M, sc[j]); }
    float Lacc = 0.f; f32x4 Oa = (f32x4){0.f, 0.f, 0.f, 0.f};
    for (int sl = 0; sl < 16; ++sl) { const float w = ex2(P[sl * PART_STRIDE + qp] - M); Lacc += w * P[sl * PART_STRIDE + 16 + qp]; Oa = Oa + *(const f32x4*)(P + sl * PART_STRIDE + 32 + qp * 128 + dv) * w; }
#pragma unroll
    for (int j = 0; j < 8; ++j) { const float p = ex2(sc[j] - M); Lacc += p; const float pb = bf2f((unsigned short)f2bf(p));
        const bf16* vrow = VB + (size_t)(NP + 8 * b + j) * 512 + head * 128 + dv;
        Oa[0] += pb * bf2f(vrow[0]); Oa[1] += pb * bf2f(vrow[1]); Oa[2] += pb * bf2f(vrow[2]); Oa[3] += pb * bf2f(vrow[3]); }
    LAS float* buf = (LAS float*)F.lds;
    const float inv = 1.0f / Lacc;
    *(LAS f32x4*)(buf + (half * 8 + qi) * 128 + dv) = Oa * inv;
    __syncthreads();
    if (half == 0) {
        const f32x4 a = *(const LAS f32x4*)(buf + qi * 128 + dv), c = *(const LAS f32x4*)(buf + (8 + qi) * 128 + dv); const f32x4 o = a - c * lam;
        float ssq = (o[0] * o[0] + o[1] * o[1]) + (o[2] * o[2] + o[3] * o[3]);
#pragma unroll
        for (int x = 1; x < 32; x <<= 1) ssq += __shfl_xor(ssq, x);
        const float rn = (1.0f - LAM_INIT) / sqrtf(ssq * (1.0f / 128.0f) + EPS); const f32x4 sg = *(const f32x4*)(F.in[I_SUBLN] + dv);
        const unsigned w0 = cvtpk(o[0] * rn * sg[0], o[1] * rn * sg[1]), w1 = cvtpk(o[2] * rn * sg[2], o[3] * rn * sg[3]);
        *(unsigned long long*)(CB + tq * 1024 + 512 + head * 128 + dv) = (unsigned long long)w0 | ((unsigned long long)w1 << 32);
    }
    __syncthreads();
}

__device__ __forceinline__ void ssm_prompt_unit(Frame& F, int b, int g) {
    LAUNDER_TID(); const int n = lane & 31, hi = lane >> 5, chunk = 32 * wave + n;
    const bf16* XB = (const bf16*)(F.ws + WS_XB); bf16* G = (bf16*)(F.ws + WS_CB);
    const unsigned long long* ss2 = (const unsigned long long*)(F.ws + WS_SS) + 2 * (size_t)NTOK;
    const bf16* Tg = (const bf16*)(F.ws + WS_T) + (size_t)g * 65536; const bf16* Eg = (const bf16*)(F.ws + WS_E) + (size_t)g * 32768; const bf16* Fg = (const bf16*)(F.ws + WS_F) + (size_t)g * 32768;
    LAS float* S = (LAS float*)F.lds;
    const size_t tok0 = (size_t)b * SEQ + 16 * chunk;
    bf16x8 uf[16];
#pragma unroll
    for (int ks = 0; ks < 16; ++ks) { const size_t tok = tok0 + ks; const v4u w = *(const v4u*)(XB + tok * 1024 + 16 * g + 8 * hi); const float r = ss_rinv(ss2 + tok, 1.0f / 1024.0f);
        v4u o; o.x = cvtpk(bflo(w.x) * r, bfhi(w.x) * r); o.y = cvtpk(bflo(w.y) * r, bfhi(w.y) * r); o.z = cvtpk(bflo(w.z) * r, bfhi(w.z) * r); o.w = cvtpk(bflo(w.w) * r, bfhi(w.w) * r);
        uf[ks] = __builtin_bit_cast(bf16x8, o); }
#pragma unroll 1
    for (int mb = 0; mb < 4; ++mb) {
        f32x16 acc = (f32x16){};
#pragma unroll
        for (int ks = 0; ks < 16; ++ks) acc = mfma32(*(const bf16x8*)(Eg + (32 * mb + n) * 256 + 16 * ks + 8 * hi), uf[ks], acc);
#pragma unroll
        for (int i = 0; i < 4; ++i) *(LAS f32x4*)(S + chunk * 132 + 32 * mb + 8 * i + 4 * hi) = (f32x4){acc[4 * i], acc[4 * i + 1], acc[4 * i + 2], acc[4 * i + 3]};
    }
    __syncthreads();
    {
        LAS float* car = S + 256 * 132;
        const f32x2_t aL = ((const f32x2_t*)(F.ws + WS_PW16))[g * 64 + lane]; float sr = 0.f, si = 0.f;
#pragma unroll 8
        for (int c = 32 * wave; c < 32 * wave + 32; ++c) { const float lr = S[c * 132 + lane], li_ = S[c * 132 + 64 + lane]; S[c * 132 + lane] = sr; S[c * 132 + 64 + lane] = si;
            const float nr = aL.x * sr - aL.y * si + lr, ni = aL.x * si + aL.y * sr + li_; sr = nr; si = ni; }
        car[wave * 128 + lane] = sr; car[wave * 128 + 64 + lane] = si;
        __syncthreads();
        float ar = aL.x, ai = aL.y;
#pragma unroll
        for (int q = 0; q < 5; ++q) { const float nr = ar * ar - ai * ai, ni = 2.f * ar * ai; ar = nr; ai = ni; }
        float cr = 0.f, ci = 0.f;
        for (int w2 = 0; w2 < wave; ++w2) { const float lr = car[w2 * 128 + lane], li_ = car[w2 * 128 + 64 + lane]; const float nr = ar * cr - ai * ci + lr, ni = ar * ci + ai * cr + li_; cr = nr; ci = ni; }
        float pr = 1.f, pi = 0.f;
#pragma unroll 8
        for (int c = 32 * wave; c < 32 * wave + 32; ++c) { S[c * 132 + lane] += pr * cr - pi * ci; S[c * 132 + 64 + lane] += pr * ci + pi * cr;
            const float nr = pr * aL.x - pi * aL.y, ni = pr * aL.y + pi * aL.x; pr = nr; pi = ni; }
        if (wave == 7) { const float fr_ = ar * cr - ai * ci + sr, fi_ = ar * ci + ai * cr + si;
            F.out[OFF_SRP + (size_t)(b * 64 + g) * 64 + lane] = fr_; F.out[OFF_SIP + (size_t)(b * 64 + g) * 64 + lane] = fi_; }
    }
    __syncthreads();
    bf16x8 sf[8];
#pragma unroll
    for (int ks = 0; ks < 8; ++ks) { const f32x4 a = *(const LAS f32x4*)(S + chunk * 132 + 16 * ks + 8 * hi), c = *(const LAS f32x4*)(S + chunk * 132 + 16 * ks + 8 * hi + 4); sf[ks] = pack_bf8(a, c); }
#pragma unroll
    for (int mb = 0; mb < 8; ++mb) {
        f32x16 acc = (f32x16){};
#pragma unroll
        for (int ks = 0; ks < 16; ++ks) if (ks <= 2 * mb + 1) acc = mfma32(*(const bf16x8*)(Tg + (32 * mb + n) * 256 + 16 * ks + 8 * hi), uf[ks], acc);
#pragma unroll
        for (int ks = 0; ks < 8; ++ks) acc = mfma32(*(const bf16x8*)(Fg + (32 * mb + n) * 128 + 16 * ks + 8 * hi), sf[ks], acc);
#pragma unroll
        for (int i = 0; i < 4; ++i) { const int t = 2 * mb + (i >> 1), c = 8 * (i & 1) + 4 * hi;
            const unsigned w0 = cvtpk(gelu_t(acc[4 * i]), gelu_t(acc[4 * i + 1])), w1 = cvtpk(gelu_t(acc[4 * i + 2]), gelu_t(acc[4 * i + 3]));
            *(unsigned long long*)(G + (tok0 + t) * 1024 + 16 * g + c) = (unsigned long long)w0 | ((unsigned long long)w1 << 32); }
    }
    __syncthreads();
}
__device__ __forceinline__ void ssm_sample_unit(Frame& F, int b, int g) {
    LAUNDER_TID(); const int p = lane; const bf16* XB = (const bf16*)(F.ws + WS_XB); bf16* G = (bf16*)(F.ws + WS_CB);
    const unsigned long long* ss2 = (const unsigned long long*)(F.ws + WS_SS) + 2 * (size_t)NTOK;
    const f32x2_t a = ((const f32x2_t*)(F.ws + WS_PW1))[g * 64 + p]; const f32x2_t* BB = (const f32x2_t*)(F.ws + WS_BBAR) + (size_t)g * 1024 + p * 16;
    const float* c_re = F.in[I_CRE] + (size_t)g * 1024; const float* c_im = F.in[I_CIM] + (size_t)g * 1024; const float* g1 = F.in[I_NMIX] + 1024 + 16 * g; const float* dsk = F.in[I_SD] + 16 * g;
    LAS float* sh = (LAS float*)(F.lds + wave * 4096);
    float sr = F.in[I_SRE][(size_t)(b * 64 + g) * 64 + p], si = F.in[I_SIM][(size_t)(b * 64 + g) * 64 + p];
    f32x2_t bb[16];
#pragma unroll
    for (int c = 0; c < 16; ++c) bb[c] = BB[c];
#pragma unroll
    for (int t = 0; t < 8; ++t) {
        const size_t tok = NP + 8 * b + t; const float r = ss_rinv(ss2 + tok, 1.0f / 1024.0f); float br = 0.f, bi = 0.f;
        const v4u w0 = *(const v4u*)(XB + tok * 1024 + 16 * g), w1 = *(const v4u*)(XB + tok * 1024 + 16 * g + 8); const unsigned ww[8] = {w0.x, w0.y, w0.z, w0.w, w1.x, w1.y, w1.z, w1.w};
#pragma unroll
        for (int c = 0; c < 16; ++c) { const float u = ((c & 1) ? bfhi(ww[c >> 1]) : bflo(ww[c >> 1])) * r * g1[c]; br += bb[c].x * u; bi += bb[c].y * u; }
        const float nr = a.x * sr - a.y * si + br, ni = a.x * si + a.y * sr + bi; sr = nr; si = ni;
        sh[t * 128 + p] = sr; sh[t * 128 + 64 + p] = si;
    }
    F.out[OFF_SRS + (size_t)(b * 64 + g) * 64 + p] = sr; F.out[OFF_SIS + (size_t)(b * 64 + g) * 64 + p] = si;
    LDS_WAIT(); asm volatile("" ::: "memory");
    {   const int t = lane >> 3, c0 = 2 * (lane & 7); const size_t tok = NP + 8 * b + t; float y0 = 0.f, y1 = 0.f;
        const float* cr0 = c_re + c0 * 64; const float* ci0 = c_im + c0 * 64;
#pragma unroll 4
        for (int q = 0; q < 16; ++q) { const f32x4 xr = *(const LAS f32x4*)(sh + t * 128 + 4 * q), xi = *(const LAS f32x4*)(sh + t * 128 + 64 + 4 * q);
            const f32x4 a0 = *(const f32x4*)(cr0 + 4 * q), b0 = *(const f32x4*)(ci0 + 4 * q), a1 = *(const f32x4*)(cr0 + 64 + 4 * q), b1 = *(const f32x4*)(ci0 + 64 + 4 * q);
#pragma unroll
            for (int e = 0; e < 4; ++e) { y0 += a0[e] * xr[e] - b0[e] * xi[e]; y1 += a1[e] * xr[e] - b1[e] * xi[e]; } }
        const float r = ss_rinv(ss2 + tok, 1.0f / 1024.0f); const unsigned xw = *(const unsigned*)(XB + tok * 1024 + 16 * g + c0);
        y0 += dsk[c0] * (bflo(xw) * r * g1[c0]); y1 += dsk[c0 + 1] * (bfhi(xw) * r * g1[c0 + 1]);
        *(unsigned*)(G + tok * 1024 + 16 * g + c0) = cvtpk(gelu_t(y0), gelu_t(y1));
    }
    LDS_WAIT(); asm volatile("" ::: "memory");
}

template <int MODE, int K>
__device__ __forceinline__ void sample_gemm_tile(Frame& F, const bf16* A, const bf16* Bt, int tile, const float* bglu, float* X, bf16* XB, bool wxb, unsigned long long* ss) {
    LAUNDER_TID();
    constexpr int kper = K / 8, nks = kper / 16;
    const int rb = tile >> 5, cb = tile & 31, r32 = lane & 31, hi = lane >> 5, k0 = wave * kper;
    const bf16* ap = A + (size_t)(32 * rb + r32) * K + k0 + 8 * hi;
    const int brow = MODE == 0 ? 32 * cb + r32 : 256 * (cb >> 2) + 32 * (cb & 3) + r32;
    const bf16* bp = Bt + (size_t)brow * K + k0 + 8 * hi;
    f32x16 acc = (f32x16){}, acc2 = (f32x16){};
#pragma unroll
    for (int ks = 0; ks < nks; ++ks) { const bf16x8 a = *(const bf16x8*)(ap + 16 * ks); const bf16x8 b = *(const bf16x8*)(bp + 16 * ks); acc = mfma32(a, b, acc);
        if (MODE == 1) { const bf16x8 b2 = *(const bf16x8*)(bp + (size_t)128 * K + 16 * ks); acc2 = mfma32(a, b2, acc2); } }
    LAS float* red = (LAS float*)F.lds;
#pragma unroll
    for (int r = 0; r < 16; ++r) { red[(wave * 16 + r) * 64 + lane] = acc[r]; if (MODE == 1) red[8192 + (wave * 16 + r) * 64 + lane] = acc2[r]; }
    __syncthreads();
#pragma unroll
    for (int h2 = 0; h2 < 2; ++h2) {
        const int r = (tid >> 6) + 8 * h2, l2 = tid & 63; float sum = 0.f, sum2 = 0.f;
#pragma unroll
        for (int w = 0; w < 8; ++w) { sum += red[(w * 16 + r) * 64 + l2]; if (MODE == 1) sum2 += red[8192 + (w * 16 + r) * 64 + l2]; }
        const int row = 32 * rb + (r & 3) + 8 * (r >> 2) + 4 * (l2 >> 5), col = 32 * cb + (l2 & 31); const size_t go = (size_t)(NP + row) * 1024 + col;
        float o = bf2f(XB[go]);
        if (MODE == 0) o += sum; else o += (sum + bglu[col]) * pg8::sigm(sum2 + bglu[1024 + col]);
        if (X) X[go] = o;
        if (wxb) XB[go] = (bf16)f2bf(o);
        float ssq = o * o;
#pragma unroll
        for (int x = 1; x < 32; x <<= 1) ssq += __shfl_xor(ssq, x);
        if ((l2 & 31) == 0) pg8::ss_add(ss + NP + row, ssq);
    }
    __syncthreads();
}
__device__ __forceinline__ void final_norm_row(Frame& F, int m) {
    LAUNDER_TID(); const float* X = (const float*)(F.ws + WS_X) + (size_t)m * 1024; const unsigned long long* ss4 = (const unsigned long long*)(F.ws + WS_SS) + 4 * (size_t)NTOK;
    const float r = ss_rinv(ss4 + m, 1.0f / 1024.0f); const float* gf = F.in[I_NFIN]; float* o = F.out + OFF_YP + (size_t)m * 1024;
#pragma unroll
    for (int j = 0; j < 4; ++j) { const int c = 4 * lane + 256 * j; const f32x4 v = *(const f32x4*)(X + c), gg = *(const f32x4*)(gf + c); *(f32x4*)(o + c) = v * gg * r; }
}
#ifndef MK_LAST_PHASE
#define MK_LAST_PHASE 99
#endif
#ifndef MK_REP_ATTNP
#define MK_REP_ATTNP 1
#endif
#ifndef MK_REP_ATTNS
#define MK_REP_ATTNS 1
#endif
#ifndef MK_REP_SGU
#define MK_REP_SGU 1
#endif
#ifndef MK_REP_SSM
#define MK_REP_SSM 1
#endif
#ifndef MK_REP_G3
#define MK_REP_G3 1
#endif
#ifndef MK_REP_P0
#define MK_REP_P0 1
#endif
#ifndef MK_REP_G1
#define MK_REP_G1 1
#endif
#ifndef MK_REP_FIN
#define MK_REP_FIN 1
#endif
#ifndef MK_PROBE_GEMMS
#define MK_PROBE_GEMMS 0
#endif
#ifndef MK_TMASK
#define MK_TMASK 0
#endif
#define MK_TMULT 4
struct Args { const float* in[32]; float* out; unsigned char* ws; };
__global__ void __launch_bounds__(NWAVES * 64, 2) hyb_fwd(Args args) {
    extern __shared__ __attribute__((aligned(16))) unsigned char lds[];
    Frame F;
    F.lds = (LAS unsigned char*)lds;
    F.MISC = (volatile LAS unsigned*)(F.lds + MISC_OFF);
    F.tid = threadIdx.x; F.lane = F.tid & 63; F.wave = __builtin_amdgcn_readfirstlane(F.tid >> 6);
    F.G = gridDim.x; { const int bx = blockIdx.x; F.vcu = (F.G % 8 == 0) ? (bx % 8) * (F.G / 8) + bx / 8 : bx; }
    F.in = args.in;
    F.out = args.out; F.ws = args.ws; F.ctl = (gu32*)(args.ws + WS_CTL);
    for (int u = F.tid; u < (LDS_BYTES - LDSCTL_OFF) / 4; u += NWAVES * 64) ((LAS unsigned*)(F.lds + LDSCTL_OFF))[u] = 0u;
    __syncthreads();
    XcdBarrier bar = xcd_barrier_post((unsigned*)(F.ctl + CW_BAR), F.MISC + 8);
#define GRID_BAR() xcd_barrier(bar)
    unsigned long long t_prev = 0, t_acc = 0; int t_idx = 0;
#define TSTAMP() do { if (MK_TMASK) { const unsigned long long t_now = __builtin_amdgcn_s_memrealtime(); if ((MK_TMASK >> t_idx) & 1) t_acc += t_now - t_prev; t_prev = t_now; ++t_idx; } } while (0)
    if (MK_TMASK) t_prev = __builtin_amdgcn_s_memrealtime();
    unsigned char* ws = F.ws;
    bf16* XB = (bf16*)(ws + WS_XB); float* X = (float*)(ws + WS_X); bf16* CB = (bf16*)(ws + WS_CB); bf16* ACT = (bf16*)(ws + WS_ACT);
    unsigned long long* SS = (unsigned long long*)(ws + WS_SS);

    for (int rep = 0; rep < MK_REP_P0; ++rep) { p0_prologue(F); __syncthreads(); }
    GRID_BAR(); TSTAMP();
    for (int rep = 0; rep < MK_REP_G1; ++rep) {
        pg8::Gemm g{XB, (const bf16*)(ws + WS_W1), NTOK, 2560, 1024}; pg8::StaticOrder S; S.init(NTOK, 2560, F.G, (int)blockIdx.x);
        pg8::EpiInProj E{(const float*)(ws + WS_R0), (bf16*)(ws + WS_U), (bf16*)(ws + WS_VR), (bf16*)(ws + WS_QB), (bf16*)(ws + WS_KB), (bf16*)(ws + WS_VB), SS, F.out, rep == 0};
        pg8::gemm_phase<pg8::EpiInProj, pg8::StaticOrder, true, true>(F.lds + RING_OFF, g, S, E);
        if (rep == 0) {
            const int rem = ((NTOK / 256) * (2560 / 256)) % F.G;
            if (rem == 0) p0_late_weights(F, 0, (int)blockIdx.x, F.G); else if ((int)blockIdx.x >= rem) p0_late_weights(F, 0, (int)blockIdx.x - rem, F.G - rem);
        }
    }
    GRID_BAR(); TSTAMP();
    const float lam = lambda_val(F);
    if (MK_LAST_PHASE >= 2) {
        const bool stream_first = ((F.vcu >> 4) & 1) != 0;
        if (stream_first) { for (int u = F.vcu; u < 256; u += F.G) attn_sample_unit(F, u >> 3, u & 7); __syncthreads(); }
        for (int rep = 0; rep < MK_REP_ATTNP; ++rep)
        for (int u = F.vcu; u < 256; u += F.G) { const int bh = u >> 4, s = u & 15; attn_prompt_unit(F, lam, bh >> 2, bh & 3, s); attn_prompt_unit(F, lam, bh >> 2, bh & 3, 31 - s); }
        if (!stream_first) { for (int u = F.vcu; u < 256; u += F.G) attn_sample_unit(F, u >> 3, u & 7); }
        __syncthreads();
        for (int rep = 0; rep < MK_REP_SGU; ++rep) {
        for (int u = F.vcu; u < 512; u += F.G) sgu_prompt_unit(F, u >> 2, u & 3);
        for (int u = F.vcu; u < 32; u += F.G) sgu_sample_unit(F, u); }
    }
    GRID_BAR(); TSTAMP();
    if (MK_LAST_PHASE >= 2) { for (int u = F.vcu; u < 128; u += F.G) attn_sample_combine(F, lam, u >> 2, u & 3); p0_late_weights(F, 1, F.vcu, F.G); }
    GRID_BAR(); TSTAMP();
    if (MK_LAST_PHASE >= 3) {
        pg8::Gemm g{CB, (const bf16*)(ws + WS_W2), NP, 1024, 1024}; pg8::StaticOrder S; S.init(NP, 1024, F.G, (int)blockIdx.x);
        pg8::EpiResid E{XB, nullptr, true, SS + 1 * (size_t)NTOK};
        pg8::gemm_phase<pg8::EpiResid, pg8::StaticOrder, true, true>(F.lds + RING_OFF, g, S, E);
        for (int t = F.vcu; t < 256; t += F.G) sample_gemm_tile<0, 1024>(F, CB + (size_t)NP * 1024, (const bf16*)(ws + WS_W2), t, nullptr, nullptr, XB, true, SS + 1 * (size_t)NTOK);
    }
    GRID_BAR(); TSTAMP();
    for (int rep = 0; rep < MK_REP_G3; ++rep) {
        pg8::Gemm g{XB, (const bf16*)(ws + WS_W3), NTOK, 5632, 1024}; pg8::StaticOrder S; S.init(NTOK, 5632, F.G, (int)blockIdx.x);
        pg8::EpiSwiGLU E{SS + 1 * (size_t)NTOK, ACT};
        pg8::gemm_phase<pg8::EpiSwiGLU, pg8::StaticOrder, true, true>(F.lds + RING_OFF, g, S, E);
        if (rep == 0) {
            const int rem = ((NTOK / 256) * (5632 / 256)) % F.G; const int j = rem == 0 ? (int)blockIdx.x : (int)blockIdx.x - rem, nj = rem == 0 ? F.G : F.G - rem;
            if (j >= 0) for (int u = j; u < 64; u += nj) p0_ssm_tables(F, u);
        }
    }
    GRID_BAR(); TSTAMP();
    if (MK_LAST_PHASE >= 5) {
        pg8::Gemm g{ACT, (const bf16*)(ws + WS_W4), NP, 1024, 2816}; pg8::StaticOrder S; S.init(NP, 1024, F.G, (int)blockIdx.x);
        pg8::EpiResid E{XB, nullptr, true, SS + 2 * (size_t)NTOK};
        pg8::gemm_phase<pg8::EpiResid, pg8::StaticOrder, true, true>(F.lds + RING_OFF, g, S, E);
        for (int t = F.vcu; t < 256; t += F.G) sample_gemm_tile<0, 2816>(F, ACT + (size_t)NP * 2816, (const bf16*)(ws + WS_W4), t, nullptr, nullptr, XB, true, SS + 2 * (size_t)NTOK);
    }
    GRID_BAR(); TSTAMP();
    if (MK_LAST_PHASE >= 6) {
        for (int rep = 0; rep < MK_REP_SSM; ++rep) {
        for (int u = F.vcu; u < 256; u += F.G) ssm_prompt_unit(F, u >> 6, u & 63);
        for (int w = F.vcu * NWAVES + F.wave; w < 2048; w += F.G * NWAVES) ssm_sample_unit(F, w >> 6, w & 63); }
    }
    GRID_BAR(); TSTAMP();
    if (MK_LAST_PHASE >= 7) {
        pg8::Gemm g{CB, (const bf16*)(ws + WS_W5), NP, 2048, 1024}; pg8::StaticOrder S; S.init(NP, 2048, F.G, (int)blockIdx.x);
        pg8::EpiGLU E{F.in[I_BGLU], XB, SS + 3 * (size_t)NTOK};
        pg8::gemm_phase<pg8::EpiGLU, pg8::StaticOrder, true, true>(F.lds + RING_OFF, g, S, E);
        for (int t = F.vcu; t < 256; t += F.G) sample_gemm_tile<1, 1024>(F, CB + (size_t)NP * 1024, (const bf16*)(ws + WS_W5), t, F.in[I_BGLU], nullptr, XB, true, SS + 3 * (size_t)NTOK);
    }
    GRID_BAR(); TSTAMP();
    if (MK_LAST_PHASE >= 8) {
        pg8::Gemm g{XB, (const bf16*)(ws + WS_W6), NTOK, 5632, 1024}; pg8::StaticOrder S; S.init(NTOK, 5632, F.G, (int)blockIdx.x);
        pg8::EpiSwiGLU E{SS + 3 * (size_t)NTOK, ACT};
        pg8::gemm_phase<pg8::EpiSwiGLU, pg8::StaticOrder, true, true>(F.lds + RING_OFF, g, S, E);
    }
    GRID_BAR(); TSTAMP();
    if (MK_LAST_PHASE >= 9) {
        pg8::Gemm g{ACT, (const bf16*)(ws + WS_W7), NP, 1024, 2816}; pg8::StaticOrder S; S.init(NP, 1024, F.G, (int)blockIdx.x);
        pg8::EpiResid E{XB, X, false, SS + 4 * (size_t)NTOK};
        pg8::gemm_phase<pg8::EpiResid, pg8::StaticOrder, true, true>(F.lds + RING_OFF, g, S, E);
        for (int t = F.vcu; t < 256; t += F.G) sample_gemm_tile<0, 2816>(F, ACT + (size_t)NP * 2816, (const bf16*)(ws + WS_W7), t, nullptr, X, XB, false, SS + 4 * (size_t)NTOK);
    }
    GRID_BAR(); TSTAMP();
#if MK_PROBE_GEMMS
    {   pg8::EpiNull E{X, (int)F.G};
        { pg8::Gemm g{CB, (const bf16*)(ws + WS_W2), NP, 1024, 1024}; pg8::StaticOrder S; S.init(NP, 1024, F.G, (int)blockIdx.x); pg8::gemm_phase<pg8::EpiNull, pg8::StaticOrder, true, true>(F.lds + RING_OFF, g, S, E); }
        { pg8::Gemm g{ACT, (const bf16*)(ws + WS_W4), NP, 1024, 2816}; pg8::StaticOrder S; S.init(NP, 1024, F.G, (int)blockIdx.x); pg8::gemm_phase<pg8::EpiNull, pg8::StaticOrder, true, true>(F.lds + RING_OFF, g, S, E); }
        { pg8::Gemm g{CB, (const bf16*)(ws + WS_W5), NP, 2048, 1024}; pg8::StaticOrder S; S.init(NP, 2048, F.G, (int)blockIdx.x); pg8::gemm_phase<pg8::EpiNull, pg8::StaticOrder, true, true>(F.lds + RING_OFF, g, S, E); }
        { pg8::Gemm g{ACT, (const bf16*)(ws + WS_W7), NP, 1024, 2816}; pg8::StaticOrder S; S.init(NP, 1024, F.G, (int)blockIdx.x); pg8::gemm_phase<pg8::EpiNull, pg8::StaticOrder, true, true>(F.lds + RING_OFF, g, S, E); }
    }
#endif
    for (int rep = 0; rep < MK_REP_FIN; ++rep) { for (int m = F.vcu * NWAVES + F.wave; m < NTOK; m += F.G * NWAVES) final_norm_row(F, m); }
    if (MK_TMASK) { TSTAMP(); if (blockIdx.x == 0 && F.tid == 0) { const unsigned long long t0_ = __builtin_amdgcn_s_memrealtime(); while (__builtin_amdgcn_s_memrealtime() - t0_ < MK_TMULT * t_acc) __builtin_amdgcn_s_sleep(8); } }
}

extern "C" void kernel_launch(void* const* d_in, const int* in_sizes, int n_in, void* d_out, int out_size, void* d_ws, size_t ws_size, hipStream_t stream) {
    static int grid = 0;
    if (grid == 0) {
        if (n_in != 32 || (size_t)out_size != OUT_TOTAL || ws_size < WS_END) { fprintf(stderr, "kernel_launch: shape mismatch (n_in %d, out %d, ws %zu); nothing launched\n", n_in, out_size, ws_size); grid = -1; return; }
        int dev = 0, cus = 0, per_cu = 0;
        if (hipGetDevice(&dev) != hipSuccess || hipDeviceGetAttribute(&cus, hipDeviceAttributeMultiprocessorCount, dev) != hipSuccess) { grid = -1; return; }
        if (hipFuncSetAttribute((const void*)hyb_fwd, hipFuncAttributeMaxDynamicSharedMemorySize, LDS_BYTES) != hipSuccess) { fprintf(stderr, "kernel_launch: hipFuncSetAttribute failed\n"); grid = -1; return; }
        if (hipOccupancyMaxActiveBlocksPerMultiprocessor(&per_cu, (const void*)hyb_fwd, NWAVES * 64, LDS_BYTES) != hipSuccess || per_cu < 1) { fprintf(stderr, "kernel_launch: occupancy query says %d blocks per CU\n", per_cu); }
        (void)hipGetLastError();
        grid = cus;
    }
    if (grid < 0) return;
    if (hipMemsetAsync((char*)d_ws + WS_CTL, 0, CTL_ZERO_BYTES, stream) != hipSuccess) { fprintf(stderr, "kernel_launch: memset failed\n"); return; }
    Args a{};
    for (int i = 0; i < 32; ++i) a.in[i] = (const float*)d_in[i];
    a.out = (float*)d_out; a.ws = (unsigned char*)d_ws;
    hipLaunchKernelGGL(hyb_fwd, dim3(grid), dim3(NWAVES * 64), LDS_BYTES, stream, a);
    const hipError_t le = hipPeekAtLastError();
    if (le != hipSuccess) fprintf(stderr, "kernel_launch: launch failed: %s\n", hipGetErrorName(le));
}
```
